# Optimizing an MI355X kernel written in HIP

```python
import math
import jax, jax.numpy as jnp
from jax import lax
import numpy as np

D_MODEL = 1024
BATCH = 8
SEQ = 4096
DEPTH = 1
DEC_BATCH = 32
DEC_SEQ = 16
PAST_LEN = 4096

CHUNK = 64
Q_BLOCK = 128
N_HEADS = 4
HEAD_DIM = 64
V_DIM = 2 * HEAD_DIM
ATTN_WIDTH = N_HEADS * V_DIM
CONV_WIDTH = D_MODEL - ATTN_WIDTH
MIX_WIDTH = ATTN_WIDTH + CONV_WIDTH
CONV_K = 31
QK_COLS = N_HEADS * 2 * HEAD_DIM
IN_COLS = 2 * QK_COLS + ATTN_WIDTH + 2 * CONV_WIDTH
D_FF = 4 * D_MODEL
N_MEM = 256
MEM_HEADS = 4
MEM_HEAD_DIM = 128
MEM_WIDTH = MEM_HEADS * MEM_HEAD_DIM
N_BUCKETS = 32
MAX_DISTANCE = 128
EPS = 1e-6
NEG_INF = -1e30

kernel_name = 'hybrid_diffattn_conformer_stream_step'


def rmsnorm(x, g):
    xf = x.astype(jnp.float32)
    y = xf * lax.rsqrt(jnp.mean(xf * xf, axis=-1, keepdims=True) + EPS)
    return (y * g.astype(jnp.float32)).astype(x.dtype)


def layernorm(x, g, b):
    xf = x.astype(jnp.float32)
    mu = jnp.mean(xf, axis=-1, keepdims=True)
    xc = xf - mu
    y = xc * lax.rsqrt(jnp.mean(xc * xc, axis=-1, keepdims=True) + EPS)
    return (y * g.astype(jnp.float32) + b.astype(jnp.float32)).astype(x.dtype)


def rel_bucket(rel):
    half = N_BUCKETS // 2
    max_exact = half // 2
    ret = jnp.where(rel > 0, half, 0)
    n = jnp.abs(rel)
    nf = jnp.maximum(n, 1).astype(jnp.float32)
    large = max_exact + (jnp.log(nf / max_exact) / math.log(MAX_DISTANCE / max_exact)
                         * (half - max_exact)).astype(jnp.int32)
    large = jnp.minimum(large, half - 1)
    return ret + jnp.where(n < max_exact, n, large)


def rel_bias(q_pos, k_pos, table):
    b = rel_bucket(k_pos[None, :] - q_pos[:, None])
    return jnp.transpose(table[b], (2, 0, 1)).astype(jnp.float32)


def chunk_mask(q_pos, k_pos):
    return (k_pos[None, :] // CHUNK) <= (q_pos[:, None] // CHUNK)


def diff_attend(q, k, v, bias, mask, lam):
    s = jnp.einsum('bqhmd,bkhmd->bhmqk', q, k).astype(jnp.float32) * (HEAD_DIM ** -0.5)
    s = jnp.where(mask, s + bias[None, :, None], NEG_INF)
    p = jax.nn.softmax(s, axis=-1)
    w = p[:, :, 0] - lam * p[:, :, 1]
    return jnp.einsum('bhqk,bkhe->bqhe', w.astype(v.dtype), v)


def depthwise_causal_conv(c_hist, w_conv, b_conv):
    out = lax.conv_general_dilated(
        c_hist, w_conv[:, None, :].astype(c_hist.dtype), window_strides=(1,), padding='VALID',
        dimension_numbers=('NWC', 'WIO', 'NWC'), feature_group_count=CONV_WIDTH)
    return out + b_conv


def memory_kv(mem, g_mem, w_mk, w_mv, g_mk):
    B, M, _ = mem.shape
    m = rmsnorm(mem, g_mem)
    mk = rmsnorm((m @ w_mk).reshape(B, M, MEM_HEADS, MEM_HEAD_DIM), g_mk)
    mv = (m @ w_mv).reshape(B, M, MEM_HEADS, MEM_HEAD_DIM)
    return mk, mv


def cross_attend(h, mk, mv, w_mq, g_mq, w_mo):
    B, T, _ = h.shape
    q = rmsnorm((h @ w_mq).reshape(B, T, MEM_HEADS, MEM_HEAD_DIM), g_mq)
    s = jnp.einsum('bqhd,bkhd->bhqk', q, mk.astype(q.dtype)).astype(jnp.float32) * (MEM_HEAD_DIM ** -0.5)
    p = jax.nn.softmax(s, axis=-1)
    o = jnp.einsum('bhqk,bkhd->bqhd', p.astype(h.dtype), mv.astype(h.dtype)).reshape(B, T, MEM_WIDTH)
    return o @ w_mo


def trunk_layer(x, k_past, v_past, c_past, mk, mv, rel_table, g_mix, w_in, g_q, g_k, lam_vec,
                g_sub, w_conv, b_conv, ln_g, ln_b, w_out, g_cross, w_mq, g_mq, w_mo,
                g_ffn, w_ff1, w_ff2, lam_init):
    B, T, _ = x.shape
    P = k_past.shape[1]
    h = rmsnorm(x, g_mix)
    z = h @ w_in
    zq, zk, zv, zu = jnp.split(z, [QK_COLS, 2 * QK_COLS, 2 * QK_COLS + ATTN_WIDTH], axis=-1)
    q = rmsnorm(zq.reshape(B, T, N_HEADS, 2, HEAD_DIM), g_q)
    k = rmsnorm(zk.reshape(B, T, N_HEADS, 2, HEAD_DIM), g_k)
    v = zv.reshape(B, T, N_HEADS, V_DIM)
    k_all = jnp.concatenate([k_past.astype(k.dtype), k], axis=1)
    v_all = jnp.concatenate([v_past.astype(v.dtype), v], axis=1)
    lp = lam_vec.astype(jnp.float32)
    lam = jnp.exp(jnp.sum(lp[0] * lp[1])) - jnp.exp(jnp.sum(lp[2] * lp[3])) + lam_init
    k_pos = jnp.arange(P + T, dtype=jnp.int32)
    if T > Q_BLOCK and T % Q_BLOCK == 0:
        nb = T // Q_BLOCK
        q_blocks = jnp.moveaxis(q.reshape(B, nb, Q_BLOCK, N_HEADS, 2, HEAD_DIM), 1, 0)

        def attend_block(args):
            i, q_blk = args
            q_pos = P + i * Q_BLOCK + jnp.arange(Q_BLOCK, dtype=jnp.int32)
            return diff_attend(q_blk, k_all, v_all, rel_bias(q_pos, k_pos, rel_table),
                               chunk_mask(q_pos, k_pos), lam)

        o = lax.map(attend_block, (jnp.arange(nb, dtype=jnp.int32), q_blocks))
        o = jnp.moveaxis(o, 0, 1).reshape(B, T, N_HEADS, V_DIM)
    else:
        q_pos = P + jnp.arange(T, dtype=jnp.int32)
        o = diff_attend(q, k_all, v_all, rel_bias(q_pos, k_pos, rel_table),
                        chunk_mask(q_pos, k_pos), lam)
    o = (rmsnorm(o, g_sub) * (1.0 - lam_init)).reshape(B, T, ATTN_WIDTH)
    a, gate = jnp.split(zu, 2, axis=-1)
    c = a * jax.nn.sigmoid(gate)
    c_hist = jnp.concatenate([c_past.astype(c.dtype), c], axis=1)
    cv = jax.nn.silu(layernorm(depthwise_causal_conv(c_hist, w_conv, b_conv), ln_g, ln_b))
    x = x + jnp.concatenate([o, cv], axis=-1) @ w_out
    x = x + cross_attend(rmsnorm(x, g_cross), mk, mv, w_mq, g_mq, w_mo)
    hf = rmsnorm(x, g_ffn)
    x = x + jnp.square(jax.nn.relu(hf @ w_ff1)) @ w_ff2
    return x, k, v, c_hist[:, -(CONV_K - 1):]


def setup_inputs(seed: int = 0) -> dict:
    key = jax.random.key(seed)
    ks = jax.random.split(key, 40)

    def nrm(k, shape, scale):
        return jax.random.normal(k, shape, jnp.float32) * scale

    def gain(k, shape):
        return 1.0 + 0.05 * jax.random.normal(k, shape, jnp.float32)

    return {
        'x_prompt': nrm(ks[0], (BATCH, SEQ, D_MODEL), 1.0),
        'x_sample': nrm(ks[1], (DEC_BATCH, DEC_SEQ, D_MODEL), 1.0),
        'cache_k': nrm(ks[2], (DEPTH, DEC_BATCH, PAST_LEN, N_HEADS, 2, HEAD_DIM), 1.0),
        'cache_v': nrm(ks[3], (DEPTH, DEC_BATCH, PAST_LEN, N_HEADS, V_DIM), 1.0),
        'cache_conv': nrm(ks[4], (DEPTH, DEC_BATCH, CONV_K - 1, CONV_WIDTH), 0.5),
        'cache_mem_k': nrm(ks[5], (DEPTH, DEC_BATCH, N_MEM, MEM_HEADS, MEM_HEAD_DIM), 1.0),
        'cache_mem_v': nrm(ks[6], (DEPTH, DEC_BATCH, N_MEM, MEM_HEADS, MEM_HEAD_DIM), 1.0),
        'mem_prompt': nrm(ks[7], (BATCH, N_MEM, D_MODEL), 1.0),
        'rel_table': nrm(ks[8], (N_BUCKETS, N_HEADS), 0.5),
        'g_mix': gain(ks[9], (DEPTH, D_MODEL)),
        'w_in': nrm(ks[10], (DEPTH, D_MODEL, IN_COLS), D_MODEL ** -0.5),
        'g_q': gain(ks[11], (DEPTH, HEAD_DIM)),
        'g_k': gain(ks[12], (DEPTH, HEAD_DIM)),
        'lam_vec': nrm(ks[13], (DEPTH, 4, HEAD_DIM), 0.1),
        'g_sub': gain(ks[14], (DEPTH, V_DIM)),
        'w_conv': nrm(ks[15], (DEPTH, CONV_K, CONV_WIDTH), CONV_K ** -0.5),
        'b_conv': nrm(ks[16], (DEPTH, CONV_WIDTH), 0.02),
        'ln_g': gain(ks[17], (DEPTH, CONV_WIDTH)),
        'ln_b': nrm(ks[18], (DEPTH, CONV_WIDTH), 0.02),
        'w_out': nrm(ks[19], (DEPTH, MIX_WIDTH, D_MODEL), MIX_WIDTH ** -0.5),
        'g_cross': gain(ks[20], (DEPTH, D_MODEL)),
        'g_mem': gain(ks[21], (DEPTH, D_MODEL)),
        'w_mq': nrm(ks[22], (DEPTH, D_MODEL, MEM_WIDTH), D_MODEL ** -0.5),
        'w_mk': nrm(ks[23], (DEPTH, D_MODEL, MEM_WIDTH), D_MODEL ** -0.5),
        'w_mv': nrm(ks[24], (DEPTH, D_MODEL, MEM_WIDTH), D_MODEL ** -0.5),
        'g_mq': gain(ks[25], (DEPTH, MEM_HEAD_DIM)),
        'g_mk': gain(ks[26], (DEPTH, MEM_HEAD_DIM)),
        'w_mo': nrm(ks[27], (DEPTH, MEM_WIDTH, D_MODEL), MEM_WIDTH ** -0.5),
        'g_ffn': gain(ks[28], (DEPTH, D_MODEL)),
        'w_ff1': nrm(ks[29], (DEPTH, D_MODEL, D_FF), D_MODEL ** -0.5),
        'w_ff2': nrm(ks[30], (DEPTH, D_FF, D_MODEL), D_FF ** -0.5),
    }


def reference(x_prompt, x_sample, cache_k, cache_v, cache_conv, cache_mem_k, cache_mem_v,
              mem_prompt, rel_table, g_mix, w_in, g_q, g_k, lam_vec, g_sub, w_conv, b_conv,
              ln_g, ln_b, w_out, g_cross, g_mem, w_mq, w_mk, w_mv, g_mq, g_mk, w_mo,
              g_ffn, w_ff1, w_ff2):
    B = x_prompt.shape[0]
    yp, ys = x_prompt, x_sample
    empty_k = jnp.zeros((B, 0, N_HEADS, 2, HEAD_DIM), x_prompt.dtype)
    empty_v = jnp.zeros((B, 0, N_HEADS, V_DIM), x_prompt.dtype)
    zero_conv = jnp.zeros((B, CONV_K - 1, CONV_WIDTH), x_prompt.dtype)
    kp_l, vp_l, cp_l, mkp_l, mvp_l, ks_l, vs_l, cs_l = [], [], [], [], [], [], [], []
    for l in range(DEPTH):
        lam_init = 0.8 - 0.6 * math.exp(-0.3 * l)
        lw = (rel_table, g_mix[l], w_in[l], g_q[l], g_k[l], lam_vec[l], g_sub[l], w_conv[l],
              b_conv[l], ln_g[l], ln_b[l], w_out[l], g_cross[l], w_mq[l], g_mq[l], w_mo[l],
              g_ffn[l], w_ff1[l], w_ff2[l])
        mk_p, mv_p = memory_kv(mem_prompt, g_mem[l], w_mk[l], w_mv[l], g_mk[l])
        yp, kp, vp, cp = trunk_layer(yp, empty_k, empty_v, zero_conv, mk_p, mv_p, *lw, lam_init)
        ys, kn, vn, cn = trunk_layer(ys, cache_k[l], cache_v[l], cache_conv[l],
                                     cache_mem_k[l], cache_mem_v[l], *lw, lam_init)
        kp_l.append(kp); vp_l.append(vp); cp_l.append(cp)
        mkp_l.append(mk_p); mvp_l.append(mv_p)
        ks_l.append(kn); vs_l.append(vn); cs_l.append(cn)
    return (yp, ys, jnp.stack(kp_l), jnp.stack(vp_l), jnp.stack(cp_l), jnp.stack(mkp_l),
            jnp.stack(mvp_l), jnp.stack(ks_l), jnp.stack(vs_l), jnp.stack(cs_l))
```

```cpp
#include <hip/hip_runtime.h>
#include <hip/hip_cooperative_groups.h>
#include <cstdio>
#include <cstdint>
namespace pg8 {
#define PG8_LAS __attribute__((address_space(3)))
typedef unsigned short bf16_t;
typedef short bf16x8 __attribute__((ext_vector_type(8)));
typedef float f32x4 __attribute__((ext_vector_type(4)));
typedef unsigned u32x4 __attribute__((ext_vector_type(4)));
constexpr int BM = 256, BK = 64, HALF = 128, HTB = HALF * BK * 2  , STAGE_BYTES = 8 * HTB, NXCD = 8, WGM = 8;

__host__ __device__ __forceinline__ int lds_byte(int r, int c) { const int st = (r >> 4) * 2 + (c >> 5), rr = r & 15, cc = c & 31, ob = rr * 64 + cc * 2; return st * 1024 + (ob ^ (((ob >> 9) & 1) << 5)); }
__host__ __device__ __forceinline__ void stage_rc(int b, int& R, int& C) { const int st = b / 1024, sb = b % 1024, swz = sb ^ (((sb >> 9) & 1) << 5); R = (st >> 1) * 16 + swz / 64; C = (st & 1) * 32 + (swz % 64) / 2; }
__host__ __device__ __forceinline__ int perm32(int rho) { const int n = rho >> 4, i = rho & 15; return 8 * (i >> 2) + 4 * n + (i & 3); }

struct Unit { int pm, pn; };
struct Gemm { const bf16_t* A; const bf16_t* Bt; int M, N, K; };

struct StaticOrder {
    int nM, nN, nwg, G, c;
    __host__ __device__ void init(int M, int N, int G_, int c_) { nM = M / BM; nN = N / BM; nwg = nM * nN; G = G_; c = c_; }
    __host__ __device__ bool next(int i, Unit& u) const {
        const long L = (long)i * G + c; if (L >= nwg) return false;
        int wgid = (int)L; { const int q = nwg / NXCD, r = nwg % NXCD, xcd = wgid % NXCD, off = wgid / NXCD; wgid = (xcd < r ? xcd * (q + 1) : r * (q + 1) + (xcd - r) * q) + off; }
        const int nig = WGM * nN, gid = wgid / nig, fm = gid * WGM, gsz = (nM - fm) < WGM ? (nM - fm) : WGM;
        u.pm = fm + ((wgid % nig) % gsz); u.pn = (wgid % nig) / gsz; return true;
    }
    __device__ __forceinline__ void a_ready(const Unit&) const {}
    __device__ __forceinline__ void done(const Unit&) const {}
};

__device__ __forceinline__ unsigned cvt_pk_bf16(float lo, float hi) { unsigned r; asm volatile("v_cvt_pk_bf16_f32 %0, %1, %2" : "=v"(r) : "v"(lo), "v"(hi)); return r; }
typedef float f32x2 __attribute__((ext_vector_type(2)));

constexpr int MP = 32768;
constexpr float EPSN = 1e-6f;
constexpr float QC2 = 0.125f * 1.4426950408889634f;
__device__ __forceinline__ void st_bf16x8(bf16_t* p, const f32x4 a, const f32x4 b) { u32x4 w; w.x = cvt_pk_bf16(a[0], a[1]); w.y = cvt_pk_bf16(a[2], a[3]); w.z = cvt_pk_bf16(b[0], b[1]); w.w = cvt_pk_bf16(b[2], b[3]); *(u32x4*)p = w; }
__device__ __forceinline__ float dot4(const f32x4 a) { return (a[0] * a[0] + a[1] * a[1]) + (a[2] * a[2] + a[3] * a[3]); }

struct EpiG1 {
    static constexpr bool PERM = true, AFTER_DRAIN = false;
    const float* rs; const float* gq; const float* gk;
    bf16_t* Q; bf16_t* KB; bf16_t* VB; float* C;
    float* kp; float* ks; float* vp; float* vs;
    __device__ __forceinline__ void operator()(const f32x4 (&acc)[2][2][4][2], const Unit& u, int wr, int wc, int fr, int fq) const {
        const int pn = u.pn;
#pragma unroll
        for (int ai = 0; ai < 2; ++ai)
#pragma unroll
            for (int m = 0; m < 4; ++m) {
                const int r = u.pm * BM + ai * HALF + wr * 64 + m * 16 + fr;
                const float rsv = rs[r];
                if (pn < 4) {
                    f32x4 v[2][2]; float ss = 0.f;
#pragma unroll
                    for (int bj = 0; bj < 2; ++bj)
#pragma unroll
                        for (int n = 0; n < 2; ++n) { v[bj][n] = acc[ai][bj][m][n] * rsv; ss += dot4(v[bj][n]); }
                    ss += __shfl_xor(ss, 16); ss += __shfl_xor(ss, 32);
                    const float rstd = 1.0f / sqrtf(ss * (1.0f / 64.0f) + EPSN);
                    const float* g = pn < 2 ? gq : gk; const float sc = pn < 2 ? rstd * QC2 : rstd;
                    const int grp = 4 * (pn & 1) + wc;
#pragma unroll
                    for (int bj = 0; bj < 2; ++bj) {
                        const int d0 = 32 * bj + 8 * fq; const f32x4 g0 = *(const f32x4*)(g + d0), g1 = *(const f32x4*)(g + d0 + 4);
                        const f32x4 o0 = v[bj][0] * g0 * sc, o1 = v[bj][1] * g1 * sc; const int col = 64 * grp + d0;
                        if (pn < 2) st_bf16x8(Q + (size_t)r * 512 + col, o0, o1);
                        else { float* ko = (r < MP ? kp + (size_t)r * 512 : ks + (size_t)(r - MP) * 512) + col; *(f32x4*)ko = o0; *(f32x4*)(ko + 4) = o1; st_bf16x8(KB + (size_t)r * 512 + col, o0, o1); }
                    }
                } else if (pn < 6) {
#pragma unroll
                    for (int bj = 0; bj < 2; ++bj) {
                        const int col = 256 * (pn - 4) + 128 * bj + 32 * wc + 8 * fq; const f32x4 o0 = acc[ai][bj][m][0] * rsv, o1 = acc[ai][bj][m][1] * rsv;
                        float* vo = (r < MP ? vp + (size_t)r * 512 : vs + (size_t)(r - MP) * 512) + col; *(f32x4*)vo = o0; *(f32x4*)(vo + 4) = o1; st_bf16x8(VB + (size_t)r * 512 + col, o0, o1);
                    }
                } else {
                    const int ch = 128 * (pn - 6) + 32 * wc + 8 * fq;
#pragma unroll
                    for (int n = 0; n < 2; ++n) { const f32x4 a = acc[ai][0][m][n] * rsv, gt = acc[ai][1][m][n] * rsv; f32x4 c;
#pragma unroll
                        for (int e = 0; e < 4; ++e) c[e] = a[e] / (1.0f + __expf(-gt[e]));
                        *(f32x4*)(C + (size_t)r * 512 + ch + 4 * n) = c; }
                }
            }
    }
};
struct EpiMem {
    static constexpr bool PERM = true, AFTER_DRAIN = false;
    const float* rs; float* mk; float* mv;
    __device__ __forceinline__ void operator()(const f32x4 (&acc)[2][2][4][2], const Unit& u, int wr, int wc, int fr, int fq) const {
        float* base = u.pn < 2 ? mk : mv; const int cb = 256 * (u.pn & 1);
#pragma unroll
        for (int ai = 0; ai < 2; ++ai)
#pragma unroll
            for (int m = 0; m < 4; ++m) { const int r = u.pm * BM + ai * HALF + wr * 64 + m * 16 + fr; const float rsv = rs[r];
#pragma unroll
                for (int bj = 0; bj < 2; ++bj) { float* o = base + (size_t)r * 512 + cb + 128 * bj + 32 * wc + 8 * fq; *(f32x4*)o = acc[ai][bj][m][0] * rsv; *(f32x4*)(o + 4) = acc[ai][bj][m][1] * rsv; } }
    }
};
struct EpiRes {
    static constexpr bool PERM = true, AFTER_DRAIN = false;
    const float* res_p; const float* res_s; float* xo; bf16_t* xb; float* ssp;
    __device__ __forceinline__ void operator()(const f32x4 (&acc)[2][2][4][2], const Unit& u, int wr, int wc, int fr, int fq) const {
#pragma unroll
        for (int ai = 0; ai < 2; ++ai)
#pragma unroll
            for (int m = 0; m < 4; ++m) { const int r = u.pm * BM + ai * HALF + wr * 64 + m * 16 + fr;
                const float* rr = r < MP ? res_p + (size_t)r * 1024 : res_s + (size_t)(r - MP) * 1024; float ss = 0.f;
#pragma unroll
                for (int bj = 0; bj < 2; ++bj) { const int col = 256 * u.pn + 128 * bj + 32 * wc + 8 * fq;
                    const f32x4 x0 = *(const f32x4*)(rr + col) + acc[ai][bj][m][0], x1 = *(const f32x4*)(rr + col + 4) + acc[ai][bj][m][1];
                    *(f32x4*)(xo + (size_t)r * 1024 + col) = x0; *(f32x4*)(xo + (size_t)r * 1024 + col + 4) = x1; st_bf16x8(xb + (size_t)r * 1024 + col, x0, x1); ss += dot4(x0) + dot4(x1); }
                ss += __shfl_xor(ss, 16); ss += __shfl_xor(ss, 32);
                if (fq == 0) ssp[(size_t)r * 16 + 4 * u.pn + wc] = ss; }
    }
};
__device__ __forceinline__ float row_rs(const float* ssp, int r) { const f32x4 a = *(const f32x4*)(ssp + (size_t)r * 16), b = *(const f32x4*)(ssp + (size_t)r * 16 + 4), c = *(const f32x4*)(ssp + (size_t)r * 16 + 8), d = *(const f32x4*)(ssp + (size_t)r * 16 + 12);
    const float s = ((a[0] + a[1]) + (a[2] + a[3])) + ((b[0] + b[1]) + (b[2] + b[3])) + ((c[0] + c[1]) + (c[2] + c[3])) + ((d[0] + d[1]) + (d[2] + d[3])); return 1.0f / sqrtf(s * (1.0f / 1024.0f) + EPSN); }
template <int ACT> struct EpiScaleBf16 {
    static constexpr bool PERM = true, AFTER_DRAIN = false;
    const float* ssp; bf16_t* O; int ldc;
    __device__ __forceinline__ void operator()(const f32x4 (&acc)[2][2][4][2], const Unit& u, int wr, int wc, int fr, int fq) const {
#pragma unroll
        for (int ai = 0; ai < 2; ++ai)
#pragma unroll
            for (int m = 0; m < 4; ++m) { const int r = u.pm * BM + ai * HALF + wr * 64 + m * 16 + fr; const float rsv = row_rs(ssp, r);
#pragma unroll
                for (int bj = 0; bj < 2; ++bj) { const int col = 256 * u.pn + 128 * bj + 32 * wc + 8 * fq; f32x4 o0 = acc[ai][bj][m][0] * rsv, o1 = acc[ai][bj][m][1] * rsv;
                    if (ACT == 1) {
#pragma unroll
                        for (int e = 0; e < 4; ++e) { const float a = fmaxf(o0[e], 0.f), b = fmaxf(o1[e], 0.f); o0[e] = a * a; o1[e] = b * b; } }
                    st_bf16x8(O + (size_t)r * ldc + col, o0, o1); } }
    }
};
struct EpiOut {
    static constexpr bool PERM = true, AFTER_DRAIN = false;
    const float* res; float* yp; float* ys;
    __device__ __forceinline__ void operator()(const f32x4 (&acc)[2][2][4][2], const Unit& u, int wr, int wc, int fr, int fq) const {
#pragma unroll
        for (int ai = 0; ai < 2; ++ai)
#pragma unroll
            for (int m = 0; m < 4; ++m) { const int r = u.pm * BM + ai * HALF + wr * 64 + m * 16 + fr;
                const float* rr = res + (size_t)r * 1024; float* yo = r < MP ? yp + (size_t)r * 1024 : ys + (size_t)(r - MP) * 1024;
#pragma unroll
                for (int bj = 0; bj < 2; ++bj) { const int col = 256 * u.pn + 128 * bj + 32 * wc + 8 * fq;
                    *(f32x4*)(yo + col) = *(const f32x4*)(rr + col) + acc[ai][bj][m][0]; *(f32x4*)(yo + col + 4) = *(const f32x4*)(rr + col + 4) + acc[ai][bj][m][1]; } }
    }
};
template <class Epi, class Sched, bool ALIGN_EPI = false, bool SP2 = false>
__device__ __forceinline__ void gemm_phase(PG8_LAS unsigned char* lds, const Gemm g, const Sched& S, const Epi& E) {
    const int tid = threadIdx.x, wid = __builtin_amdgcn_readfirstlane(tid >> 6), lane = tid & 63, wr = wid >> 2, wc = wid & 3, fr = lane & 15, fq = lane >> 4;
    const int K = g.K, nt = K / BK;
    unsigned voffA[2], voffB[2];
#pragma unroll
    for (int i = 0; i < 2; ++i) { int R, C; stage_rc(tid * 16 + i * 8192, R, C); const int Rb = Epi::PERM ? ((R & ~31) + perm32(R & 31)) : R;
        voffA[i] = (unsigned)(R * K + C) * 2u; voffB[i] = (unsigned)(Rb * K + C) * 2u; }
    const size_t kstep = (size_t)(BK * 2);
    const size_t hstep = (size_t)HALF * K * 2;
    const size_t tstep = 2 * hstep;
    const unsigned ldsw = (unsigned)wid * 1024u;
    const int aoff = lds_byte(wr * 64 + fr, fq * 8), boff = lds_byte(wc * 32 + fr, fq * 8);
#define PG8_SA(b, h) (((b) * 2 + (h)) * HTB)
#define PG8_SB(b, h) ((4 + (b) * 2 + (h)) * HTB)
#define PG8_STAGE(bufoff, gbase, voff) do { _Pragma("unroll") for (int _i = 0; _i < 2; ++_i) \
        __builtin_amdgcn_global_load_lds((const unsigned*)((const char*)(gbase) + (voff)[_i]), (PG8_LAS unsigned*)(lds + (bufoff) + ldsw + _i * 8192), 16, 0, 0); } while (0)
#define PG8_LDA(dst, b, h) do { _Pragma("unroll") for (int m = 0; m < 4; ++m) _Pragma("unroll") for (int k = 0; k < 2; ++k) dst[m][k] = *(const PG8_LAS bf16x8*)(lds + PG8_SA(b, h) + aoff + m * 2048 + k * 1024); } while (0)
#define PG8_LDB(dst, b, h) do { _Pragma("unroll") for (int n = 0; n < 2; ++n) _Pragma("unroll") for (int k = 0; k < 2; ++k) dst[n][k] = *(const PG8_LAS bf16x8*)(lds + PG8_SB(b, h) + boff + n * 2048 + k * 1024); } while (0)
#define PG8_MMA(ai, bj, At, Bt) do { __builtin_amdgcn_s_setprio(1); _Pragma("unroll") for (int m = 0; m < 4; ++m) _Pragma("unroll") for (int n = 0; n < 2; ++n) _Pragma("unroll") for (int k = 0; k < 2; ++k) \
        acc[ai][bj][m][n] = __builtin_amdgcn_mfma_f32_16x16x32_bf16(Bt[n][k], At[m][k], acc[ai][bj][m][n], 0, 0, 0); __builtin_amdgcn_s_setprio(0); } while (0)
#define PG8_WAIT_V(n) asm volatile("s_waitcnt vmcnt(" #n ")" ::: "memory")
#define PG8_WAIT_L(n) asm volatile("s_waitcnt lgkmcnt(" #n ")" ::: "memory")
#define PG8_BAR __builtin_amdgcn_s_barrier()
#define PG8_SCHED __builtin_amdgcn_sched_barrier(0)
    Unit cur, nxt; int ui = 0;
    if (!S.next(0, cur)) return;
    f32x4 acc[2][2][4][2];
#pragma unroll
    for (int a = 0; a < 2; ++a)
#pragma unroll
        for (int b = 0; b < 2; ++b)
#pragma unroll
            for (int m = 0; m < 4; ++m)
#pragma unroll
                for (int n = 0; n < 2; ++n) acc[a][b][m][n] = (f32x4){0.f, 0.f, 0.f, 0.f};
    bf16x8 At[4][2], B0[2][2], B1[2][2];
    const char* cA = (const char*)g.A + (size_t)cur.pm * tstep; const char* cB = (const char*)g.Bt + (size_t)cur.pn * tstep;
    S.a_ready(cur);
    if constexpr (SP2) {
        PG8_STAGE(PG8_SB(0, 0), cB, voffB); PG8_STAGE(PG8_SB(0, 1), cB + hstep, voffB); PG8_STAGE(PG8_SA(0, 0), cA, voffA); PG8_STAGE(PG8_SA(0, 1), cA + hstep, voffA);
        if (wr == 1) PG8_BAR;
        PG8_WAIT_V(2); PG8_BAR;
        PG8_STAGE(PG8_SB(1, 0), cB + kstep, voffB); PG8_STAGE(PG8_SA(1, 0), cA + kstep, voffA); PG8_STAGE(PG8_SB(1, 1), cB + hstep + kstep, voffB);
        PG8_WAIT_V(6); PG8_BAR;
    } else {
        PG8_STAGE(PG8_SB(0, 0), cB, voffB); PG8_STAGE(PG8_SA(0, 0), cA, voffA); PG8_STAGE(PG8_SB(0, 1), cB + hstep, voffB); PG8_STAGE(PG8_SA(0, 1), cA + hstep, voffA);
        if (wr == 1) PG8_BAR;
        PG8_WAIT_V(4); PG8_BAR;
        PG8_STAGE(PG8_SB(1, 0), cB + kstep, voffB); PG8_STAGE(PG8_SA(1, 0), cA + kstep, voffA); PG8_STAGE(PG8_SB(1, 1), cB + hstep + kstep, voffB);
        PG8_WAIT_V(6); PG8_BAR;
    }
    for (;;) {
        const bool has_next = S.next(ui + 1, nxt);
        const char* nA = has_next ? (const char*)g.A + (size_t)nxt.pm * tstep : cA; const char* nB = has_next ? (const char*)g.Bt + (size_t)nxt.pn * tstep : cB;
        for (int t = 0; t < nt; t += 2) {
            const bool last = (t == nt - 2);
            const char* a1 = cA + (size_t)(t + 1) * kstep;
            const char* a2 = last ? nA : cA + (size_t)(t + 2) * kstep; const char* b2 = last ? nB : cB + (size_t)(t + 2) * kstep;
            const char* a3 = a2 + kstep; const char* b3 = b2 + kstep;
            if (last && has_next) S.a_ready(nxt);
            if constexpr (SP2) {
            PG8_LDB(B0, 0, 0); PG8_LDB(B1, 0, 1); PG8_SCHED; PG8_LDA(At, 0, 0); PG8_STAGE(PG8_SA(1, 1), a1 + hstep, voffA);
            PG8_WAIT_V(8); PG8_WAIT_L(0); PG8_BAR; PG8_MMA(0, 0, At, B0); PG8_MMA(0, 1, At, B1); PG8_BAR; PG8_SCHED;
            PG8_LDA(At, 0, 1); PG8_STAGE(PG8_SB(0, 0), b2, voffB); PG8_STAGE(PG8_SB(0, 1), b2 + hstep, voffB); PG8_STAGE(PG8_SA(0, 0), a2, voffA);
            PG8_WAIT_V(8); PG8_WAIT_L(0); PG8_BAR; PG8_MMA(1, 0, At, B0); PG8_MMA(1, 1, At, B1); PG8_BAR; PG8_SCHED;
            PG8_LDB(B0, 1, 0); PG8_LDB(B1, 1, 1); PG8_SCHED; PG8_LDA(At, 1, 0); PG8_STAGE(PG8_SA(0, 1), a2 + hstep, voffA);
            PG8_WAIT_V(8); PG8_WAIT_L(0); PG8_BAR; PG8_MMA(0, 0, At, B0); PG8_MMA(0, 1, At, B1); PG8_BAR; PG8_SCHED;
            PG8_LDA(At, 1, 1); PG8_STAGE(PG8_SB(1, 0), b3, voffB); PG8_STAGE(PG8_SB(1, 1), b3 + hstep, voffB); PG8_STAGE(PG8_SA(1, 0), a3, voffA);
            PG8_WAIT_V(8); PG8_WAIT_L(0); PG8_BAR; PG8_MMA(1, 0, At, B0); PG8_MMA(1, 1, At, B1); PG8_BAR; PG8_SCHED;
            } else {
            PG8_LDB(B0, 0, 0); PG8_SCHED; PG8_LDA(At, 0, 0); PG8_STAGE(PG8_SA(1, 1), a1 + hstep, voffA);
            PG8_WAIT_L(8); PG8_BAR; PG8_WAIT_L(0); PG8_MMA(0, 0, At, B0); PG8_BAR; PG8_SCHED;
            PG8_LDB(B1, 0, 1); PG8_STAGE(PG8_SB(0, 0), b2, voffB);
            PG8_BAR; PG8_WAIT_L(0); PG8_MMA(0, 1, At, B1); PG8_BAR;
            PG8_LDA(At, 0, 1); PG8_STAGE(PG8_SA(0, 0), a2, voffA);
            PG8_BAR; PG8_WAIT_L(0); PG8_MMA(1, 0, At, B0); PG8_BAR; PG8_SCHED;
            PG8_STAGE(PG8_SB(0, 1), b2 + hstep, voffB);
            PG8_WAIT_V(6); PG8_BAR; PG8_MMA(1, 1, At, B1); PG8_BAR;
            PG8_LDB(B0, 1, 0); PG8_SCHED; PG8_LDA(At, 1, 0); PG8_STAGE(PG8_SA(0, 1), a2 + hstep, voffA);
            PG8_WAIT_L(8); PG8_BAR; PG8_WAIT_L(0); PG8_MMA(0, 0, At, B0); PG8_BAR; PG8_SCHED;
            PG8_LDB(B1, 1, 1); PG8_STAGE(PG8_SB(1, 0), b3, voffB);
            PG8_BAR; PG8_WAIT_L(0); PG8_MMA(0, 1, At, B1); PG8_BAR;
            PG8_LDA(At, 1, 1); PG8_STAGE(PG8_SA(1, 0), a3, voffA);
            PG8_BAR; PG8_WAIT_L(0); PG8_MMA(1, 0, At, B0); PG8_BAR; PG8_SCHED;
            PG8_STAGE(PG8_SB(1, 1), b3 + hstep, voffB);
            PG8_WAIT_V(6); PG8_BAR; PG8_MMA(1, 1, At, B1); PG8_BAR;
            }
        }
        if constexpr (ALIGN_EPI) { if (wr == 0) PG8_BAR; }
        if constexpr (!Epi::AFTER_DRAIN) { E(acc, cur, wr, wc, fr, fq); S.done(cur); }
        if (!has_next) break;
#pragma unroll
        for (int a = 0; a < 2; ++a)
#pragma unroll
            for (int b = 0; b < 2; ++b)
#pragma unroll
                for (int m = 0; m < 4; ++m)
#pragma unroll
                    for (int n = 0; n < 2; ++n) acc[a][b][m][n] = (f32x4){0.f, 0.f, 0.f, 0.f};
        cur = nxt; cA = nA; cB = nB; ++ui;
        if constexpr (ALIGN_EPI) { if (wr == 1) PG8_BAR; }
    }
    PG8_WAIT_V(0);
    if constexpr (!ALIGN_EPI) { if (wr == 0) PG8_BAR; }
    PG8_BAR;
    if constexpr (Epi::AFTER_DRAIN) { E.fused(acc, cur, wr, wc, fr, fq, lds, wid, lane); S.done(cur); }
#undef PG8_SA
#undef PG8_SB
#undef PG8_STAGE
#undef PG8_LDA
#undef PG8_LDB
#undef PG8_MMA
#undef PG8_WAIT_V
#undef PG8_WAIT_L
#undef PG8_BAR
#undef PG8_SCHED
}
}

namespace cg = cooperative_groups;
constexpr int NWAVES = 8, NTHREADS = 512;
constexpr int MTOT = 33280, MPR = 32768, MSA = 512;
constexpr int DM = 1024, TP = 4096, TS = 16, NBP = 8, NBS = 32, PAST = 4096;
constexpr float EPS = 1e-6f, LOG2E = 1.4426950408889634f;
constexpr float LAM_INIT = 0.2f;
constexpr size_t O_YP = 0, O_YS = 33554432, O_KP = 34078720, O_VP = 50855936, O_CP = 67633152, O_MK = 67756032, O_MV = 68804608, O_KS = 69853184, O_VS = 70115328, O_CS = 70377472, O_END = 70868992;
constexpr size_t MiB = 1u << 20;
constexpr size_t WS_RS0 = 1 * MiB, WS_RSM = 1 * MiB + 256 * 1024, WS_SSP1 = 2 * MiB, WS_SSP2 = 5 * MiB, WS_QSS = 8 * MiB;
constexpr size_t WS_W1T = 12 * MiB, WS_WOT = 17 * MiB, WS_WMQT = 19 * MiB, WS_WMKVT = 20 * MiB, WS_WMOT = 22 * MiB, WS_WF1T = 23 * MiB, WS_WF2T = 31 * MiB;
constexpr size_t WS_MEMB = 40 * MiB, WS_MKB = 44 * MiB, WS_MVB = 54 * MiB;
constexpr size_t WS_XB = 64 * MiB, WS_Q = 130 * MiB, WS_KB = 163 * MiB, WS_VB = 196 * MiB, WS_C = 229 * MiB, WS_A3 = 294 * MiB, WS_OA = 360 * MiB;
constexpr size_t WS_X1 = 490 * MiB, WS_X1B = 620 * MiB, WS_QM = 685 * MiB, WS_OM = 718 * MiB, WS_X2B = 751 * MiB, WS_END = 816 * MiB;
constexpr size_t WS_U = 64 * MiB;
static_assert(WS_U + (size_t)MTOT * 4096 * 2 <= WS_OA, "U overlay");
#ifndef PHMASK
#define PHMASK 0xFFFFF
#endif
#define PH(k) ((PHMASK >> (k)) & 1)
constexpr int LDS_BYTES = 147456;

#define LAS __attribute__((address_space(3)))
typedef unsigned short bf16;
typedef unsigned v4u __attribute__((ext_vector_type(4)));
typedef unsigned v2u __attribute__((ext_vector_type(2)));
typedef float f32x4 __attribute__((ext_vector_type(4)));
__device__ __forceinline__ unsigned f2bf(float f) { unsigned u = __builtin_bit_cast(unsigned, f); return (u + 0x7fffu + ((u >> 16) & 1u)) >> 16; }
__device__ __forceinline__ unsigned pk2(float lo, float hi) { return f2bf(lo) | (f2bf(hi) << 16); }
__device__ __forceinline__ float bf2f(unsigned h) { return __builtin_bit_cast(float, h << 16); }
__device__ __forceinline__ float wave_sum(float v) {
#pragma unroll
    for (int o = 1; o < 64; o <<= 1) v += __shfl_xor(v, o);
    return v;
}
__device__ __forceinline__ void unpack8(const v4u w, float* f) { f[0] = bf2f(w.x & 0xffffu); f[1] = bf2f(w.x >> 16); f[2] = bf2f(w.y & 0xffffu); f[3] = bf2f(w.y >> 16); f[4] = bf2f(w.z & 0xffffu); f[5] = bf2f(w.z >> 16); f[6] = bf2f(w.w & 0xffffu); f[7] = bf2f(w.w >> 16); }

struct Params { const float* in[31]; float* out; unsigned char* ws; };
enum { I_XP = 0, I_XS, I_CK, I_CV, I_CC, I_CMK, I_CMV, I_MEM, I_REL, I_GMIX, I_WIN, I_GQ, I_GK, I_LAM, I_GSUB, I_WCONV, I_BCONV, I_LNG, I_LNB, I_WOUT, I_GCROSS, I_GMEM, I_WMQ, I_WMK, I_WMV, I_GMQ, I_GMK, I_WMO, I_GFFN, I_WFF1, I_WFF2 };

__device__ __forceinline__ int rel_bucket(int rel) {
    const int n = rel < 0 ? -rel : rel; const int lg = n < 8 ? n : min(15, 2 + (31 - __clz(n * n)));
    return (rel > 0 ? 16 : 0) + lg;
}
#define RDL(x, d) __builtin_bit_cast(float, __builtin_amdgcn_readlane(__builtin_bit_cast(int, (x)), (d)))
__device__ __forceinline__ float compute_lam(const float* lv, int lane) {
    const float a = wave_sum(lv[lane] * lv[64 + lane]), b = wave_sum(lv[128 + lane] * lv[192 + lane]);
    return __expf(a) - __expf(b) + LAM_INIT;
}

__device__ __forceinline__ void p0_transpose_item(const float* W, int K, int N, const float* gain, bf16* WT, int dst_row0, LAS float* scr, int k0, int n0, int lane) {
#pragma unroll 8
    for (int i = 0; i < 32; ++i) { const int kk = 2 * i + (lane >> 5); const float g = gain ? gain[k0 + kk] : 1.0f; scr[kk * 33 + (lane & 31)] = W[(size_t)(k0 + kk) * N + n0 + (lane & 31)] * g; }
    asm volatile("s_waitcnt lgkmcnt(0)" ::: "memory");
    const int c = lane & 7;
#pragma unroll
    for (int j = 0; j < 4; ++j) { const int n = (lane >> 3) + 8 * j; const LAS float* s = scr + (8 * c) * 33 + n;
        v4u o; o.x = pk2(s[0 * 33], s[1 * 33]); o.y = pk2(s[2 * 33], s[3 * 33]); o.z = pk2(s[4 * 33], s[5 * 33]); o.w = pk2(s[6 * 33], s[7 * 33]);
        *(v4u*)(WT + (size_t)(dst_row0 + n) * K + k0 + 8 * c) = o; }
    asm volatile("s_waitcnt lgkmcnt(0)" ::: "memory");
}
__device__ __forceinline__ int w1_row(int a) {
    if (a < 1024) { const int pn = a >> 8, wc = (a >> 6) & 3, bj = (a >> 5) & 1; return 256 * pn + 128 * bj + 32 * wc; }
    if (a < 1536) return a;
    const int g = a >= 2048, ch = a - (g ? 2048 : 1536), t = ch >> 7, wc = (ch >> 5) & 3; return 1536 + 256 * t + 128 * g + 32 * wc;
}
__device__ __forceinline__ void row_to_bf16_rs(const float* xrow, bf16* orow, float* rs_out, int lane) {
    const f32x4* xr = (const f32x4*)xrow + lane; f32x4 v[4]; float s = 0.f;
#pragma unroll
    for (int j = 0; j < 4; ++j) { v[j] = xr[64 * j]; s += (v[j].x * v[j].x + v[j].y * v[j].y) + (v[j].z * v[j].z + v[j].w * v[j].w); }
    s = wave_sum(s);
    unsigned long long* o8 = (unsigned long long*)orow + lane;
#pragma unroll
    for (int j = 0; j < 4; ++j) o8[64 * j] = (unsigned long long)pk2(v[j].x, v[j].y) | ((unsigned long long)pk2(v[j].z, v[j].w) << 32);
    if (lane == 0) *rs_out = 1.0f / sqrtf(s * (1.0f / 1024.0f) + EPS);
}

__global__ void __launch_bounds__(NTHREADS, 2) fwd_kernel(Params p) {
    extern __shared__ __attribute__((aligned(16))) unsigned char lds_raw[];
    LAS unsigned char* lds = (LAS unsigned char*)lds_raw;
    cg::grid_group grid = cg::this_grid();
    const int tid = threadIdx.x, lane = tid & 63, wave = __builtin_amdgcn_readfirstlane(tid >> 6);
    const int G = gridDim.x, gw = blockIdx.x * NWAVES + wave, NGW = G * NWAVES;
    unsigned char* ws = p.ws; float* out = p.out;
    float* RS0 = (float*)(ws + WS_RS0); float* RSM = (float*)(ws + WS_RSM); float* SSP1 = (float*)(ws + WS_SSP1); float* SSP2 = (float*)(ws + WS_SSP2);
    bf16* W1T = (bf16*)(ws + WS_W1T); bf16* WOT = (bf16*)(ws + WS_WOT); bf16* WMQT = (bf16*)(ws + WS_WMQT); bf16* WMKVT = (bf16*)(ws + WS_WMKVT); bf16* WMOT = (bf16*)(ws + WS_WMOT);
    bf16* WF1T = (bf16*)(ws + WS_WF1T); bf16* WF2T = (bf16*)(ws + WS_WF2T); bf16* MEMB = (bf16*)(ws + WS_MEMB);
    bf16* XB = (bf16*)(ws + WS_XB); bf16* QB = (bf16*)(ws + WS_Q); bf16* KB = (bf16*)(ws + WS_KB); bf16* VB = (bf16*)(ws + WS_VB); float* CB = (float*)(ws + WS_C);
    bf16* A3 = (bf16*)(ws + WS_A3); float* OA = (float*)(ws + WS_OA); float* X1 = (float*)(ws + WS_X1); bf16* X1B = (bf16*)(ws + WS_X1B); bf16* QM = (bf16*)(ws + WS_QM); bf16* OM = (bf16*)(ws + WS_OM);
    bf16* X2B = (bf16*)(ws + WS_X2B); bf16* UB = (bf16*)(ws + WS_U);

    if constexpr (PH(0)) {
        LAS float* scr = (LAS float*)(lds + wave * 16384);
        constexpr int I1 = 16 * 80, I2 = 16 * 32, I3 = 16 * 16, I6 = 8 * 32, I7 = 16 * 128, I8 = 64 * 32;
        constexpr int NITEMS = I1 + I2 + 3 * I3 + I6 + I7 + I8;
        for (int it = gw; it < NITEMS; it += NGW) {
            int r = it;
            if (r < I1) { const int kb = r / 80, nb = r % 80; p0_transpose_item(p.in[I_WIN], 1024, 2560, p.in[I_GMIX], W1T, w1_row(32 * nb), scr, 64 * kb, 32 * nb, lane); continue; } r -= I1;
            if (r < I2) { const int kb = r / 32, nb = r % 32; p0_transpose_item(p.in[I_WOUT], 1024, 1024, nullptr, WOT, 32 * nb, scr, 64 * kb, 32 * nb, lane); continue; } r -= I2;
            if (r < I3) { const int kb = r / 16, nb = r % 16; p0_transpose_item(p.in[I_WMQ], 1024, 512, p.in[I_GCROSS], WMQT, 32 * nb, scr, 64 * kb, 32 * nb, lane); continue; } r -= I3;
            if (r < I3) { const int kb = r / 16, nb = r % 16; p0_transpose_item(p.in[I_WMK], 1024, 512, p.in[I_GMEM], WMKVT, 32 * nb, scr, 64 * kb, 32 * nb, lane); continue; } r -= I3;
            if (r < I3) { const int kb = r / 16, nb = r % 16; p0_transpose_item(p.in[I_WMV], 1024, 512, p.in[I_GMEM], WMKVT, 512 + 32 * nb, scr, 64 * kb, 32 * nb, lane); continue; } r -= I3;
            if (r < I6) { const int kb = r / 32, nb = r % 32; p0_transpose_item(p.in[I_WMO], 512, 1024, nullptr, WMOT, 32 * nb, scr, 64 * kb, 32 * nb, lane); continue; } r -= I6;
            if (r < I7) { const int kb = r / 128, nb = r % 128; p0_transpose_item(p.in[I_WFF1], 1024, 4096, p.in[I_GFFN], WF1T, 32 * nb, scr, 64 * kb, 32 * nb, lane); continue; } r -= I7;
            { const int kb = r / 32, nb = r % 32; p0_transpose_item(p.in[I_WFF2], 4096, 1024, nullptr, WF2T, 32 * nb, scr, 64 * kb, 32 * nb, lane); }
        }
        for (int m = gw; m < MTOT + 2048; m += NGW) {
            if (m < MPR) row_to_bf16_rs(p.in[I_XP] + (size_t)m * 1024, XB + (size_t)m * 1024, RS0 + m, lane);
            else if (m < MTOT) row_to_bf16_rs(p.in[I_XS] + (size_t)(m - MPR) * 1024, XB + (size_t)m * 1024, RS0 + m, lane);
            else row_to_bf16_rs(p.in[I_MEM] + (size_t)(m - MTOT) * 1024, MEMB + (size_t)(m - MTOT) * 1024, RSM + (m - MTOT), lane);
        }
    }
    grid.sync();

    if constexpr (PH(1)) {
        pg8::Gemm g{XB, W1T, MTOT, 2560, 1024}; pg8::StaticOrder S; S.init(MTOT, 2560, G, (int)blockIdx.x);
        pg8::EpiG1 E{RS0, p.in[I_GQ], p.in[I_GK], QB, KB, VB, CB, out + O_KP, out + O_KS, out + O_VP, out + O_VS};
        pg8::gemm_phase<pg8::EpiG1, pg8::StaticOrder, true, true>(lds, g, S, E);
    }
    if constexpr (PH(2)) {
        pg8::Gemm g{MEMB, WMKVT, 2048, 1024, 1024}; pg8::StaticOrder S; S.init(2048, 1024, G, (int)((blockIdx.x + 128) % G));
        pg8::EpiMem E{RSM, out + O_MK, out + O_MV};
        pg8::gemm_phase<pg8::EpiMem, pg8::StaticOrder, true, true>(lds, g, S, E);
    }
    grid.sync();

    if constexpr (PH(3)) for (int r = gw; r < 2048; r += NGW) {
        float* mk = out + O_MK + (size_t)r * 512 + lane * 8; f32x4 a = *(f32x4*)mk, b = *(f32x4*)(mk + 4);
        float ss = (a.x * a.x + a.y * a.y) + (a.z * a.z + a.w * a.w) + (b.x * b.x + b.y * b.y) + (b.z * b.z + b.w * b.w);
        ss += __shfl_xor(ss, 1); ss += __shfl_xor(ss, 2); ss += __shfl_xor(ss, 4); ss += __shfl_xor(ss, 8);
        const float rstd = 1.0f / sqrtf(ss * (1.0f / 128.0f) + EPS); const float* g = p.in[I_GMK] + (lane & 15) * 8;
        const f32x4 g0 = *(const f32x4*)g, g1 = *(const f32x4*)(g + 4);
        *(f32x4*)mk = a * g0 * rstd; *(f32x4*)(mk + 4) = b * g1 * rstd;
    }
    if constexpr (PH(4)) for (int r = gw; r < MTOT; r += NGW) {
        const bool smp = r >= MPR; const int b = smp ? (r - MPR) >> 4 : r >> 12, t = smp ? (r - MPR) & 15 : r & 4095, rb = smp ? MPR + b * 16 : b * 4096, ch0 = lane * 8;
        float acc[8];
        { const f32x4 b0 = *(const f32x4*)(p.in[I_BCONV] + ch0), b1 = *(const f32x4*)(p.in[I_BCONV] + ch0 + 4); acc[0] = b0.x; acc[1] = b0.y; acc[2] = b0.z; acc[3] = b0.w; acc[4] = b1.x; acc[5] = b1.y; acc[6] = b1.z; acc[7] = b1.w; }
        for (int j = 0; j < 31; ++j) { const int tt = t - 30 + j; const float* src;
            if (tt >= 0) src = CB + (size_t)(rb + tt) * 512 + ch0; else if (smp) src = p.in[I_CC] + (size_t)(b * 30 + 30 + tt) * 512 + ch0; else continue;
            const f32x4 c0 = *(const f32x4*)src, c1 = *(const f32x4*)(src + 4), w0 = *(const f32x4*)(p.in[I_WCONV] + j * 512 + ch0), w1 = *(const f32x4*)(p.in[I_WCONV] + j * 512 + ch0 + 4);
            acc[0] += c0.x * w0.x; acc[1] += c0.y * w0.y; acc[2] += c0.z * w0.z; acc[3] += c0.w * w0.w; acc[4] += c1.x * w1.x; acc[5] += c1.y * w1.y; acc[6] += c1.z * w1.z; acc[7] += c1.w * w1.w; }
        float s = 0.f;
#pragma unroll
        for (int e = 0; e < 8; ++e) s += acc[e];
        const float mean = wave_sum(s) * (1.0f / 512.0f); float q = 0.f;
#pragma unroll
        for (int e = 0; e < 8; ++e) { acc[e] -= mean; q += acc[e] * acc[e]; }
        const float rstd = 1.0f / sqrtf(wave_sum(q) * (1.0f / 512.0f) + EPS);
        float y[8];
#pragma unroll
        for (int e = 0; e < 8; ++e) { const float v = acc[e] * rstd * p.in[I_LNG][ch0 + e] + p.in[I_LNB][ch0 + e]; y[e] = v / (1.0f + __expf(-v)); }
        v4u o; o.x = pk2(y[0], y[1]); o.y = pk2(y[2], y[3]); o.z = pk2(y[4], y[5]); o.w = pk2(y[6], y[7]);
        *(v4u*)(A3 + (size_t)r * 1024 + 512 + ch0) = o;
    }
    if constexpr (PH(5)) for (int it = gw; it < (NBP + NBS) * 30; it += NGW) {
        const float* src; float* dst;
        if (it < NBP * 30) { const int b = it / 30, i = it % 30; src = CB + (size_t)(b * 4096 + 4066 + i) * 512; dst = out + O_CP + (size_t)it * 512; }
        else { const int k = it - NBP * 30, b = k / 30, i = k % 30; src = i < 14 ? p.in[I_CC] + (size_t)(b * 30 + 16 + i) * 512 : CB + (size_t)(MPR + b * 16 + i - 14) * 512; dst = out + O_CS + (size_t)k * 512; }
        *(f32x4*)(dst + lane * 8) = *(const f32x4*)(src + lane * 8); *(f32x4*)(dst + lane * 8 + 4) = *(const f32x4*)(src + lane * 8 + 4);
    }
    {
        const float* rel = p.in[I_REL];
        if constexpr (PH(6)) for (int it = gw; it < NBP * 16 * 64; it += NGW) {
            const int round = it / NGW, cc = it & 63, chunk = (round & 1) ? 63 - cc : cc, bhmv = it >> 6, b = bhmv >> 4, hm = (bhmv >> 1) & 7, vh = bhmv & 1, h = hm >> 1;
            const int t = chunk * 64 + lane, r = b * 4096 + t;
            float q[64];
#pragma unroll
            for (int c = 0; c < 8; ++c) unpack8(*(const v4u*)(QB + (size_t)r * 512 + hm * 64 + c * 8), q + c * 8);
            const float* Kf = out + O_KP + (size_t)b * 4096 * 512 + hm * 64 + lane; const float* Vf = out + O_VP + (size_t)b * 4096 * 512 + h * 128 + vh * 64 + lane;
            float mx = -1e30f, l = 0.f, o[64];
#pragma unroll
            for (int e = 0; e < 64; ++e) o[e] = 0.f;
            const int nk = 64 * (chunk + 1);
#pragma unroll 1
            for (int j0 = 0; j0 < nk; j0 += 4) {
                float kk[4], vv[4];
#pragma unroll
                for (int jj = 0; jj < 4; ++jj) { kk[jj] = Kf[(size_t)(j0 + jj) * 512]; vv[jj] = Vf[(size_t)(j0 + jj) * 512]; }
#pragma unroll
                for (int jj = 0; jj < 4; ++jj) { float a = 0.f;
#pragma unroll
                    for (int d = 0; d < 64; ++d) a += q[d] * RDL(kk[jj], d);
                    const float sc = a + rel[rel_bucket(j0 + jj - t) * 4 + h] * LOG2E;
                    if (sc > mx) { const float f = exp2f(mx - sc); l *= f;
#pragma unroll
                        for (int e = 0; e < 64; ++e) o[e] *= f;
                        mx = sc; }
                    const float pr = exp2f(sc - mx); l += pr;
#pragma unroll
                    for (int e = 0; e < 64; ++e) o[e] += pr * RDL(vv[jj], e); }
            }
            const float il = 1.0f / l; float* od = OA + (size_t)r * 1024 + hm * 128 + vh * 64;
#pragma unroll
            for (int c = 0; c < 16; ++c) *(f32x4*)(od + 4 * c) = (f32x4){o[4 * c] * il, o[4 * c + 1] * il, o[4 * c + 2] * il, o[4 * c + 3] * il};
        }
        if constexpr (PH(7)) for (int it = gw; it < NBS * 16; it += NGW) {
            const int b = it >> 4, hm = (it >> 1) & 7, vh = it & 1, h = hm >> 1, i = lane & 15, r = MPR + b * 16 + i;
            float q[64];
#pragma unroll
            for (int c = 0; c < 8; ++c) unpack8(*(const v4u*)(QB + (size_t)r * 512 + hm * 64 + c * 8), q + c * 8);
            float mx = -1e30f, l = 0.f, o[64];
#pragma unroll
            for (int e = 0; e < 64; ++e) o[e] = 0.f;
            const float* Kc = p.in[I_CK] + (size_t)b * PAST * 512 + hm * 64 + lane; const float* Vc = p.in[I_CV] + (size_t)b * PAST * 512 + h * 128 + vh * 64 + lane;
            const float* Kn = out + O_KS + (size_t)b * 16 * 512 + hm * 64 + lane; const float* Vn = out + O_VS + (size_t)b * 16 * 512 + h * 128 + vh * 64 + lane;
#pragma unroll 1
            for (int j0 = 0; j0 < PAST + 16; j0 += 4) {
                float kk[4], vv[4];
#pragma unroll
                for (int jj = 0; jj < 4; ++jj) { const int j = j0 + jj; kk[jj] = j < PAST ? Kc[(size_t)j * 512] : Kn[(size_t)(j - PAST) * 512]; vv[jj] = j < PAST ? Vc[(size_t)j * 512] : Vn[(size_t)(j - PAST) * 512]; }
#pragma unroll
                for (int jj = 0; jj < 4; ++jj) { float a = 0.f;
#pragma unroll
                    for (int d = 0; d < 64; ++d) a += q[d] * RDL(kk[jj], d);
                    const float sc = a + rel[rel_bucket(j0 + jj - (PAST + i)) * 4 + h] * LOG2E;
                    if (sc > mx) { const float f = exp2f(mx - sc); l *= f;
#pragma unroll
                        for (int e = 0; e < 64; ++e) o[e] *= f;
                        mx = sc; }
                    const float pr = exp2f(sc - mx); l += pr;
#pragma unroll
                    for (int e = 0; e < 64; ++e) o[e] += pr * RDL(vv[jj], e); }
            }
            const float il = 1.0f / l; float* od = OA + (size_t)r * 1024 + hm * 128 + vh * 64;
            if (lane < 16) {
#pragma unroll
                for (int c = 0; c < 16; ++c) *(f32x4*)(od + 4 * c) = (f32x4){o[4 * c] * il, o[4 * c + 1] * il, o[4 * c + 2] * il, o[4 * c + 3] * il}; }
        }
    }
    grid.sync();
    if constexpr (PH(8)) {
        const float lam = compute_lam(p.in[I_LAM], lane);
        for (int r = gw; r < MTOT; r += NGW) {
            const int h = lane >> 4, e0 = (lane & 15) * 8; const float* o0 = OA + (size_t)r * 1024 + (2 * h) * 128 + e0; const float* o1 = o0 + 128;
            const f32x4 a0 = *(const f32x4*)o0, a1 = *(const f32x4*)(o0 + 4), b0 = *(const f32x4*)o1, b1 = *(const f32x4*)(o1 + 4);
            const f32x4 d0 = a0 - b0 * lam, d1 = a1 - b1 * lam;
            float ss = (d0.x * d0.x + d0.y * d0.y) + (d0.z * d0.z + d0.w * d0.w) + (d1.x * d1.x + d1.y * d1.y) + (d1.z * d1.z + d1.w * d1.w);
            ss += __shfl_xor(ss, 1); ss += __shfl_xor(ss, 2); ss += __shfl_xor(ss, 4); ss += __shfl_xor(ss, 8);
            const float sc = (1.0f - LAM_INIT) / sqrtf(ss * (1.0f / 128.0f) + EPS); const f32x4 g0 = *(const f32x4*)(p.in[I_GSUB] + e0), g1 = *(const f32x4*)(p.in[I_GSUB] + e0 + 4);
            const f32x4 y0 = d0 * g0 * sc, y1 = d1 * g1 * sc;
            v4u o; o.x = pk2(y0.x, y0.y); o.y = pk2(y0.z, y0.w); o.z = pk2(y1.x, y1.y); o.w = pk2(y1.z, y1.w);
            *(v4u*)(A3 + (size_t)r * 1024 + h * 128 + e0) = o;
        }
    }
    grid.sync();
    if constexpr (PH(9)) {
        pg8::Gemm g{A3, WOT, MTOT, 1024, 1024}; pg8::StaticOrder S; S.init(MTOT, 1024, G, (int)blockIdx.x);
        pg8::EpiRes E{p.in[I_XP], p.in[I_XS], X1, X1B, SSP1};
        pg8::gemm_phase<pg8::EpiRes, pg8::StaticOrder, true, true>(lds, g, S, E);
    }
    grid.sync();
    if constexpr (PH(10)) {
        pg8::Gemm g{X1B, WMQT, MTOT, 512, 1024}; pg8::StaticOrder S; S.init(MTOT, 512, G, (int)blockIdx.x);
        pg8::EpiScaleBf16<0> E{SSP1, QM, 512};
        pg8::gemm_phase<pg8::EpiScaleBf16<0>, pg8::StaticOrder, true, true>(lds, g, S, E);
    }
    grid.sync();
    if constexpr (PH(11)) for (int it = gw; it < (MTOT / 16) * 4; it += NGW) {
        const int grp = it >> 2, head = it & 3, i = lane & 15, sp = lane >> 4, r = grp * 16 + i;
        const float* mkb; const float* mvb;
        if (grp < 2048) { const int bb = grp >> 8; mkb = out + O_MK + (size_t)bb * 256 * 512; mvb = out + O_MV + (size_t)bb * 256 * 512; }
        else { const int bb = grp - 2048; mkb = p.in[I_CMK] + (size_t)bb * 256 * 512; mvb = p.in[I_CMV] + (size_t)bb * 256 * 512; }
        mkb += head * 128 + sp * 32; mvb += head * 128 + sp * 32;
        float q[32]; float ss = 0.f;
#pragma unroll
        for (int c = 0; c < 4; ++c) unpack8(*(const v4u*)(QM + (size_t)r * 512 + head * 128 + sp * 32 + c * 8), q + c * 8);
#pragma unroll
        for (int d = 0; d < 32; ++d) ss += q[d] * q[d];
        ss += __shfl_xor(ss, 16); ss += __shfl_xor(ss, 32);
        const float qs = (1.0f / sqrtf(ss * (1.0f / 128.0f) + EPS)) * (0.08838834764831845f * LOG2E);
#pragma unroll
        for (int d = 0; d < 32; ++d) q[d] *= qs * p.in[I_GMQ][sp * 32 + d];
        float mx = -1e30f, l = 0.f, o[32];
#pragma unroll
        for (int e = 0; e < 32; ++e) o[e] = 0.f;
#pragma unroll 1
        for (int j = 0; j < 256; ++j) {
            const f32x4* kr = (const f32x4*)(mkb + (size_t)j * 512); const f32x4* vr = (const f32x4*)(mvb + (size_t)j * 512);
            f32x4 kk[8], vv[8];
#pragma unroll
            for (int c = 0; c < 8; ++c) { kk[c] = kr[c]; vv[c] = vr[c]; }
            float a = 0.f;
#pragma unroll
            for (int c = 0; c < 8; ++c) a += (q[4 * c] * kk[c].x + q[4 * c + 1] * kk[c].y) + (q[4 * c + 2] * kk[c].z + q[4 * c + 3] * kk[c].w);
            a += __shfl_xor(a, 16); a += __shfl_xor(a, 32);
            if (a > mx) { const float f = exp2f(mx - a); l *= f;
#pragma unroll
                for (int e = 0; e < 32; ++e) o[e] *= f;
                mx = a; }
            const float pr = exp2f(a - mx); l += pr;
#pragma unroll
            for (int c = 0; c < 8; ++c) { o[4 * c] += pr * vv[c].x; o[4 * c + 1] += pr * vv[c].y; o[4 * c + 2] += pr * vv[c].z; o[4 * c + 3] += pr * vv[c].w; }
        }
        const float il = 1.0f / l; bf16* od = OM + (size_t)r * 512 + head * 128 + sp * 32;
#pragma unroll
        for (int c = 0; c < 4; ++c) { v4u w; w.x = pk2(o[8 * c] * il, o[8 * c + 1] * il); w.y = pk2(o[8 * c + 2] * il, o[8 * c + 3] * il); w.z = pk2(o[8 * c + 4] * il, o[8 * c + 5] * il); w.w = pk2(o[8 * c + 6] * il, o[8 * c + 7] * il); *(v4u*)(od + 8 * c) = w; }
    }
    grid.sync();
    if constexpr (PH(12)) {
        pg8::Gemm g{OM, WMOT, MTOT, 1024, 512}; pg8::StaticOrder S; S.init(MTOT, 1024, G, (int)blockIdx.x);
        pg8::EpiRes E{X1, X1 + (size_t)MPR * 1024, X1, X2B, SSP2};
        pg8::gemm_phase<pg8::EpiRes, pg8::StaticOrder, true, true>(lds, g, S, E);
    }
    grid.sync();
    if constexpr (PH(13)) {
        pg8::Gemm g{X2B, WF1T, MTOT, 4096, 1024}; pg8::StaticOrder S; S.init(MTOT, 4096, G, (int)blockIdx.x);
        pg8::EpiScaleBf16<1> E{SSP2, UB, 4096};
        pg8::gemm_phase<pg8::EpiScaleBf16<1>, pg8::StaticOrder, true, true>(lds, g, S, E);
    }
    grid.sync();
    if constexpr (PH(14)) {
        pg8::Gemm g{UB, WF2T, MTOT, 1024, 4096}; pg8::StaticOrder S; S.init(MTOT, 1024, G, (int)blockIdx.x);
        pg8::EpiOut E{X1, out + O_YP, out + O_YS};
        pg8::gemm_phase<pg8::EpiOut, pg8::StaticOrder, true, true>(lds, g, S, E);
    }
}

extern "C" void kernel_launch(void* const* d_in, const int* in_sizes, int n_in, void* d_out, int out_size, void* d_ws, size_t ws_size, hipStream_t stream) {
    static int grid = 0;
    if (grid == 0) {
        if (n_in != 31 || out_size != (int)O_END || ws_size < WS_END) { fprintf(stderr, "kernel_launch: unexpected shapes (n_in %d, out %d, ws %zu)\n", n_in, out_size, ws_size); grid = -1; return; }
        int dev = 0, cus = 0, per_cu = 0;
        hipGetDevice(&dev); hipDeviceGetAttribute(&cus, hipDeviceAttributeMultiprocessorCount, dev);
        if (hipFuncSetAttribute((const void*)fwd_kernel, hipFuncAttributeMaxDynamicSharedMemorySize, LDS_BYTES) != hipSuccess) { fprintf(stderr, "kernel_launch: hipFuncSetAttribute failed\n"); grid = -1; return; }
        if (hipOccupancyMaxActiveBlocksPerMultiprocessor(&per_cu, (const void*)fwd_kernel, NTHREADS, LDS_BYTES) != hipSuccess || per_cu < 1) { fprintf(stderr, "kernel_launch: occupancy query failed (%d)\n", per_cu); (void)hipGetLastError(); per_cu = 1; }
        if (per_cu > 1) per_cu = 1;
        grid = cus * per_cu;
        if (grid % 8 != 0 || grid < 8) { fprintf(stderr, "kernel_launch: unexpected CU count %d\n", cus); }
    }
    if (grid < 0) return;
    Params p{};
    for (int i = 0; i < 31; ++i) p.in[i] = (const float*)d_in[i];
    p.out = (float*)d_out; p.ws = (unsigned char*)d_ws;
    void* args[] = {&p};
    hipError_t e = hipLaunchCooperativeKernel((const void*)fwd_kernel, dim3(grid), dim3(NTHREADS), args, LDS_BYTES, stream);
    if (e != hipSuccess) fprintf(stderr, "kernel_launch: cooperative launch failed: %s (grid %d)\n", hipGetErrorString(e), grid);
}
```

```cpp
#include <hip/hip_runtime.h>
#include <hip/hip_cooperative_groups.h>
#include <cstdio>
#include <cstdint>
namespace pg8 {
#define PG8_LAS __attribute__((address_space(3)))
typedef unsigned short bf16_t;
typedef short bf16x8 __attribute__((ext_vector_type(8)));
typedef float f32x4 __attribute__((ext_vector_type(4)));
typedef unsigned u32x4 __attribute__((ext_vector_type(4)));
constexpr int BM = 256, BK = 64, HALF = 128, HTB = HALF * BK * 2  , STAGE_BYTES = 8 * HTB, NXCD = 8, WGM = 8;

__host__ __device__ __forceinline__ int lds_byte(int r, int c) { const int st = (r >> 4) * 2 + (c >> 5), rr = r & 15, cc = c & 31, ob = rr * 64 + cc * 2; return st * 1024 + (ob ^ (((ob >> 9) & 1) << 5)); }
__host__ __device__ __forceinline__ void stage_rc(int b, int& R, int& C) { const int st = b / 1024, sb = b % 1024, swz = sb ^ (((sb >> 9) & 1) << 5); R = (st >> 1) * 16 + swz / 64; C = (st & 1) * 32 + (swz % 64) / 2; }
__host__ __device__ __forceinline__ int perm32(int rho) { const int n = rho >> 4, i = rho & 15; return 8 * (i >> 2) + 4 * n + (i & 3); }

struct Unit { int pm, pn; };
struct Gemm { const bf16_t* A; const bf16_t* Bt; int M, N, K; };

struct StaticOrder {
    int nM, nN, nwg, G, c;
    __host__ __device__ void init(int M, int N, int G_, int c_) { nM = M / BM; nN = N / BM; nwg = nM * nN; G = G_; c = c_; }
    __host__ __device__ bool next(int i, Unit& u) const {
        const long L = (long)i * G + c; if (L >= nwg) return false;
        int wgid = (int)L; { const int q = nwg / NXCD, r = nwg % NXCD, xcd = wgid % NXCD, off = wgid / NXCD; wgid = (xcd < r ? xcd * (q + 1) : r * (q + 1) + (xcd - r) * q) + off; }
        const int nig = WGM * nN, gid = wgid / nig, fm = gid * WGM, gsz = (nM - fm) < WGM ? (nM - fm) : WGM;
        u.pm = fm + ((wgid % nig) % gsz); u.pn = (wgid % nig) / gsz; return true;
    }
    __device__ __forceinline__ void a_ready(const Unit&) const {}
    __device__ __forceinline__ void done(const Unit&) const {}
};

__device__ __forceinline__ unsigned cvt_pk_bf16(float lo, float hi) { unsigned r; asm volatile("v_cvt_pk_bf16_f32 %0, %1, %2" : "=v"(r) : "v"(lo), "v"(hi)); return r; }
typedef float f32x2 __attribute__((ext_vector_type(2)));

constexpr int MP = 32768;
constexpr float EPSN = 1e-6f;
constexpr float QC2 = 0.125f * 1.4426950408889634f;
__device__ __forceinline__ void st_bf16x8(bf16_t* p, const f32x4 a, const f32x4 b) { u32x4 w; w.x = cvt_pk_bf16(a[0], a[1]); w.y = cvt_pk_bf16(a[2], a[3]); w.z = cvt_pk_bf16(b[0], b[1]); w.w = cvt_pk_bf16(b[2], b[3]); *(u32x4*)p = w; }
__device__ __forceinline__ float dot4(const f32x4 a) { return (a[0] * a[0] + a[1] * a[1]) + (a[2] * a[2] + a[3] * a[3]); }

struct EpiG1 {
    static constexpr bool PERM = true, AFTER_DRAIN = false;
    const float* rs; const float* gq; const float* gk;
    bf16_t* Q; bf16_t* KB; bf16_t* VB; float* C;
    float* kp; float* ks; float* vp; float* vs;
    __device__ __forceinline__ void operator()(const f32x4 (&acc)[2][2][4][2], const Unit& u, int wr, int wc, int fr, int fq) const {
        const int pn = u.pn;
#pragma unroll
        for (int ai = 0; ai < 2; ++ai)
#pragma unroll
            for (int m = 0; m < 4; ++m) {
                const int r = u.pm * BM + ai * HALF + wr * 64 + m * 16 + fr;
                const float rsv = rs[r];
                if (pn < 4) {
                    f32x4 v[2][2]; float ss = 0.f;
#pragma unroll
                    for (int bj = 0; bj < 2; ++bj)
#pragma unroll
                        for (int n = 0; n < 2; ++n) { v[bj][n] = acc[ai][bj][m][n] * rsv; ss += dot4(v[bj][n]); }
                    ss += __shfl_xor(ss, 16); ss += __shfl_xor(ss, 32);
                    const float rstd = 1.0f / sqrtf(ss * (1.0f / 64.0f) + EPSN);
                    const float* g = pn < 2 ? gq : gk; const float sc = pn < 2 ? rstd * QC2 : rstd;
                    const int grp = 4 * (pn & 1) + wc;
#pragma unroll
                    for (int bj = 0; bj < 2; ++bj) {
                        const int d0 = 32 * bj + 8 * fq; const f32x4 g0 = *(const f32x4*)(g + d0), g1 = *(const f32x4*)(g + d0 + 4);
                        const f32x4 o0 = v[bj][0] * g0 * sc, o1 = v[bj][1] * g1 * sc; const int col = 64 * grp + d0;
                        if (pn < 2) st_bf16x8(Q + (size_t)r * 512 + col, o0, o1);
                        else { float* ko = (r < MP ? kp + (size_t)r * 512 : ks + (size_t)(r - MP) * 512) + col; *(f32x4*)ko = o0; *(f32x4*)(ko + 4) = o1; st_bf16x8(KB + (size_t)r * 512 + col, o0, o1); }
                    }
                } else if (pn < 6) {
#pragma unroll
                    for (int bj = 0; bj < 2; ++bj) {
                        const int col = 256 * (pn - 4) + 128 * bj + 32 * wc + 8 * fq; const f32x4 o0 = acc[ai][bj][m][0] * rsv, o1 = acc[ai][bj][m][1] * rsv;
                        float* vo = (r < MP ? vp + (size_t)r * 512 : vs + (size_t)(r - MP) * 512) + col; *(f32x4*)vo = o0; *(f32x4*)(vo + 4) = o1; st_bf16x8(VB + (size_t)r * 512 + col, o0, o1);
                    }
                } else {
                    const int ch = 128 * (pn - 6) + 32 * wc + 8 * fq;
#pragma unroll
                    for (int n = 0; n < 2; ++n) { const f32x4 a = acc[ai][0][m][n] * rsv, gt = acc[ai][1][m][n] * rsv; f32x4 c;
#pragma unroll
                        for (int e = 0; e < 4; ++e) c[e] = a[e] / (1.0f + __expf(-gt[e]));
                        *(f32x4*)(C + (size_t)r * 512 + ch + 4 * n) = c; }
                }
            }
    }
};
struct EpiMem {
    static constexpr bool PERM = true, AFTER_DRAIN = false;
    const float* rs; float* mk; float* mv;
    __device__ __forceinline__ void operator()(const f32x4 (&acc)[2][2][4][2], const Unit& u, int wr, int wc, int fr, int fq) const {
        float* base = u.pn < 2 ? mk : mv; const int cb = 256 * (u.pn & 1);
#pragma unroll
        for (int ai = 0; ai < 2; ++ai)
#pragma unroll
            for (int m = 0; m < 4; ++m) { const int r = u.pm * BM + ai * HALF + wr * 64 + m * 16 + fr; const float rsv = rs[r];
#pragma unroll
                for (int bj = 0; bj < 2; ++bj) { float* o = base + (size_t)r * 512 + cb + 128 * bj + 32 * wc + 8 * fq; *(f32x4*)o = acc[ai][bj][m][0] * rsv; *(f32x4*)(o + 4) = acc[ai][bj][m][1] * rsv; } }
    }
};
struct EpiRes {
    static constexpr bool PERM = true, AFTER_DRAIN = false;
    const float* res_p; const float* res_s; float* xo; bf16_t* xb; float* ssp;
    __device__ __forceinline__ void operator()(const f32x4 (&acc)[2][2][4][2], const Unit& u, int wr, int wc, int fr, int fq) const {
#pragma unroll
        for (int ai = 0; ai < 2; ++ai)
#pragma unroll
            for (int m = 0; m < 4; ++m) { const int r = u.pm * BM + ai * HALF + wr * 64 + m * 16 + fr;
                const float* rr = r < MP ? res_p + (size_t)r * 1024 : res_s + (size_t)(r - MP) * 1024; float ss = 0.f;
#pragma unroll
                for (int bj = 0; bj < 2; ++bj) { const int col = 256 * u.pn + 128 * bj + 32 * wc + 8 * fq;
                    const f32x4 x0 = *(const f32x4*)(rr + col) + acc[ai][bj][m][0], x1 = *(const f32x4*)(rr + col + 4) + acc[ai][bj][m][1];
                    *(f32x4*)(xo + (size_t)r * 1024 + col) = x0; *(f32x4*)(xo + (size_t)r * 1024 + col + 4) = x1; st_bf16x8(xb + (size_t)r * 1024 + col, x0, x1); ss += dot4(x0) + dot4(x1); }
                ss += __shfl_xor(ss, 16); ss += __shfl_xor(ss, 32);
                if (fq == 0) ssp[(size_t)r * 16 + 4 * u.pn + wc] = ss; }
    }
};
__device__ __forceinline__ float row_rs(const float* ssp, int r) { const f32x4 a = *(const f32x4*)(ssp + (size_t)r * 16), b = *(const f32x4*)(ssp + (size_t)r * 16 + 4), c = *(const f32x4*)(ssp + (size_t)r * 16 + 8), d = *(const f32x4*)(ssp + (size_t)r * 16 + 12);
    const float s = ((a[0] + a[1]) + (a[2] + a[3])) + ((b[0] + b[1]) + (b[2] + b[3])) + ((c[0] + c[1]) + (c[2] + c[3])) + ((d[0] + d[1]) + (d[2] + d[3])); return 1.0f / sqrtf(s * (1.0f / 1024.0f) + EPSN); }
template <int ACT> struct EpiScaleBf16 {
    static constexpr bool PERM = true, AFTER_DRAIN = false;
    const float* ssp; bf16_t* O; int ldc;
    __device__ __forceinline__ void operator()(const f32x4 (&acc)[2][2][4][2], const Unit& u, int wr, int wc, int fr, int fq) const {
#pragma unroll
        for (int ai = 0; ai < 2; ++ai)
#pragma unroll
            for (int m = 0; m < 4; ++m) { const int r = u.pm * BM + ai * HALF + wr * 64 + m * 16 + fr; const float rsv = row_rs(ssp, r);
#pragma unroll
                for (int bj = 0; bj < 2; ++bj) { const int col = 256 * u.pn + 128 * bj + 32 * wc + 8 * fq; f32x4 o0 = acc[ai][bj][m][0] * rsv, o1 = acc[ai][bj][m][1] * rsv;
                    if (ACT == 1) {
#pragma unroll
                        for (int e = 0; e < 4; ++e) { const float a = fmaxf(o0[e], 0.f), b = fmaxf(o1[e], 0.f); o0[e] = a * a; o1[e] = b * b; } }
                    st_bf16x8(O + (size_t)r * ldc + col, o0, o1); } }
    }
};
struct EpiOut {
    static constexpr bool PERM = true, AFTER_DRAIN = false;
    const float* res; float* yp; float* ys;
    __device__ __forceinline__ void operator()(const f32x4 (&acc)[2][2][4][2], const Unit& u, int wr, int wc, int fr, int fq) const {
#pragma unroll
        for (int ai = 0; ai < 2; ++ai)
#pragma unroll
            for (int m = 0; m < 4; ++m) { const int r = u.pm * BM + ai * HALF + wr * 64 + m * 16 + fr;
                const float* rr = res + (size_t)r * 1024; float* yo = r < MP ? yp + (size_t)r * 1024 : ys + (size_t)(r - MP) * 1024;
#pragma unroll
                for (int bj = 0; bj < 2; ++bj) { const int col = 256 * u.pn + 128 * bj + 32 * wc + 8 * fq;
                    *(f32x4*)(yo + col) = *(const f32x4*)(rr + col) + acc[ai][bj][m][0]; *(f32x4*)(yo + col + 4) = *(const f32x4*)(rr + col + 4) + acc[ai][bj][m][1]; } }
    }
};
template <class Epi, class Sched, bool ALIGN_EPI = false, bool SP2 = false>
__device__ __forceinline__ void gemm_phase(PG8_LAS unsigned char* lds, const Gemm g, const Sched& S, const Epi& E) {
    int tid = threadIdx.x; asm volatile("" : "+v"(tid));
    const int wid = __builtin_amdgcn_readfirstlane(tid >> 6), lane = tid & 63, wr = wid >> 2, wc = wid & 3, fr = lane & 15, fq = lane >> 4;
    const int K = g.K, nt = K / BK;
    unsigned voffA[2], voffB[2];
#pragma unroll
    for (int i = 0; i < 2; ++i) { int R, C; stage_rc(tid * 16 + i * 8192, R, C); const int Rb = Epi::PERM ? ((R & ~31) + perm32(R & 31)) : R;
        voffA[i] = (unsigned)(R * K + C) * 2u; voffB[i] = (unsigned)(Rb * K + C) * 2u; }
    const size_t kstep = (size_t)(BK * 2);
    const size_t hstep = (size_t)HALF * K * 2;
    const size_t tstep = 2 * hstep;
    const unsigned ldsw = (unsigned)wid * 1024u;
    const int aoff = lds_byte(wr * 64 + fr, fq * 8), boff = lds_byte(wc * 32 + fr, fq * 8);
#define PG8_SA(b, h) (((b) * 2 + (h)) * HTB)
#define PG8_SB(b, h) ((4 + (b) * 2 + (h)) * HTB)
#define PG8_STAGE(bufoff, gbase, voff) do { _Pragma("unroll") for (int _i = 0; _i < 2; ++_i) \
        __builtin_amdgcn_global_load_lds((const unsigned*)((const char*)(gbase) + (voff)[_i]), (PG8_LAS unsigned*)(lds + (bufoff) + ldsw + _i * 8192), 16, 0, 0); } while (0)
#define PG8_LDA(dst, b, h) do { _Pragma("unroll") for (int m = 0; m < 4; ++m) _Pragma("unroll") for (int k = 0; k < 2; ++k) dst[m][k] = *(const PG8_LAS bf16x8*)(lds + PG8_SA(b, h) + aoff + m * 2048 + k * 1024); } while (0)
#define PG8_LDB(dst, b, h) do { _Pragma("unroll") for (int n = 0; n < 2; ++n) _Pragma("unroll") for (int k = 0; k < 2; ++k) dst[n][k] = *(const PG8_LAS bf16x8*)(lds + PG8_SB(b, h) + boff + n * 2048 + k * 1024); } while (0)
#define PG8_MMA(ai, bj, At, Bt) do { __builtin_amdgcn_s_setprio(1); _Pragma("unroll") for (int m = 0; m < 4; ++m) _Pragma("unroll") for (int n = 0; n < 2; ++n) _Pragma("unroll") for (int k = 0; k < 2; ++k) \
        acc[ai][bj][m][n] = __builtin_amdgcn_mfma_f32_16x16x32_bf16(Bt[n][k], At[m][k], acc[ai][bj][m][n], 0, 0, 0); __builtin_amdgcn_s_setprio(0); } while (0)
#define PG8_WAIT_V(n) asm volatile("s_waitcnt vmcnt(" #n ")" ::: "memory")
#define PG8_WAIT_L(n) asm volatile("s_waitcnt lgkmcnt(" #n ")" ::: "memory")
#define PG8_BAR __builtin_amdgcn_s_barrier()
#define PG8_SCHED __builtin_amdgcn_sched_barrier(0)
    Unit cur, nxt; int ui = 0;
    if (!S.next(0, cur)) return;
    f32x4 acc[2][2][4][2];
#pragma unroll
    for (int a = 0; a < 2; ++a)
#pragma unroll
        for (int b = 0; b < 2; ++b)
#pragma unroll
            for (int m = 0; m < 4; ++m)
#pragma unroll
                for (int n = 0; n < 2; ++n) acc[a][b][m][n] = (f32x4){0.f, 0.f, 0.f, 0.f};
    bf16x8 At[4][2], B0[2][2], B1[2][2];
    const char* cA = (const char*)g.A + (size_t)cur.pm * tstep; const char* cB = (const char*)g.Bt + (size_t)cur.pn * tstep;
    S.a_ready(cur);
    if constexpr (SP2) {
        PG8_STAGE(PG8_SB(0, 0), cB, voffB); PG8_STAGE(PG8_SB(0, 1), cB + hstep, voffB); PG8_STAGE(PG8_SA(0, 0), cA, voffA); PG8_STAGE(PG8_SA(0, 1), cA + hstep, voffA);
        if (wr == 1) PG8_BAR;
        PG8_WAIT_V(2); PG8_BAR;
        PG8_STAGE(PG8_SB(1, 0), cB + kstep, voffB); PG8_STAGE(PG8_SA(1, 0), cA + kstep, voffA); PG8_STAGE(PG8_SB(1, 1), cB + hstep + kstep, voffB);
        PG8_WAIT_V(6); PG8_BAR;
    } else {
        PG8_STAGE(PG8_SB(0, 0), cB, voffB); PG8_STAGE(PG8_SA(0, 0), cA, voffA); PG8_STAGE(PG8_SB(0, 1), cB + hstep, voffB); PG8_STAGE(PG8_SA(0, 1), cA + hstep, voffA);
        if (wr == 1) PG8_BAR;
        PG8_WAIT_V(4); PG8_BAR;
        PG8_STAGE(PG8_SB(1, 0), cB + kstep, voffB); PG8_STAGE(PG8_SA(1, 0), cA + kstep, voffA); PG8_STAGE(PG8_SB(1, 1), cB + hstep + kstep, voffB);
        PG8_WAIT_V(6); PG8_BAR;
    }
    for (;;) {
        const bool has_next = S.next(ui + 1, nxt);
        const char* nA = has_next ? (const char*)g.A + (size_t)nxt.pm * tstep : cA; const char* nB = has_next ? (const char*)g.Bt + (size_t)nxt.pn * tstep : cB;
        for (int t = 0; t < nt; t += 2) {
            const bool last = (t == nt - 2);
            const char* a1 = cA + (size_t)(t + 1) * kstep;
            const char* a2 = last ? nA : cA + (size_t)(t + 2) * kstep; const char* b2 = last ? nB : cB + (size_t)(t + 2) * kstep;
            const char* a3 = a2 + kstep; const char* b3 = b2 + kstep;
            if (last && has_next) S.a_ready(nxt);
            if constexpr (SP2) {
            PG8_LDB(B0, 0, 0); PG8_LDB(B1, 0, 1); PG8_SCHED; PG8_LDA(At, 0, 0); PG8_STAGE(PG8_SA(1, 1), a1 + hstep, voffA);
            PG8_WAIT_V(8); PG8_WAIT_L(0); PG8_BAR; PG8_MMA(0, 0, At, B0); PG8_MMA(0, 1, At, B1); PG8_BAR; PG8_SCHED;
            PG8_LDA(At, 0, 1); PG8_STAGE(PG8_SB(0, 0), b2, voffB); PG8_STAGE(PG8_SB(0, 1), b2 + hstep, voffB); PG8_STAGE(PG8_SA(0, 0), a2, voffA);
            PG8_WAIT_V(8); PG8_WAIT_L(0); PG8_BAR; PG8_MMA(1, 0, At, B0); PG8_MMA(1, 1, At, B1); PG8_BAR; PG8_SCHED;
            PG8_LDB(B0, 1, 0); PG8_LDB(B1, 1, 1); PG8_SCHED; PG8_LDA(At, 1, 0); PG8_STAGE(PG8_SA(0, 1), a2 + hstep, voffA);
            PG8_WAIT_V(8); PG8_WAIT_L(0); PG8_BAR; PG8_MMA(0, 0, At, B0); PG8_MMA(0, 1, At, B1); PG8_BAR; PG8_SCHED;
            PG8_LDA(At, 1, 1); PG8_STAGE(PG8_SB(1, 0), b3, voffB); PG8_STAGE(PG8_SB(1, 1), b3 + hstep, voffB); PG8_STAGE(PG8_SA(1, 0), a3, voffA);
            PG8_WAIT_V(8); PG8_WAIT_L(0); PG8_BAR; PG8_MMA(1, 0, At, B0); PG8_MMA(1, 1, At, B1); PG8_BAR; PG8_SCHED;
            } else {
            PG8_LDB(B0, 0, 0); PG8_SCHED; PG8_LDA(At, 0, 0); PG8_STAGE(PG8_SA(1, 1), a1 + hstep, voffA);
            PG8_WAIT_L(8); PG8_BAR; PG8_WAIT_L(0); PG8_MMA(0, 0, At, B0); PG8_BAR; PG8_SCHED;
            PG8_LDB(B1, 0, 1); PG8_STAGE(PG8_SB(0, 0), b2, voffB);
            PG8_BAR; PG8_WAIT_L(0); PG8_MMA(0, 1, At, B1); PG8_BAR;
            PG8_LDA(At, 0, 1); PG8_STAGE(PG8_SA(0, 0), a2, voffA);
            PG8_BAR; PG8_WAIT_L(0); PG8_MMA(1, 0, At, B0); PG8_BAR; PG8_SCHED;
            PG8_STAGE(PG8_SB(0, 1), b2 + hstep, voffB);
            PG8_WAIT_V(6); PG8_BAR; PG8_MMA(1, 1, At, B1); PG8_BAR;
            PG8_LDB(B0, 1, 0); PG8_SCHED; PG8_LDA(At, 1, 0); PG8_STAGE(PG8_SA(0, 1), a2 + hstep, voffA);
            PG8_WAIT_L(8); PG8_BAR; PG8_WAIT_L(0); PG8_MMA(0, 0, At, B0); PG8_BAR; PG8_SCHED;
            PG8_LDB(B1, 1, 1); PG8_STAGE(PG8_SB(1, 0), b3, voffB);
            PG8_BAR; PG8_WAIT_L(0); PG8_MMA(0, 1, At, B1); PG8_BAR;
            PG8_LDA(At, 1, 1); PG8_STAGE(PG8_SA(1, 0), a3, voffA);
            PG8_BAR; PG8_WAIT_L(0); PG8_MMA(1, 0, At, B0); PG8_BAR; PG8_SCHED;
            PG8_STAGE(PG8_SB(1, 1), b3 + hstep, voffB);
            PG8_WAIT_V(6); PG8_BAR; PG8_MMA(1, 1, At, B1); PG8_BAR;
            }
        }
        if constexpr (ALIGN_EPI) { if (wr == 0) PG8_BAR; }
        if constexpr (!Epi::AFTER_DRAIN) { E(acc, cur, wr, wc, fr, fq); S.done(cur); }
        if (!has_next) break;
#pragma unroll
        for (int a = 0; a < 2; ++a)
#pragma unroll
            for (int b = 0; b < 2; ++b)
#pragma unroll
                for (int m = 0; m < 4; ++m)
#pragma unroll
                    for (int n = 0; n < 2; ++n) acc[a][b][m][n] = (f32x4){0.f, 0.f, 0.f, 0.f};
        cur = nxt; cA = nA; cB = nB; ++ui;
        if constexpr (ALIGN_EPI) { if (wr == 1) PG8_BAR; }
    }
    PG8_WAIT_V(0);
    if constexpr (!ALIGN_EPI) { if (wr == 0) PG8_BAR; }
    PG8_BAR;
    if constexpr (Epi::AFTER_DRAIN) { E.fused(acc, cur, wr, wc, fr, fq, lds, wid, lane); S.done(cur); }
#undef PG8_SA
#undef PG8_SB
#undef PG8_STAGE
#undef PG8_LDA
#undef PG8_LDB
#undef PG8_MMA
#undef PG8_WAIT_V
#undef PG8_WAIT_L
#undef PG8_BAR
#undef PG8_SCHED
}
}
#include <hip/hip_bf16.h>
#include <cmath>
namespace attn_body {
using bf16=__hip_bfloat16;
using bf16x8=__attribute__((ext_vector_type(8)))short;
using s16x4=__attribute__((ext_vector_type(4)))short;
using f32x16=__attribute__((ext_vector_type(16)))float;
using u32x4=__attribute__((ext_vector_type(4)))unsigned;
constexpr int SEQ=4096,D=64,PQ=512,PK=512,PV=512,PO=1024;
constexpr int NW=8,QBLK=32,QB=QBLK*NW,KVBLK=64,NQB=SEQ/QB;
constexpr int ATTN_UNIT_ROWS=QB;
__device__ __forceinline__ int crow(int r,int hi){return (r&3)+8*(r>>2)+4*hi;}
#define SBAR() __builtin_amdgcn_sched_barrier(0)
typedef __attribute__((address_space(3))) const float* lds_fptr;
__device__ __forceinline__ void bmask(f32x16&p0,f32x16&p1,int dist,lds_fptr tb){
  if(dist<0){
    #pragma unroll
    for(int r=0;r<16;++r){p0[r]=-INFINITY;p1[r]=-INFINITY;}
  } else if(dist<=2){
    #pragma unroll
    for(int r=0;r<16;++r){const int o=(r&3)+8*(r>>2); p0[r]+=tb[o]; p1[r]+=tb[o+32];}
  }
}

__device__ __forceinline__ void binit(f32x16&c0,f32x16&c1,int dist,lds_fptr tb){
  if(dist<0){
    #pragma unroll
    for(int r=0;r<16;++r){c0[r]=-INFINITY;c1[r]=-INFINITY;}
  } else if(dist<=2){
    #pragma unroll
    for(int r=0;r<16;++r){const int o=(r&3)+8*(r>>2); c0[r]=tb[o]; c1[r]=tb[o+32];}
  } else {
    #pragma unroll
    for(int r=0;r<16;++r){c0[r]=0.f;c1[r]=0.f;}
  }
}
__device__ __forceinline__ void binit1(f32x16&c,int dist,lds_fptr tb){
  if(dist<0){
    #pragma unroll
    for(int r=0;r<16;++r)c[r]=-INFINITY;
  } else if(dist<=2){
    #pragma unroll
    for(int r=0;r<16;++r)c[r]=tb[(r&3)+8*(r>>2)];
  } else {
    #pragma unroll
    for(int r=0;r<16;++r)c[r]=0.f;
  }
}
__device__ __forceinline__ void bpost(f32x16&c0,f32x16&c1,float mhat){
  #pragma unroll
  for(int r=0;r<16;++r){c0[r]-=mhat;c1[r]-=mhat;}
}
constexpr int NSLOT=3, SLOTB=8192;
constexpr int LDS_K=0, LDS_V=NSLOT*SLOTB, LDS_WS=2*NSLOT*SLOTB, LDS_OST=LDS_WS+NW*64*4, LDS_BYTES=LDS_OST+NW*4096;
constexpr float C2=0.125f*1.4426950408889634f;
__device__ __forceinline__ void glds16(const void*gsrc,unsigned lds_dst){unsigned keep;
  asm volatile("s_mov_b32 %0, m0\n\ts_mov_b32 m0, %2\n\ts_nop 0\n\tglobal_load_lds_dwordx4 %1, off\n\ts_mov_b32 m0, %0":"=&s"(keep):"v"(gsrc),"s"(lds_dst):"memory");}
__device__ __forceinline__ float max3f(float a,float b,float c){float r;asm("v_max3_f32 %0, %1, %2, %3":"=v"(r):"v"(a),"v"(b),"v"(c));return r;}
__device__ __forceinline__ float max2f(float a,float b){float r;asm("v_max_f32_e32 %0, %1, %2":"=v"(r):"v"(a),"v"(b));return r;}
__device__ __forceinline__ float fadd_s(float a,float b){float r;asm("v_add_f32_e32 %0, %1, %2":"=v"(r):"v"(a),"v"(b));return r;}
__device__ __forceinline__ float fsub_s(float a,float b){float r;asm("v_sub_f32_e32 %0, %1, %2":"=v"(r):"v"(a),"v"(b));return r;}
typedef float f32x2_t __attribute__((ext_vector_type(2))); typedef __bf16 bf16x2_t __attribute__((ext_vector_type(2)));
__device__ __forceinline__ unsigned cvtpk_s(float lo,float hi){f32x2_t v={lo,hi};bf16x2_t b=__builtin_convertvector(v,bf16x2_t);return __builtin_bit_cast(unsigned,b);}
#define WAIT_BAR(N) asm volatile("s_waitcnt vmcnt(" #N ") lgkmcnt(0)\n\ts_barrier":::"memory")

__device__ __forceinline__ void qkt(f32x16&p0,f32x16&p1,const char*Kslot,const bf16x8*qr,const f32x16&negm,int r32,int hi){
  const char*kb=Kslot+hi*1024+r32*16;
  #pragma unroll
  for(int d0=0;d0<4;++d0){
    const bf16x8 b0=*reinterpret_cast<const bf16x8*>(kb+d0*2048);
    const bf16x8 b1=*reinterpret_cast<const bf16x8*>(kb+d0*2048+512);
    {p0=__builtin_amdgcn_mfma_f32_32x32x16_bf16(b0,qr[d0],p0,0,0,0);p1=__builtin_amdgcn_mfma_f32_32x32x16_bf16(b1,qr[d0],p1,0,0,0);}}
}
typedef __attribute__((address_space(3))) const char* lds_cptr;
typedef short v4i16_t __attribute__((ext_vector_type(4)));
__device__ __forceinline__ void kload8(bf16x8*kf,lds_cptr kp){
  kf[0]=*(const __attribute__((address_space(3))) bf16x8*)(kp);      kf[1]=*(const __attribute__((address_space(3))) bf16x8*)(kp+512);
  kf[2]=*(const __attribute__((address_space(3))) bf16x8*)(kp+2048); kf[3]=*(const __attribute__((address_space(3))) bf16x8*)(kp+2560);
  kf[4]=*(const __attribute__((address_space(3))) bf16x8*)(kp+4096); kf[5]=*(const __attribute__((address_space(3))) bf16x8*)(kp+4608);
  kf[6]=*(const __attribute__((address_space(3))) bf16x8*)(kp+6144); kf[7]=*(const __attribute__((address_space(3))) bf16x8*)(kp+6656);
}
__device__ __forceinline__ void kload2(bf16x8*kf,lds_cptr kp,int j){ kf[2*j]=*(const __attribute__((address_space(3))) bf16x8*)(kp+j*2048); kf[2*j+1]=*(const __attribute__((address_space(3))) bf16x8*)(kp+j*2048+512); }
__device__ __forceinline__ s16x4 vtr(lds_cptr p){ return __builtin_bit_cast(s16x4,__builtin_amdgcn_ds_read_tr16_b64_v4i16((__attribute__((address_space(3))) v4i16_t*)p)); }
__device__ __forceinline__ float rowmax(const f32x16&p0,const f32x16&p1){
  float a=max3f(p0[0],p0[1],p1[0]),b=max3f(p0[2],p0[3],p1[1]);a=max3f(a,p1[2],p1[3]);
  #pragma unroll
  for(int r=4;r<16;r+=4){a=max3f(a,p0[r],p0[r+1]);b=max3f(b,p0[r+2],p0[r+3]);a=max3f(a,p1[r],p1[r+1]);b=max3f(b,p1[r+2],p1[r+3]);}
  const float m=max2f(a,b);
  auto rr=__builtin_amdgcn_permlane32_swap(__float_as_uint(m),__float_as_uint(m),false,false);
  return max2f(__uint_as_float(rr[0]),__uint_as_float(rr[1]));
}
__device__ __forceinline__ void pv(f32x16*o,int vb,bf16x8 pa0,bf16x8 pa1,bf16x8 pa2,bf16x8 pa3){
  #pragma unroll
  for(int d0=0;d0<2;++d0){s16x4 lo[4],hi[4];
    #pragma unroll
    for(int ks=0;ks<4;++ks){
      asm volatile("ds_read_b64_tr_b16 %0,%1 offset:%c2":"=&v"(lo[ks]):"v"(vb),"i"(d0*4096+ks*1024):"memory");
      asm volatile("ds_read_b64_tr_b16 %0,%1 offset:%c2":"=&v"(hi[ks]):"v"(vb),"i"(d0*4096+ks*1024+512):"memory");}
    asm volatile("s_waitcnt lgkmcnt(0)":::"memory");SBAR();
    #define PK(k) (bf16x8){lo[k][0],lo[k][1],lo[k][2],lo[k][3],hi[k][0],hi[k][1],hi[k][2],hi[k][3]}
    o[d0]=__builtin_amdgcn_mfma_f32_32x32x16_bf16(pa0,PK(0),o[d0],0,0,0);
    o[d0]=__builtin_amdgcn_mfma_f32_32x32x16_bf16(pa1,PK(1),o[d0],0,0,0);
    o[d0]=__builtin_amdgcn_mfma_f32_32x32x16_bf16(pa2,PK(2),o[d0],0,0,0);
    o[d0]=__builtin_amdgcn_mfma_f32_32x32x16_bf16(pa3,PK(3),o[d0],0,0,0);
    #undef PK
  }
}

#ifndef ATTN_STORE16
#define ATTN_STORE16(p,v) (*(u32x4*)(p)=(v))
#endif
template<int THRL> __device__ __forceinline__ void attn_unit(int b,int qcol,int kcol,int vcol,int ocol,int qb,int hd,const float*reltab,const bf16*Q,const bf16*__restrict__ K,const bf16*__restrict__ V,bf16*O,char*shm){
  int tid=threadIdx.x; asm volatile("":"+v"(tid));
  const int lane=tid&63,r32=lane&31,hi=lane>>5; const int wid=__builtin_amdgcn_readfirstlane(tid>>6);
  const long rowbase=(long)b*SEQ; const int q0=qb*QB;
  const bf16*Qw=Q+(rowbase+q0+wid*QBLK)*PQ+qcol;
  const bf16*Kh=K+rowbase*PK+kcol,*Vh=V+rowbase*PV+vcol;
  const lds_cptr shm3=(lds_cptr)shm;
  const unsigned lds0=(unsigned)(uintptr_t)shm;
  float*wsf=(float*)(shm+LDS_WS)+wid*64;
  const bf16*ksrc=Kh+(long)lane*PK+wid*8;
  const bf16*vsrc=Vh+(long)(16*(wid&3)+(lane>>2))*PV+(wid>>2)*32+(lane&3)*8;
  const unsigned kdst=lds0+LDS_K+wid*1024, vdst=lds0+LDS_V+wid*1024;
  #define DMA_K(t,slot) glds16(ksrc+(long)(t)*KVBLK*PK,(unsigned)__builtin_amdgcn_readfirstlane(kdst+(slot)))
  #define DMA_V(t,slot) glds16(vsrc+(long)(t)*KVBLK*PV,(unsigned)__builtin_amdgcn_readfirstlane(vdst+(slot)))
  const int vb0=(int)(lds0+LDS_V)+((lane>>4)&1)*32+(lane&3)*8+(4*hi+((lane&15)>>2))*64;
  const char*Kbase=shm+LDS_K; bf16x8 kf[8];
  const lds_cptr kp0=shm3+LDS_K+hi*1024+r32*16; const lds_cptr vp0=shm3+LDS_V+((lane>>4)&1)*32+(lane&3)*8+(4*hi+((lane&15)>>2))*64;
  const int NT=(q0+QB)/KVBLK;
  DMA_K(0,0);DMA_V(0,0);DMA_K(1,SLOTB);
  if(tid<256){ const int rel_=tid-191, n_=rel_<0?-rel_:rel_; const int bk_=(rel_>0?16:0)+(n_<8?n_:min(15,2+(31-__clz(n_*n_))));
    ((__attribute__((address_space(3))) float*)(shm3+LDS_BYTES))[tid]=(reltab[bk_*4+hd]-reltab[15*4+hd])*1.4426950408889634f; }
  bf16x8 qr[4];
  #pragma unroll
  for(int d0=0;d0<4;++d0)qr[d0]=*reinterpret_cast<const bf16x8*>(&Qw[(long)r32*PQ+d0*16+hi*8]);
  float mhat=0.f,l_reg=0.f;f32x16 o[2];o[0]=f32x16{};o[1]=f32x16{};f32x16 negm=f32x16{};asm volatile("":"+v"(negm));
  const int wc2=wid>>1; const lds_fptr dtl=(lds_fptr)(shm3+LDS_BYTES)+191-(32*(wid&1)+r32)+4*hi;
  bool resc=false;
  #define START(P0,P1) do{ const float rm=rowmax(P0,P1); resc=false; \
    { const float dl=rm; mhat=fadd_s(mhat,dl); \
      _Pragma("unroll") for(int r=0;r<16;++r){P0[r]=fsub_s(P0[r],dl);P1[r]=fsub_s(P1[r],dl);} \
      _Pragma("unroll") for(int r=0;r<16;++r)negm[r]=-mhat; asm volatile("":"+v"(negm)); } \
    _Pragma("unroll") for(int r=0;r<16;++r)P0[r]=__builtin_amdgcn_exp2f(P0[r]); }while(0)
  #define RESC() do{ if(resc){ asm volatile("s_waitcnt lgkmcnt(0)":::"memory"); \
      _Pragma("unroll") for(int d_=0;d_<2;++d_) _Pragma("unroll") for(int r=0;r<16;++r)o[d_][r]*=wsf[crow(r,hi)]; } }while(0)
  f32x16 pA0,pA1,pB0,pB1;
  int sl_prev=0,sl_cur=0,sl_next=SLOTB;
  #define ROT() do{sl_prev=sl_cur;sl_cur=sl_next;sl_next=(sl_next==(NSLOT-1)*SLOTB)?0:sl_next+SLOTB;}while(0)
  DMA_K(2,2*SLOTB);
  WAIT_BAR(3);
  { const int dist_=wc2+(NT-4); binit(pA0,pA1,dist_,dtl-64*dist_); }
  qkt(pA0,pA1,Kbase,qr,negm,r32,hi);asm volatile("s_nop 15\n\ts_nop 7":"+v"(pA0),"+v"(pA1));
  START(pA0,pA1);
  _Pragma("unroll") for(int r=0;r<16;++r)pA1[r]=__builtin_amdgcn_exp2f(pA1[r]);
  WAIT_BAR(0);
  DMA_K(3,0);DMA_V(1,SLOTB);
  ROT();
  kload8(kf,kp0+sl_cur);
  WAIT_BAR(2);
  s16x4 vlo[8],vhi[8]; u32x4 pw0,pw1,pw2,pw3;
  #define PKW(P,B) cvtpk_s(P[B],P[B+1])
  #define PAF(k) __builtin_bit_cast(bf16x8,pw##k)
  #define VFR(i) (bf16x8){vlo[i][0],vlo[i][1],vlo[i][2],vlo[i][3],vhi[i][0],vhi[i][1],vhi[i][2],vhi[i][3]}
  #define PIN(x) asm volatile("":"+v"(x))
  #define MX3(a,b,c) __builtin_fmaxf(__builtin_fmaxf((a),(b)),(c))
  #define GAPA(MF,A0,A1,A2,A3,W0,W1,PW) do{ MF; sacc+=A0; sacc+=A1; sacc+=A2; sacc+=A3; PIN(sacc); W0; W1; PIN(PW); SBAR(); }while(0)
  #define EX(v) __builtin_amdgcn_exp2f(v)
  #define GAPB(MF,X,B) do{ MF; X[B]=EX(X[B]); X[B+1]=EX(X[B+1]); X[B+2]=EX(X[B+2]); X[B+3]=EX(X[B+3]); PIN(X); SBAR(); }while(0)
  #define VRD(i) do{ vlo[i]=vtr(vp_+(((i)>>2)*4096+((i)&3)*1024)); vhi[i]=vtr(vp_+(((i)>>2)*4096+((i)&3)*1024+512)); }while(0)
  #define KRD(G,j) do{ if(G){ kload2(kf,kp0+sl_next,j); SBAR(); } }while(0)
  #define STEP(C0,C1,P0,P1,t,GK,GV,GL) do{ SBAR(); \
    const lds_cptr vp_=vp0+sl_prev; \
    CINIT0(C0,t); VRD(0); SBAR(); float sacc=(P0[0]+P0[1]); \
    GAPA(C0=__builtin_amdgcn_mfma_f32_32x32x16_bf16(kf[0],qr[0],CSRC(C0),0,0,0), P0[2],P0[3],P0[4],P0[5],     pw0[0]=PKW(P0,0), pw0[1]=PKW(P0,2), pw0); \
    CINIT1(C1,t); VRD(4); SBAR(); GAPA(C1=__builtin_amdgcn_mfma_f32_32x32x16_bf16(kf[1],qr[0],CSRC(C1),0,0,0), P0[6],P0[7],P0[8],P0[9],     pw0[2]=PKW(P0,4), pw0[3]=PKW(P0,6), pw0); \
    VRD(1); SBAR(); GAPA(C0=__builtin_amdgcn_mfma_f32_32x32x16_bf16(kf[2],qr[1],C0,0,0,0),   P0[10],P0[11],P0[12],P0[13], pw1[0]=PKW(P0,8), pw1[1]=PKW(P0,10), pw1); \
    VRD(5); SBAR(); GAPA(C1=__builtin_amdgcn_mfma_f32_32x32x16_bf16(kf[3],qr[1],C1,0,0,0),   P0[14],P0[15],P1[0],P1[1],   pw1[2]=PKW(P0,12),pw1[3]=PKW(P0,14), pw1); \
    VRD(2); SBAR(); GAPA(C0=__builtin_amdgcn_mfma_f32_32x32x16_bf16(kf[4],qr[2],C0,0,0,0),   P1[2],P1[3],P1[4],P1[5],     pw2[0]=PKW(P1,0), pw2[1]=PKW(P1,2), pw2); \
    VRD(6); SBAR(); GAPA(C1=__builtin_amdgcn_mfma_f32_32x32x16_bf16(kf[5],qr[2],C1,0,0,0),   P1[6],P1[7],P1[8],P1[9],     pw2[2]=PKW(P1,4), pw2[3]=PKW(P1,6), pw2); \
    VRD(3); SBAR(); GAPA(C0=__builtin_amdgcn_mfma_f32_32x32x16_bf16(kf[6],qr[3],C0,0,0,0),   P1[10],P1[11],P1[12],P1[13], pw3[0]=PKW(P1,8), pw3[1]=PKW(P1,10), pw3); \
    VRD(7); SBAR(); GAPA(C1=__builtin_amdgcn_mfma_f32_32x32x16_bf16(kf[7],qr[3],C1,0,0,0),   P1[14],P1[15],0.f,0.f,       pw3[2]=PKW(P1,12),pw3[3]=PKW(P1,14), pw3); \
    l_reg+=sacc; \
    if(GK){DMA_K((t)+3,sl_cur);} if(GV){DMA_V((t)+1,sl_next);} \
    CPOST(C0,C1); \
    { float a=MX3(C0[0],C0[1],C1[0]),b=MX3(C0[2],C0[3],C1[1]); a=MX3(a,C1[2],C1[3]); \
      _Pragma("unroll") for(int r=4;r<16;r+=4){a=MX3(a,C0[r],C0[r+1]);b=MX3(b,C0[r+2],C0[r+3]);a=MX3(a,C1[r],C1[r+1]);b=MX3(b,C1[r+2],C1[r+3]);} \
      float rm=__builtin_fmaxf(a,b); { auto rr=__builtin_amdgcn_permlane32_swap(__float_as_uint(rm),__float_as_uint(rm),false,false); rm=__builtin_fmaxf(__uint_as_float(rr[0]),__uint_as_float(rr[1])); } \
      resc=false; \
      if(__builtin_expect(__any(rm>(float)THRL),0)){ const float dl=__builtin_fmaxf(rm,0.f); mhat+=dl; \
        _Pragma("unroll") for(int r=0;r<16;++r){C0[r]-=dl;C1[r]-=dl;} \
        NEGM_UPD(); \
        const float f=__builtin_amdgcn_exp2f(-dl); l_reg*=f; if(hi==0)wsf[r32]=f; resc=true; } } \
    SBAR(); \
    GAPB(o[0]=__builtin_amdgcn_mfma_f32_32x32x16_bf16(PAF(0),VFR(0),o[0],0,0,0), C0,0); \
    GAPB(o[1]=__builtin_amdgcn_mfma_f32_32x32x16_bf16(PAF(0),VFR(4),o[1],0,0,0), C0,4); \
    KRD(GL,0); GAPB(o[0]=__builtin_amdgcn_mfma_f32_32x32x16_bf16(PAF(1),VFR(1),o[0],0,0,0), C0,8); \
    KRD(GL,1); GAPB(o[1]=__builtin_amdgcn_mfma_f32_32x32x16_bf16(PAF(1),VFR(5),o[1],0,0,0), C0,12); \
    KRD(GL,2); GAPB(o[0]=__builtin_amdgcn_mfma_f32_32x32x16_bf16(PAF(2),VFR(2),o[0],0,0,0), C1,0); \
    KRD(GL,3); GAPB(o[1]=__builtin_amdgcn_mfma_f32_32x32x16_bf16(PAF(2),VFR(6),o[1],0,0,0), C1,4); \
    GAPB(o[0]=__builtin_amdgcn_mfma_f32_32x32x16_bf16(PAF(3),VFR(3),o[0],0,0,0), C1,8); \
    GAPB(o[1]=__builtin_amdgcn_mfma_f32_32x32x16_bf16(PAF(3),VFR(7),o[1],0,0,0), C1,12); \
    }while(0)
  int t=1;
  #define CINIT0(C,t) do{}while(0)
  #define CINIT1(C,t) do{}while(0)
  #define CSRC(C) negm
  #define CPOST(C0,C1) do{}while(0)
  #define NEGM_UPD() do{ _Pragma("unroll") for(int r=0;r<16;++r)negm[r]=-mhat; asm volatile("":"+v"(negm)); }while(0)
  for(;t+7<NT;t+=2){
    STEP(pB0,pB1,pA0,pA1,t,true,true,true);     WAIT_BAR(2); RESC(); ROT();
    STEP(pA0,pA1,pB0,pB1,t+1,true,true,true);   WAIT_BAR(2); RESC(); ROT();
  }
  #undef CINIT0
  #undef CINIT1
  #undef CSRC
  #undef CPOST
  #undef NEGM_UPD
  #define NEGM_UPD() do{}while(0)
  #define CINIT0(C,t) do{const int dist_=wc2+(NT-4-(t)); binit1(C,dist_,dtl-64*dist_);}while(0)
  #define CINIT1(C,t) do{const int dist_=wc2+(NT-4-(t)); binit1(C,dist_,dtl-64*dist_+32);}while(0)
  #define CSRC(C) C
  #define CPOST(C0,C1) bpost(C0,C1,mhat)
  #define ENDW(tt) do{ if((tt)+3<NT){WAIT_BAR(2);} else if((tt)+2<NT){WAIT_BAR(1);} else {WAIT_BAR(0);} }while(0)
  for(;t+1<NT;t+=2){
    STEP(pB0,pB1,pA0,pA1,t,(t+3<NT),(t+1<NT),(t+1<NT));       ENDW(t);   RESC(); ROT();
    STEP(pA0,pA1,pB0,pB1,t+1,(t+4<NT),(t+2<NT),(t+2<NT));     ENDW(t+1); RESC(); ROT();
  }
  STEP(pB0,pB1,pA0,pA1,NT-1,false,false,false); RESC();
  { float sacc=pB0[0]+pB0[1]; _Pragma("unroll") for(int r=2;r<16;++r)sacc+=pB0[r]; _Pragma("unroll") for(int r=0;r<16;++r)sacc+=pB1[r]; l_reg+=sacc;
    pw0=(u32x4){PKW(pB0,0),PKW(pB0,2),PKW(pB0,4),PKW(pB0,6)};pw1=(u32x4){PKW(pB0,8),PKW(pB0,10),PKW(pB0,12),PKW(pB0,14)};pw2=(u32x4){PKW(pB1,0),PKW(pB1,2),PKW(pB1,4),PKW(pB1,6)};pw3=(u32x4){PKW(pB1,8),PKW(pB1,10),PKW(pB1,12),PKW(pB1,14)};
    SBAR(); pv(o,vb0+sl_cur,PAF(0),PAF(1),PAF(2),PAF(3)); }
  #undef PKW
  #undef PAF
  #undef VFR
  #undef PIN
  #undef MX3
  #undef GAPA
  #undef GAPB
  #undef EX
  #undef VRD
  #undef KRD
  #undef STEP
  #undef ENDW
  {auto rr=__builtin_amdgcn_permlane32_swap(__float_as_uint(l_reg),__float_as_uint(l_reg),false,false);l_reg=__uint_as_float(rr[0])+__uint_as_float(rr[1]);}
  if(hi==0)wsf[32+r32]=l_reg;asm volatile("s_waitcnt lgkmcnt(0)":::"memory");
  float rli[16];
  #pragma unroll
  for(int r=0;r<16;++r)rli[r]=__builtin_amdgcn_rcpf(wsf[32+crow(r,hi)]);
  bf16*Ow=O+(rowbase+q0+wid*QBLK)*PO+ocol;
  { bf16*stg=(bf16*)(shm+LDS_OST)+wid*2048;
    #pragma unroll
    for(int r=0;r<16;++r){const int orow=crow(r,hi);
      #pragma unroll
      for(int d0=0;d0<2;++d0)stg[orow*64+d0*32+r32]=__float2bfloat16(o[d0][r]*rli[r]);}
    asm volatile("s_waitcnt lgkmcnt(0)":::"memory");
    #pragma unroll
    for(int i=0;i<4;++i){const int row=i*8+(lane>>3),ch=lane&7; const u32x4 v=*(const u32x4*)(stg+row*64+ch*8); ATTN_STORE16(Ow+(long)row*PO+ch*8,v);} }
  asm volatile("s_waitcnt lgkmcnt(0)\n\ts_barrier":::"memory");
  #undef DMA_K
  #undef DMA_V
  #undef CINIT0
  #undef CINIT1
  #undef CSRC
  #undef CPOST
  #undef NEGM_UPD
  #undef START
  #undef RESC
  #undef ROT
}
constexpr int ATTN_LDS_BYTES=LDS_BYTES+1024;
#undef SBAR
#undef WAIT_BAR
}

namespace cg = cooperative_groups;
constexpr int NWAVES = 8, NTHREADS = 512;
constexpr int MTOT = 33280, MPR = 32768, MSA = 512;
constexpr int DM = 1024, TP = 4096, TS = 16, NBP = 8, NBS = 32, PAST = 4096;
constexpr float EPS = 1e-6f, LOG2E = 1.4426950408889634f;
constexpr float LAM_INIT = 0.2f;
constexpr size_t O_YP = 0, O_YS = 33554432, O_KP = 34078720, O_VP = 50855936, O_CP = 67633152, O_MK = 67756032, O_MV = 68804608, O_KS = 69853184, O_VS = 70115328, O_CS = 70377472, O_END = 70868992;
constexpr size_t MiB = 1u << 20;
constexpr size_t WS_RS0 = 1 * MiB, WS_RSM = 1 * MiB + 256 * 1024, WS_SSP1 = 2 * MiB, WS_SSP2 = 5 * MiB, WS_QSS = 8 * MiB;
constexpr size_t WS_W1T = 12 * MiB, WS_WOT = 17 * MiB, WS_WMQT = 19 * MiB, WS_WMKVT = 20 * MiB, WS_WMOT = 22 * MiB, WS_WF1T = 23 * MiB, WS_WF2T = 31 * MiB;
constexpr size_t WS_MEMB = 40 * MiB, WS_MKB = 44 * MiB, WS_MVB = 54 * MiB;
constexpr size_t WS_XB = 64 * MiB, WS_Q = 130 * MiB, WS_KB = 163 * MiB, WS_VB = 196 * MiB, WS_C = 229 * MiB, WS_A3 = 294 * MiB, WS_OA = 360 * MiB;
constexpr size_t WS_X1 = 490 * MiB, WS_X1B = 620 * MiB, WS_QM = 685 * MiB, WS_OM = 718 * MiB, WS_X2B = 751 * MiB, WS_END = 816 * MiB;
constexpr size_t WS_U = 64 * MiB;
static_assert(WS_U + (size_t)MTOT * 4096 * 2 <= WS_OA, "U overlay");
#ifndef PHMASK
#define PHMASK 0xFFFFF
#endif
#define PH(k) ((PHMASK >> (k)) & 1)
constexpr int LDS_BYTES = 147456;

#define LAS __attribute__((address_space(3)))
typedef unsigned short bf16;
typedef unsigned v4u __attribute__((ext_vector_type(4)));
typedef unsigned v2u __attribute__((ext_vector_type(2)));
typedef float f32x4 __attribute__((ext_vector_type(4)));
__device__ __forceinline__ unsigned f2bf(float f) { unsigned u = __builtin_bit_cast(unsigned, f); return (u + 0x7fffu + ((u >> 16) & 1u)) >> 16; }
__device__ __forceinline__ unsigned pk2(float lo, float hi) { return f2bf(lo) | (f2bf(hi) << 16); }
__device__ __forceinline__ float bf2f(unsigned h) { return __builtin_bit_cast(float, h << 16); }
__device__ __forceinline__ float wave_sum(float v) {
#pragma unroll
    for (int o = 1; o < 64; o <<= 1) v += __shfl_xor(v, o);
    return v;
}
__device__ __forceinline__ void unpack8(const v4u w, float* f) { f[0] = bf2f(w.x & 0xffffu); f[1] = bf2f(w.x >> 16); f[2] = bf2f(w.y & 0xffffu); f[3] = bf2f(w.y >> 16); f[4] = bf2f(w.z & 0xffffu); f[5] = bf2f(w.z >> 16); f[6] = bf2f(w.w & 0xffffu); f[7] = bf2f(w.w >> 16); }

struct Params { const float* in[31]; float* out; unsigned char* ws; };
enum { I_XP = 0, I_XS, I_CK, I_CV, I_CC, I_CMK, I_CMV, I_MEM, I_REL, I_GMIX, I_WIN, I_GQ, I_GK, I_LAM, I_GSUB, I_WCONV, I_BCONV, I_LNG, I_LNB, I_WOUT, I_GCROSS, I_GMEM, I_WMQ, I_WMK, I_WMV, I_GMQ, I_GMK, I_WMO, I_GFFN, I_WFF1, I_WFF2 };

__device__ __forceinline__ int rel_bucket(int rel) {
    const int n = rel < 0 ? -rel : rel; const int lg = n < 8 ? n : min(15, 2 + (31 - __clz(n * n)));
    return (rel > 0 ? 16 : 0) + lg;
}
#define RDL(x, d) __builtin_bit_cast(float, __builtin_amdgcn_readlane(__builtin_bit_cast(int, (x)), (d)))
__device__ __forceinline__ float compute_lam(const float* lv, int lane) {
    const float a = wave_sum(lv[lane] * lv[64 + lane]), b = wave_sum(lv[128 + lane] * lv[192 + lane]);
    return __expf(a) - __expf(b) + LAM_INIT;
}

__device__ __forceinline__ void p0_transpose_item(const float* W, int K, int N, const float* gain, bf16* WT, int dst_row0, LAS float* scr, int k0, int n0, int lane) {
#pragma unroll 8
    for (int i = 0; i < 32; ++i) { const int kk = 2 * i + (lane >> 5); const float g = gain ? gain[k0 + kk] : 1.0f; scr[kk * 33 + (lane & 31)] = W[(size_t)(k0 + kk) * N + n0 + (lane & 31)] * g; }
    asm volatile("s_waitcnt lgkmcnt(0)" ::: "memory");
    const int c = lane & 7;
#pragma unroll
    for (int j = 0; j < 4; ++j) { const int n = (lane >> 3) + 8 * j; const LAS float* s = scr + (8 * c) * 33 + n;
        v4u o; o.x = pk2(s[0 * 33], s[1 * 33]); o.y = pk2(s[2 * 33], s[3 * 33]); o.z = pk2(s[4 * 33], s[5 * 33]); o.w = pk2(s[6 * 33], s[7 * 33]);
        *(v4u*)(WT + (size_t)(dst_row0 + n) * K + k0 + 8 * c) = o; }
    asm volatile("s_waitcnt lgkmcnt(0)" ::: "memory");
}
__device__ __forceinline__ int w1_row(int a) {
    if (a < 1024) { const int pn = a >> 8, wc = (a >> 6) & 3, bj = (a >> 5) & 1; return 256 * pn + 128 * bj + 32 * wc; }
    if (a < 1536) return a;
    const int g = a >= 2048, ch = a - (g ? 2048 : 1536), t = ch >> 7, wc = (ch >> 5) & 3; return 1536 + 256 * t + 128 * g + 32 * wc;
}
__device__ __forceinline__ void row_to_bf16_rs(const float* xrow, bf16* orow, float* rs_out, int lane) {
    const f32x4* xr = (const f32x4*)xrow + lane; f32x4 v[4]; float s = 0.f;
#pragma unroll
    for (int j = 0; j < 4; ++j) { v[j] = xr[64 * j]; s += (v[j].x * v[j].x + v[j].y * v[j].y) + (v[j].z * v[j].z + v[j].w * v[j].w); }
    s = wave_sum(s);
    unsigned long long* o8 = (unsigned long long*)orow + lane;
#pragma unroll
    for (int j = 0; j < 4; ++j) o8[64 * j] = (unsigned long long)pk2(v[j].x, v[j].y) | ((unsigned long long)pk2(v[j].z, v[j].w) << 32);
    if (lane == 0) *rs_out = 1.0f / sqrtf(s * (1.0f / 1024.0f) + EPS);
}

__global__ void __launch_bounds__(NTHREADS, 2) fwd_kernel(Params p) {
    extern __shared__ __attribute__((aligned(16))) unsigned char lds_raw[];
    LAS unsigned char* lds = (LAS unsigned char*)lds_raw;
    cg::grid_group grid = cg::this_grid();
    const int tid = threadIdx.x, lane = tid & 63, wave = __builtin_amdgcn_readfirstlane(tid >> 6);
    const int G = gridDim.x, gw = blockIdx.x * NWAVES + wave, NGW = G * NWAVES;
    unsigned char* ws = p.ws; float* out = p.out;
    float* RS0 = (float*)(ws + WS_RS0); float* RSM = (float*)(ws + WS_RSM); float* SSP1 = (float*)(ws + WS_SSP1); float* SSP2 = (float*)(ws + WS_SSP2);
    bf16* W1T = (bf16*)(ws + WS_W1T); bf16* WOT = (bf16*)(ws + WS_WOT); bf16* WMQT = (bf16*)(ws + WS_WMQT); bf16* WMKVT = (bf16*)(ws + WS_WMKVT); bf16* WMOT = (bf16*)(ws + WS_WMOT);
    bf16* WF1T = (bf16*)(ws + WS_WF1T); bf16* WF2T = (bf16*)(ws + WS_WF2T); bf16* MEMB = (bf16*)(ws + WS_MEMB);
    bf16* XB = (bf16*)(ws + WS_XB); bf16* QB = (bf16*)(ws + WS_Q); bf16* KB = (bf16*)(ws + WS_KB); bf16* VB = (bf16*)(ws + WS_VB); float* CB = (float*)(ws + WS_C);
    bf16* A3 = (bf16*)(ws + WS_A3); float* OA = (float*)(ws + WS_OA); bf16* OAB = (bf16*)(ws + WS_OA); float* X1 = (float*)(ws + WS_X1); bf16* X1B = (bf16*)(ws + WS_X1B); bf16* QM = (bf16*)(ws + WS_QM); bf16* OM = (bf16*)(ws + WS_OM);
    bf16* X2B = (bf16*)(ws + WS_X2B); bf16* UB = (bf16*)(ws + WS_U);

    if constexpr (PH(0)) {
        LAS float* scr = (LAS float*)(lds + wave * 16384);
        constexpr int I1 = 16 * 80, I2 = 16 * 32, I3 = 16 * 16, I6 = 8 * 32, I7 = 16 * 128, I8 = 64 * 32;
        constexpr int NITEMS = I1 + I2 + 3 * I3 + I6 + I7 + I8;
        for (int it = gw; it < NITEMS; it += NGW) {
            int r = it;
            if (r < I1) { const int kb = r / 80, nb = r % 80; p0_transpose_item(p.in[I_WIN], 1024, 2560, p.in[I_GMIX], W1T, w1_row(32 * nb), scr, 64 * kb, 32 * nb, lane); continue; } r -= I1;
            if (r < I2) { const int kb = r / 32, nb = r % 32; p0_transpose_item(p.in[I_WOUT], 1024, 1024, nullptr, WOT, 32 * nb, scr, 64 * kb, 32 * nb, lane); continue; } r -= I2;
            if (r < I3) { const int kb = r / 16, nb = r % 16; p0_transpose_item(p.in[I_WMQ], 1024, 512, p.in[I_GCROSS], WMQT, 32 * nb, scr, 64 * kb, 32 * nb, lane); continue; } r -= I3;
            if (r < I3) { const int kb = r / 16, nb = r % 16; p0_transpose_item(p.in[I_WMK], 1024, 512, p.in[I_GMEM], WMKVT, 32 * nb, scr, 64 * kb, 32 * nb, lane); continue; } r -= I3;
            if (r < I3) { const int kb = r / 16, nb = r % 16; p0_transpose_item(p.in[I_WMV], 1024, 512, p.in[I_GMEM], WMKVT, 512 + 32 * nb, scr, 64 * kb, 32 * nb, lane); continue; } r -= I3;
            if (r < I6) { const int kb = r / 32, nb = r % 32; p0_transpose_item(p.in[I_WMO], 512, 1024, nullptr, WMOT, 32 * nb, scr, 64 * kb, 32 * nb, lane); continue; } r -= I6;
            if (r < I7) { const int kb = r / 128, nb = r % 128; p0_transpose_item(p.in[I_WFF1], 1024, 4096, p.in[I_GFFN], WF1T, 32 * nb, scr, 64 * kb, 32 * nb, lane); continue; } r -= I7;
            { const int kb = r / 32, nb = r % 32; p0_transpose_item(p.in[I_WFF2], 4096, 1024, nullptr, WF2T, 32 * nb, scr, 64 * kb, 32 * nb, lane); }
        }
        for (int m = gw; m < MTOT + 2048; m += NGW) {
            if (m < MPR) row_to_bf16_rs(p.in[I_XP] + (size_t)m * 1024, XB + (size_t)m * 1024, RS0 + m, lane);
            else if (m < MTOT) row_to_bf16_rs(p.in[I_XS] + (size_t)(m - MPR) * 1024, XB + (size_t)m * 1024, RS0 + m, lane);
            else row_to_bf16_rs(p.in[I_MEM] + (size_t)(m - MTOT) * 1024, MEMB + (size_t)(m - MTOT) * 1024, RSM + (m - MTOT), lane);
        }
    }
    grid.sync();

    if constexpr (PH(1)) {
        pg8::Gemm g{XB, W1T, MTOT, 2560, 1024}; pg8::StaticOrder S; S.init(MTOT, 2560, G, (int)blockIdx.x);
        pg8::EpiG1 E{RS0, p.in[I_GQ], p.in[I_GK], QB, KB, VB, CB, out + O_KP, out + O_KS, out + O_VP, out + O_VS};
        pg8::gemm_phase<pg8::EpiG1, pg8::StaticOrder, true, true>(lds, g, S, E);
    }
    if constexpr (PH(2)) {
        pg8::Gemm g{MEMB, WMKVT, 2048, 1024, 1024}; pg8::StaticOrder S; S.init(2048, 1024, G, (int)((blockIdx.x + 128) % G));
        pg8::EpiMem E{RSM, out + O_MK, out + O_MV};
        pg8::gemm_phase<pg8::EpiMem, pg8::StaticOrder, true, true>(lds, g, S, E);
    }
    grid.sync();

    if constexpr (PH(3)) for (int r = gw; r < 2048; r += NGW) {
        float* mk = out + O_MK + (size_t)r * 512 + lane * 8; f32x4 a = *(f32x4*)mk, b = *(f32x4*)(mk + 4);
        float ss = (a.x * a.x + a.y * a.y) + (a.z * a.z + a.w * a.w) + (b.x * b.x + b.y * b.y) + (b.z * b.z + b.w * b.w);
        ss += __shfl_xor(ss, 1); ss += __shfl_xor(ss, 2); ss += __shfl_xor(ss, 4); ss += __shfl_xor(ss, 8);
        const float rstd = 1.0f / sqrtf(ss * (1.0f / 128.0f) + EPS); const float* g = p.in[I_GMK] + (lane & 15) * 8;
        const f32x4 g0 = *(const f32x4*)g, g1 = *(const f32x4*)(g + 4);
        *(f32x4*)mk = a * g0 * rstd; *(f32x4*)(mk + 4) = b * g1 * rstd;
    }
    if constexpr (PH(4)) for (int r = gw; r < MTOT; r += NGW) {
        const bool smp = r >= MPR; const int b = smp ? (r - MPR) >> 4 : r >> 12, t = smp ? (r - MPR) & 15 : r & 4095, rb = smp ? MPR + b * 16 : b * 4096, ch0 = lane * 8;
        float acc[8];
        { const f32x4 b0 = *(const f32x4*)(p.in[I_BCONV] + ch0), b1 = *(const f32x4*)(p.in[I_BCONV] + ch0 + 4); acc[0] = b0.x; acc[1] = b0.y; acc[2] = b0.z; acc[3] = b0.w; acc[4] = b1.x; acc[5] = b1.y; acc[6] = b1.z; acc[7] = b1.w; }
        for (int j = 0; j < 31; ++j) { const int tt = t - 30 + j; const float* src;
            if (tt >= 0) src = CB + (size_t)(rb + tt) * 512 + ch0; else if (smp) src = p.in[I_CC] + (size_t)(b * 30 + 30 + tt) * 512 + ch0; else continue;
            const f32x4 c0 = *(const f32x4*)src, c1 = *(const f32x4*)(src + 4), w0 = *(const f32x4*)(p.in[I_WCONV] + j * 512 + ch0), w1 = *(const f32x4*)(p.in[I_WCONV] + j * 512 + ch0 + 4);
            acc[0] += c0.x * w0.x; acc[1] += c0.y * w0.y; acc[2] += c0.z * w0.z; acc[3] += c0.w * w0.w; acc[4] += c1.x * w1.x; acc[5] += c1.y * w1.y; acc[6] += c1.z * w1.z; acc[7] += c1.w * w1.w; }
        float s = 0.f;
#pragma unroll
        for (int e = 0; e < 8; ++e) s += acc[e];
        const float mean = wave_sum(s) * (1.0f / 512.0f); float q = 0.f;
#pragma unroll
        for (int e = 0; e < 8; ++e) { acc[e] -= mean; q += acc[e] * acc[e]; }
        const float rstd = 1.0f / sqrtf(wave_sum(q) * (1.0f / 512.0f) + EPS);
        float y[8];
#pragma unroll
        for (int e = 0; e < 8; ++e) { const float v = acc[e] * rstd * p.in[I_LNG][ch0 + e] + p.in[I_LNB][ch0 + e]; y[e] = v / (1.0f + __expf(-v)); }
        v4u o; o.x = pk2(y[0], y[1]); o.y = pk2(y[2], y[3]); o.z = pk2(y[4], y[5]); o.w = pk2(y[6], y[7]);
        *(v4u*)(A3 + (size_t)r * 1024 + 512 + ch0) = o;
    }
    if constexpr (PH(5)) for (int it = gw; it < (NBP + NBS) * 30; it += NGW) {
        const float* src; float* dst;
        if (it < NBP * 30) { const int b = it / 30, i = it % 30; src = CB + (size_t)(b * 4096 + 4066 + i) * 512; dst = out + O_CP + (size_t)it * 512; }
        else { const int k = it - NBP * 30, b = k / 30, i = k % 30; src = i < 14 ? p.in[I_CC] + (size_t)(b * 30 + 16 + i) * 512 : CB + (size_t)(MPR + b * 16 + i - 14) * 512; dst = out + O_CS + (size_t)k * 512; }
        *(f32x4*)(dst + lane * 8) = *(const f32x4*)(src + lane * 8); *(f32x4*)(dst + lane * 8 + 4) = *(const f32x4*)(src + lane * 8 + 4);
    }
    {
        const float* rel = p.in[I_REL];
        if constexpr (PH(6)) {
            const int vcu = (G % 8 == 0) ? ((int)blockIdx.x % 8) * (G / 8) + (int)blockIdx.x / 8 : (int)blockIdx.x;
            for (int P = vcu; P < 1024; P += G) {
                const int bhv = P >> 3, s = P & 7, b = bhv >> 4, hm = (bhv >> 1) & 7, vh = bhv & 1;
#pragma unroll 1
                for (int k = 0; k < 2; ++k)
                    attn_body::attn_unit<8>(b, hm * 64, hm * 64, (hm >> 1) * 128 + vh * 64, hm * 128 + vh * 64, k ? 15 - s : s, hm >> 1, rel,
                                            (const attn_body::bf16*)QB, (const attn_body::bf16*)KB, (const attn_body::bf16*)VB, (attn_body::bf16*)OAB, (char*)lds_raw);
            }
        }
        if constexpr (PH(7)) for (int it = gw; it < NBS * 16; it += NGW) {
            const int b = it >> 4, hm = (it >> 1) & 7, vh = it & 1, h = hm >> 1, i = lane & 15, r = MPR + b * 16 + i;
            float q[64];
#pragma unroll
            for (int c = 0; c < 8; ++c) unpack8(*(const v4u*)(QB + (size_t)r * 512 + hm * 64 + c * 8), q + c * 8);
            float mx = -1e30f, l = 0.f, o[64];
#pragma unroll
            for (int e = 0; e < 64; ++e) o[e] = 0.f;
            const float* Kc = p.in[I_CK] + (size_t)b * PAST * 512 + hm * 64 + lane; const float* Vc = p.in[I_CV] + (size_t)b * PAST * 512 + h * 128 + vh * 64 + lane;
            const float* Kn = out + O_KS + (size_t)b * 16 * 512 + hm * 64 + lane; const float* Vn = out + O_VS + (size_t)b * 16 * 512 + h * 128 + vh * 64 + lane;
#pragma unroll 1
            for (int j0 = 0; j0 < PAST + 16; j0 += 4) {
                float kk[4], vv[4];
#pragma unroll
                for (int jj = 0; jj < 4; ++jj) { const int j = j0 + jj; kk[jj] = j < PAST ? Kc[(size_t)j * 512] : Kn[(size_t)(j - PAST) * 512]; vv[jj] = j < PAST ? Vc[(size_t)j * 512] : Vn[(size_t)(j - PAST) * 512]; }
#pragma unroll
                for (int jj = 0; jj < 4; ++jj) { float a = 0.f;
#pragma unroll
                    for (int d = 0; d < 64; ++d) a += q[d] * RDL(kk[jj], d);
                    const float sc = a + rel[rel_bucket(j0 + jj - (PAST + i)) * 4 + h] * LOG2E;
                    if (sc > mx) { const float f = exp2f(mx - sc); l *= f;
#pragma unroll
                        for (int e = 0; e < 64; ++e) o[e] *= f;
                        mx = sc; }
                    const float pr = exp2f(sc - mx); l += pr;
#pragma unroll
                    for (int e = 0; e < 64; ++e) o[e] += pr * RDL(vv[jj], e); }
            }
            const float il = 1.0f / l; float* od = OA + (size_t)r * 1024 + hm * 128 + vh * 64;
            if (lane < 16) {
#pragma unroll
                for (int c = 0; c < 16; ++c) *(f32x4*)(od + 4 * c) = (f32x4){o[4 * c] * il, o[4 * c + 1] * il, o[4 * c + 2] * il, o[4 * c + 3] * il}; }
        }
    }
    grid.sync();
    if constexpr (PH(8)) {
        const float lam = compute_lam(p.in[I_LAM], lane);
        for (int r = gw; r < MTOT; r += NGW) {
            const int h = lane >> 4, e0 = (lane & 15) * 8; f32x4 a0, a1, b0, b1;
            if (r < MPR) { float fa[8], fb[8]; unpack8(*(const v4u*)(OAB + (size_t)r * 1024 + (2 * h) * 128 + e0), fa); unpack8(*(const v4u*)(OAB + (size_t)r * 1024 + (2 * h + 1) * 128 + e0), fb);
                a0 = (f32x4){fa[0], fa[1], fa[2], fa[3]}; a1 = (f32x4){fa[4], fa[5], fa[6], fa[7]}; b0 = (f32x4){fb[0], fb[1], fb[2], fb[3]}; b1 = (f32x4){fb[4], fb[5], fb[6], fb[7]}; }
            else { const float* o0 = OA + (size_t)r * 1024 + (2 * h) * 128 + e0; const float* o1 = o0 + 128; a0 = *(const f32x4*)o0; a1 = *(const f32x4*)(o0 + 4); b0 = *(const f32x4*)o1; b1 = *(const f32x4*)(o1 + 4); }
            const f32x4 d0 = a0 - b0 * lam, d1 = a1 - b1 * lam;
            float ss = (d0.x * d0.x + d0.y * d0.y) + (d0.z * d0.z + d0.w * d0.w) + (d1.x * d1.x + d1.y * d1.y) + (d1.z * d1.z + d1.w * d1.w);
            ss += __shfl_xor(ss, 1); ss += __shfl_xor(ss, 2); ss += __shfl_xor(ss, 4); ss += __shfl_xor(ss, 8);
            const float sc = (1.0f - LAM_INIT) / sqrtf(ss * (1.0f / 128.0f) + EPS); const f32x4 g0 = *(const f32x4*)(p.in[I_GSUB] + e0), g1 = *(const f32x4*)(p.in[I_GSUB] + e0 + 4);
            const f32x4 y0 = d0 * g0 * sc, y1 = d1 * g1 * sc;
            v4u o; o.x = pk2(y0.x, y0.y); o.y = pk2(y0.z, y0.w); o.z = pk2(y1.x, y1.y); o.w = pk2(y1.z, y1.w);
            *(v4u*)(A3 + (size_t)r * 1024 + h * 128 + e0) = o;
        }
    }
    grid.sync();
    if constexpr (PH(9)) {
        pg8::Gemm g{A3, WOT, MTOT, 1024, 1024}; pg8::StaticOrder S; S.init(MTOT, 1024, G, (int)blockIdx.x);
        pg8::EpiRes E{p.in[I_XP], p.in[I_XS], X1, X1B, SSP1};
        pg8::gemm_phase<pg8::EpiRes, pg8::StaticOrder, true, true>(lds, g, S, E);
    }
    grid.sync();
    if constexpr (PH(10)) {
        pg8::Gemm g{X1B, WMQT, MTOT, 512, 1024}; pg8::StaticOrder S; S.init(MTOT, 512, G, (int)blockIdx.x);
        pg8::EpiScaleBf16<0> E{SSP1, QM, 512};
        pg8::gemm_phase<pg8::EpiScaleBf16<0>, pg8::StaticOrder, true, true>(lds, g, S, E);
    }
    grid.sync();
    if constexpr (PH(11)) for (int it = gw; it < (MTOT / 16) * 4; it += NGW) {
        const int grp = it >> 2, head = it & 3, i = lane & 15, sp = lane >> 4, r = grp * 16 + i;
        const float* mkb; const float* mvb;
        if (grp < 2048) { const int bb = grp >> 8; mkb = out + O_MK + (size_t)bb * 256 * 512; mvb = out + O_MV + (size_t)bb * 256 * 512; }
        else { const int bb = grp - 2048; mkb = p.in[I_CMK] + (size_t)bb * 256 * 512; mvb = p.in[I_CMV] + (size_t)bb * 256 * 512; }
        mkb += head * 128 + sp * 32; mvb += head * 128 + sp * 32;
        float q[32]; float ss = 0.f;
#pragma unroll
        for (int c = 0; c < 4; ++c) unpack8(*(const v4u*)(QM + (size_t)r * 512 + head * 128 + sp * 32 + c * 8), q + c * 8);
#pragma unroll
        for (int d = 0; d < 32; ++d) ss += q[d] * q[d];
        ss += __shfl_xor(ss, 16); ss += __shfl_xor(ss, 32);
        const float qs = (1.0f / sqrtf(ss * (1.0f / 128.0f) + EPS)) * (0.08838834764831845f * LOG2E);
#pragma unroll
        for (int d = 0; d < 32; ++d) q[d] *= qs * p.in[I_GMQ][sp * 32 + d];
        float mx = -1e30f, l = 0.f, o[32];
#pragma unroll
        for (int e = 0; e < 32; ++e) o[e] = 0.f;
#pragma unroll 1
        for (int j = 0; j < 256; ++j) {
            const f32x4* kr = (const f32x4*)(mkb + (size_t)j * 512); const f32x4* vr = (const f32x4*)(mvb + (size_t)j * 512);
            f32x4 kk[8], vv[8];
#pragma unroll
            for (int c = 0; c < 8; ++c) { kk[c] = kr[c]; vv[c] = vr[c]; }
            float a = 0.f;
#pragma unroll
            for (int c = 0; c < 8; ++c) a += (q[4 * c] * kk[c].x + q[4 * c + 1] * kk[c].y) + (q[4 * c + 2] * kk[c].z + q[4 * c + 3] * kk[c].w);
            a += __shfl_xor(a, 16); a += __shfl_xor(a, 32);
            if (a > mx) { const float f = exp2f(mx - a); l *= f;
#pragma unroll
                for (int e = 0; e < 32; ++e) o[e] *= f;
                mx = a; }
            const float pr = exp2f(a - mx); l += pr;
#pragma unroll
            for (int c = 0; c < 8; ++c) { o[4 * c] += pr * vv[c].x; o[4 * c + 1] += pr * vv[c].y; o[4 * c + 2] += pr * vv[c].z; o[4 * c + 3] += pr * vv[c].w; }
        }
        const float il = 1.0f / l; bf16* od = OM + (size_t)r * 512 + head * 128 + sp * 32;
#pragma unroll
        for (int c = 0; c < 4; ++c) { v4u w; w.x = pk2(o[8 * c] * il, o[8 * c + 1] * il); w.y = pk2(o[8 * c + 2] * il, o[8 * c + 3] * il); w.z = pk2(o[8 * c + 4] * il, o[8 * c + 5] * il); w.w = pk2(o[8 * c + 6] * il, o[8 * c + 7] * il); *(v4u*)(od + 8 * c) = w; }
    }
    grid.sync();
    if constexpr (PH(12)) {
        pg8::Gemm g{OM, WMOT, MTOT, 1024, 512}; pg8::StaticOrder S; S.init(MTOT, 1024, G, (int)blockIdx.x);
        pg8::EpiRes E{X1, X1 + (size_t)MPR * 1024, X1, X2B, SSP2};
        pg8::gemm_phase<pg8::EpiRes, pg8::StaticOrder, true, true>(lds, g, S, E);
    }
    grid.sync();
    if constexpr (PH(13)) {
        pg8::Gemm g{X2B, WF1T, MTOT, 4096, 1024}; pg8::StaticOrder S; S.init(MTOT, 4096, G, (int)blockIdx.x);
        pg8::EpiScaleBf16<1> E{SSP2, UB, 4096};
        pg8::gemm_phase<pg8::EpiScaleBf16<1>, pg8::StaticOrder, true, true>(lds, g, S, E);
    }
    grid.sync();
    if constexpr (PH(14)) {
        pg8::Gemm g{UB, WF2T, MTOT, 1024, 4096}; pg8::StaticOrder S; S.init(MTOT, 1024, G, (int)blockIdx.x);
        pg8::EpiOut E{X1, out + O_YP, out + O_YS};
        pg8::gemm_phase<pg8::EpiOut, pg8::StaticOrder, true, true>(lds, g, S, E);
    }
}

extern "C" void kernel_launch(void* const* d_in, const int* in_sizes, int n_in, void* d_out, int out_size, void* d_ws, size_t ws_size, hipStream_t stream) {
    static int grid = 0;
    if (grid == 0) {
        if (n_in != 31 || out_size != (int)O_END || ws_size < WS_END) { fprintf(stderr, "kernel_launch: unexpected shapes (n_in %d, out %d, ws %zu)\n", n_in, out_size, ws_size); grid = -1; return; }
        int dev = 0, cus = 0, per_cu = 0;
        hipGetDevice(&dev); hipDeviceGetAttribute(&cus, hipDeviceAttributeMultiprocessorCount, dev);
        if (hipFuncSetAttribute((const void*)fwd_kernel, hipFuncAttributeMaxDynamicSharedMemorySize, LDS_BYTES) != hipSuccess) { fprintf(stderr, "kernel_launch: hipFuncSetAttribute failed\n"); grid = -1; return; }
        if (hipOccupancyMaxActiveBlocksPerMultiprocessor(&per_cu, (const void*)fwd_kernel, NTHREADS, LDS_BYTES) != hipSuccess || per_cu < 1) { fprintf(stderr, "kernel_launch: occupancy query failed (%d)\n", per_cu); (void)hipGetLastError(); per_cu = 1; }
        if (per_cu > 1) per_cu = 1;
        grid = cus * per_cu;
        if (grid % 8 != 0 || grid < 8) { fprintf(stderr, "kernel_launch: unexpected CU count %d\n", cus); }
    }
    if (grid < 0) return;
    Params p{};
    for (int i = 0; i < 31; ++i) p.in[i] = (const float*)d_in[i];
    p.out = (float*)d_out; p.ws = (unsigned char*)d_ws;
    void* args[] = {&p};
    hipError_t e = hipLaunchCooperativeKernel((const void*)fwd_kernel, dim3(grid), dim3(NTHREADS), args, LDS_BYTES, stream);
    if (e != hipSuccess) fprintf(stderr, "kernel_launch: cooperative launch failed: %s (grid %d)\n", hipGetErrorString(e), grid);
}
```

```cpp
#include <hip/hip_runtime.h>
#include <hip/hip_cooperative_groups.h>
#include <cstdio>
#include <cstdint>
namespace pg8 {
#define PG8_LAS __attribute__((address_space(3)))
typedef unsigned short bf16_t;
typedef short bf16x8 __attribute__((ext_vector_type(8)));
typedef float f32x4 __attribute__((ext_vector_type(4)));
typedef unsigned u32x4 __attribute__((ext_vector_type(4)));
constexpr int BM = 256, BK = 64, HALF = 128, HTB = HALF * BK * 2  , STAGE_BYTES = 8 * HTB, NXCD = 8, WGM = 8;

__host__ __device__ __forceinline__ int lds_byte(int r, int c) { const int st = (r >> 4) * 2 + (c >> 5), rr = r & 15, cc = c & 31, ob = rr * 64 + cc * 2; return st * 1024 + (ob ^ (((ob >> 9) & 1) << 5)); }
__host__ __device__ __forceinline__ void stage_rc(int b, int& R, int& C) { const int st = b / 1024, sb = b % 1024, swz = sb ^ (((sb >> 9) & 1) << 5); R = (st >> 1) * 16 + swz / 64; C = (st & 1) * 32 + (swz % 64) / 2; }
__host__ __device__ __forceinline__ int perm32(int rho) { const int n = rho >> 4, i = rho & 15; return 8 * (i >> 2) + 4 * n + (i & 3); }

struct Unit { int pm, pn; };
struct Gemm { const bf16_t* A; const bf16_t* Bt; int M, N, K; };

struct StaticOrder {
    int nM, nN, nwg, G, c;
    __host__ __device__ void init(int M, int N, int G_, int c_) { nM = M / BM; nN = N / BM; nwg = nM * nN; G = G_; c = c_; }
    __host__ __device__ bool next(int i, Unit& u) const {
        const long L = (long)i * G + c; if (L >= nwg) return false;
        int wgid = (int)L; { const int q = nwg / NXCD, r = nwg % NXCD, xcd = wgid % NXCD, off = wgid / NXCD; wgid = (xcd < r ? xcd * (q + 1) : r * (q + 1) + (xcd - r) * q) + off; }
        const int nig = WGM * nN, gid = wgid / nig, fm = gid * WGM, gsz = (nM - fm) < WGM ? (nM - fm) : WGM;
        u.pm = fm + ((wgid % nig) % gsz); u.pn = (wgid % nig) / gsz; return true;
    }
    __device__ __forceinline__ void a_ready(const Unit&) const {}
    __device__ __forceinline__ void done(const Unit&) const {}
};

__device__ __forceinline__ unsigned cvt_pk_bf16(float lo, float hi) { unsigned r; asm volatile("v_cvt_pk_bf16_f32 %0, %1, %2" : "=v"(r) : "v"(lo), "v"(hi)); return r; }
typedef float f32x2 __attribute__((ext_vector_type(2)));

constexpr int MP = 32768;
constexpr float EPSN = 1e-6f;
constexpr float QC2 = 0.125f * 1.4426950408889634f;
__device__ __forceinline__ void st_bf16x8(bf16_t* p, const f32x4 a, const f32x4 b) { u32x4 w; w.x = cvt_pk_bf16(a[0], a[1]); w.y = cvt_pk_bf16(a[2], a[3]); w.z = cvt_pk_bf16(b[0], b[1]); w.w = cvt_pk_bf16(b[2], b[3]); *(u32x4*)p = w; }
__device__ __forceinline__ float dot4(const f32x4 a) { return (a[0] * a[0] + a[1] * a[1]) + (a[2] * a[2] + a[3] * a[3]); }

struct EpiG1 {
    static constexpr bool PERM = true, AFTER_DRAIN = false;
    const float* rs; const float* gq; const float* gk;
    bf16_t* Q; bf16_t* KB; bf16_t* VB; float* C;
    float* kp; float* ks; float* vp; float* vs;
    __device__ __forceinline__ void operator()(const f32x4 (&acc)[2][2][4][2], const Unit& u, int wr, int wc, int fr, int fq) const {
        const int pn = u.pn;
#pragma unroll
        for (int ai = 0; ai < 2; ++ai)
#pragma unroll
            for (int m = 0; m < 4; ++m) {
                const int r = u.pm * BM + ai * HALF + wr * 64 + m * 16 + fr;
                const float rsv = rs[r];
                if (pn < 4) {
                    f32x4 v[2][2]; float ss = 0.f;
#pragma unroll
                    for (int bj = 0; bj < 2; ++bj)
#pragma unroll
                        for (int n = 0; n < 2; ++n) { v[bj][n] = acc[ai][bj][m][n] * rsv; ss += dot4(v[bj][n]); }
                    ss += __shfl_xor(ss, 16); ss += __shfl_xor(ss, 32);
                    const float rstd = 1.0f / sqrtf(ss * (1.0f / 64.0f) + EPSN);
                    const float* g = pn < 2 ? gq : gk; const float sc = pn < 2 ? rstd * QC2 : rstd;
                    const int grp = 4 * (pn & 1) + wc;
#pragma unroll
                    for (int bj = 0; bj < 2; ++bj) {
                        const int d0 = 32 * bj + 8 * fq; const f32x4 g0 = *(const f32x4*)(g + d0), g1 = *(const f32x4*)(g + d0 + 4);
                        const f32x4 o0 = v[bj][0] * g0 * sc, o1 = v[bj][1] * g1 * sc; const int col = 64 * grp + d0;
                        if (pn < 2) st_bf16x8(Q + (size_t)r * 512 + col, o0, o1);
                        else { float* ko = (r < MP ? kp + (size_t)r * 512 : ks + (size_t)(r - MP) * 512) + col; *(f32x4*)ko = o0; *(f32x4*)(ko + 4) = o1; st_bf16x8(KB + (size_t)r * 512 + col, o0, o1); }
                    }
                } else if (pn < 6) {
#pragma unroll
                    for (int bj = 0; bj < 2; ++bj) {
                        const int col = 256 * (pn - 4) + 128 * bj + 32 * wc + 8 * fq; const f32x4 o0 = acc[ai][bj][m][0] * rsv, o1 = acc[ai][bj][m][1] * rsv;
                        float* vo = (r < MP ? vp + (size_t)r * 512 : vs + (size_t)(r - MP) * 512) + col; *(f32x4*)vo = o0; *(f32x4*)(vo + 4) = o1; st_bf16x8(VB + (size_t)r * 512 + col, o0, o1);
                    }
                } else {
                    const int ch = 128 * (pn - 6) + 32 * wc + 8 * fq;
#pragma unroll
                    for (int n = 0; n < 2; ++n) { const f32x4 a = acc[ai][0][m][n] * rsv, gt = acc[ai][1][m][n] * rsv; f32x4 c;
#pragma unroll
                        for (int e = 0; e < 4; ++e) c[e] = a[e] / (1.0f + __expf(-gt[e]));
                        *(f32x4*)(C + (size_t)r * 512 + ch + 4 * n) = c; }
                }
            }
    }
};
struct EpiMem {
    static constexpr bool PERM = true, AFTER_DRAIN = false;
    const float* rs; float* mk; float* mv;
    __device__ __forceinline__ void operator()(const f32x4 (&acc)[2][2][4][2], const Unit& u, int wr, int wc, int fr, int fq) const {
        float* base = u.pn < 2 ? mk : mv; const int cb = 256 * (u.pn & 1);
#pragma unroll
        for (int ai = 0; ai < 2; ++ai)
#pragma unroll
            for (int m = 0; m < 4; ++m) { const int r = u.pm * BM + ai * HALF + wr * 64 + m * 16 + fr; const float rsv = rs[r];
#pragma unroll
                for (int bj = 0; bj < 2; ++bj) { float* o = base + (size_t)r * 512 + cb + 128 * bj + 32 * wc + 8 * fq; *(f32x4*)o = acc[ai][bj][m][0] * rsv; *(f32x4*)(o + 4) = acc[ai][bj][m][1] * rsv; } }
    }
};
struct EpiRes {
    static constexpr bool PERM = true, AFTER_DRAIN = false;
    const float* res_p; const float* res_s; float* xo; bf16_t* xb; float* ssp;
    __device__ __forceinline__ void operator()(const f32x4 (&acc)[2][2][4][2], const Unit& u, int wr, int wc, int fr, int fq) const {
#pragma unroll
        for (int ai = 0; ai < 2; ++ai)
#pragma unroll
            for (int m = 0; m < 4; ++m) { const int r = u.pm * BM + ai * HALF + wr * 64 + m * 16 + fr;
                const float* rr = r < MP ? res_p + (size_t)r * 1024 : res_s + (size_t)(r - MP) * 1024; float ss = 0.f;
#pragma unroll
                for (int bj = 0; bj < 2; ++bj) { const int col = 256 * u.pn + 128 * bj + 32 * wc + 8 * fq;
                    const f32x4 x0 = *(const f32x4*)(rr + col) + acc[ai][bj][m][0], x1 = *(const f32x4*)(rr + col + 4) + acc[ai][bj][m][1];
                    *(f32x4*)(xo + (size_t)r * 1024 + col) = x0; *(f32x4*)(xo + (size_t)r * 1024 + col + 4) = x1; st_bf16x8(xb + (size_t)r * 1024 + col, x0, x1); ss += dot4(x0) + dot4(x1); }
                ss += __shfl_xor(ss, 16); ss += __shfl_xor(ss, 32);
                if (fq == 0) ssp[(size_t)r * 16 + 4 * u.pn + wc] = ss; }
    }
};
__device__ __forceinline__ float row_rs(const float* ssp, int r) { const f32x4 a = *(const f32x4*)(ssp + (size_t)r * 16), b = *(const f32x4*)(ssp + (size_t)r * 16 + 4), c = *(const f32x4*)(ssp + (size_t)r * 16 + 8), d = *(const f32x4*)(ssp + (size_t)r * 16 + 12);
    const float s = ((a[0] + a[1]) + (a[2] + a[3])) + ((b[0] + b[1]) + (b[2] + b[3])) + ((c[0] + c[1]) + (c[2] + c[3])) + ((d[0] + d[1]) + (d[2] + d[3])); return 1.0f / sqrtf(s * (1.0f / 1024.0f) + EPSN); }
template <int ACT> struct EpiScaleBf16 {
    static constexpr bool PERM = true, AFTER_DRAIN = false;
    const float* ssp; bf16_t* O; int ldc;
    __device__ __forceinline__ void operator()(const f32x4 (&acc)[2][2][4][2], const Unit& u, int wr, int wc, int fr, int fq) const {
#pragma unroll
        for (int ai = 0; ai < 2; ++ai)
#pragma unroll
            for (int m = 0; m < 4; ++m) { const int r = u.pm * BM + ai * HALF + wr * 64 + m * 16 + fr; const float rsv = row_rs(ssp, r);
#pragma unroll
                for (int bj = 0; bj < 2; ++bj) { const int col = 256 * u.pn + 128 * bj + 32 * wc + 8 * fq; f32x4 o0 = acc[ai][bj][m][0] * rsv, o1 = acc[ai][bj][m][1] * rsv;
                    if (ACT == 1) {
#pragma unroll
                        for (int e = 0; e < 4; ++e) { const float a = fmaxf(o0[e], 0.f), b = fmaxf(o1[e], 0.f); o0[e] = a * a; o1[e] = b * b; } }
                    st_bf16x8(O + (size_t)r * ldc + col, o0, o1); } }
    }
};
struct EpiOut {
    static constexpr bool PERM = true, AFTER_DRAIN = false;
    const float* res; float* yp; float* ys;
    __device__ __forceinline__ void operator()(const f32x4 (&acc)[2][2][4][2], const Unit& u, int wr, int wc, int fr, int fq) const {
#pragma unroll
        for (int ai = 0; ai < 2; ++ai)
#pragma unroll
            for (int m = 0; m < 4; ++m) { const int r = u.pm * BM + ai * HALF + wr * 64 + m * 16 + fr;
                const float* rr = res + (size_t)r * 1024; float* yo = r < MP ? yp + (size_t)r * 1024 : ys + (size_t)(r - MP) * 1024;
#pragma unroll
                for (int bj = 0; bj < 2; ++bj) { const int col = 256 * u.pn + 128 * bj + 32 * wc + 8 * fq;
                    *(f32x4*)(yo + col) = *(const f32x4*)(rr + col) + acc[ai][bj][m][0]; *(f32x4*)(yo + col + 4) = *(const f32x4*)(rr + col + 4) + acc[ai][bj][m][1]; } }
    }
};
template <class Epi, class Sched, bool ALIGN_EPI = false, bool SP2 = false>
__device__ __forceinline__ void gemm_phase(PG8_LAS unsigned char* lds, const Gemm g, const Sched& S, const Epi& E) {
    int tid = threadIdx.x; asm volatile("" : "+v"(tid));
    const int wid = __builtin_amdgcn_readfirstlane(tid >> 6), lane = tid & 63, wr = wid >> 2, wc = wid & 3, fr = lane & 15, fq = lane >> 4;
    const int K = g.K, nt = K / BK;
    unsigned voffA[2], voffB[2];
#pragma unroll
    for (int i = 0; i < 2; ++i) { int R, C; stage_rc(tid * 16 + i * 8192, R, C); const int Rb = Epi::PERM ? ((R & ~31) + perm32(R & 31)) : R;
        voffA[i] = (unsigned)(R * K + C) * 2u; voffB[i] = (unsigned)(Rb * K + C) * 2u; }
    const size_t kstep = (size_t)(BK * 2);
    const size_t hstep = (size_t)HALF * K * 2;
    const size_t tstep = 2 * hstep;
    const unsigned ldsw = (unsigned)wid * 1024u;
    const int aoff = lds_byte(wr * 64 + fr, fq * 8), boff = lds_byte(wc * 32 + fr, fq * 8);
#define PG8_SA(b, h) (((b) * 2 + (h)) * HTB)
#define PG8_SB(b, h) ((4 + (b) * 2 + (h)) * HTB)
#define PG8_STAGE(bufoff, gbase, voff) do { _Pragma("unroll") for (int _i = 0; _i < 2; ++_i) \
        __builtin_amdgcn_global_load_lds((const unsigned*)((const char*)(gbase) + (voff)[_i]), (PG8_LAS unsigned*)(lds + (bufoff) + ldsw + _i * 8192), 16, 0, 0); } while (0)
#define PG8_LDA(dst, b, h) do { _Pragma("unroll") for (int m = 0; m < 4; ++m) _Pragma("unroll") for (int k = 0; k < 2; ++k) dst[m][k] = *(const PG8_LAS bf16x8*)(lds + PG8_SA(b, h) + aoff + m * 2048 + k * 1024); } while (0)
#define PG8_LDB(dst, b, h) do { _Pragma("unroll") for (int n = 0; n < 2; ++n) _Pragma("unroll") for (int k = 0; k < 2; ++k) dst[n][k] = *(const PG8_LAS bf16x8*)(lds + PG8_SB(b, h) + boff + n * 2048 + k * 1024); } while (0)
#define PG8_MMA(ai, bj, At, Bt) do { __builtin_amdgcn_s_setprio(1); _Pragma("unroll") for (int m = 0; m < 4; ++m) _Pragma("unroll") for (int n = 0; n < 2; ++n) _Pragma("unroll") for (int k = 0; k < 2; ++k) \
        acc[ai][bj][m][n] = __builtin_amdgcn_mfma_f32_16x16x32_bf16(Bt[n][k], At[m][k], acc[ai][bj][m][n], 0, 0, 0); __builtin_amdgcn_s_setprio(0); } while (0)
#define PG8_WAIT_V(n) asm volatile("s_waitcnt vmcnt(" #n ")" ::: "memory")
#define PG8_WAIT_L(n) asm volatile("s_waitcnt lgkmcnt(" #n ")" ::: "memory")
#define PG8_BAR __builtin_amdgcn_s_barrier()
#define PG8_SCHED __builtin_amdgcn_sched_barrier(0)
    Unit cur, nxt; int ui = 0;
    if (!S.next(0, cur)) return;
    f32x4 acc[2][2][4][2];
#pragma unroll
    for (int a = 0; a < 2; ++a)
#pragma unroll
        for (int b = 0; b < 2; ++b)
#pragma unroll
            for (int m = 0; m < 4; ++m)
#pragma unroll
                for (int n = 0; n < 2; ++n) acc[a][b][m][n] = (f32x4){0.f, 0.f, 0.f, 0.f};
    bf16x8 At[4][2], B0[2][2], B1[2][2];
    const char* cA = (const char*)g.A + (size_t)cur.pm * tstep; const char* cB = (const char*)g.Bt + (size_t)cur.pn * tstep;
    S.a_ready(cur);
    if constexpr (SP2) {
        PG8_STAGE(PG8_SB(0, 0), cB, voffB); PG8_STAGE(PG8_SB(0, 1), cB + hstep, voffB); PG8_STAGE(PG8_SA(0, 0), cA, voffA); PG8_STAGE(PG8_SA(0, 1), cA + hstep, voffA);
        if (wr == 1) PG8_BAR;
        PG8_WAIT_V(2); PG8_BAR;
        PG8_STAGE(PG8_SB(1, 0), cB + kstep, voffB); PG8_STAGE(PG8_SA(1, 0), cA + kstep, voffA); PG8_STAGE(PG8_SB(1, 1), cB + hstep + kstep, voffB);
        PG8_WAIT_V(6); PG8_BAR;
    } else {
        PG8_STAGE(PG8_SB(0, 0), cB, voffB); PG8_STAGE(PG8_SA(0, 0), cA, voffA); PG8_STAGE(PG8_SB(0, 1), cB + hstep, voffB); PG8_STAGE(PG8_SA(0, 1), cA + hstep, voffA);
        if (wr == 1) PG8_BAR;
        PG8_WAIT_V(4); PG8_BAR;
        PG8_STAGE(PG8_SB(1, 0), cB + kstep, voffB); PG8_STAGE(PG8_SA(1, 0), cA + kstep, voffA); PG8_STAGE(PG8_SB(1, 1), cB + hstep + kstep, voffB);
        PG8_WAIT_V(6); PG8_BAR;
    }
    for (;;) {
        const bool has_next = S.next(ui + 1, nxt);
        const char* nA = has_next ? (const char*)g.A + (size_t)nxt.pm * tstep : cA; const char* nB = has_next ? (const char*)g.Bt + (size_t)nxt.pn * tstep : cB;
        for (int t = 0; t < nt; t += 2) {
            const bool last = (t == nt - 2);
            const char* a1 = cA + (size_t)(t + 1) * kstep;
            const char* a2 = last ? nA : cA + (size_t)(t + 2) * kstep; const char* b2 = last ? nB : cB + (size_t)(t + 2) * kstep;
            const char* a3 = a2 + kstep; const char* b3 = b2 + kstep;
            if (last && has_next) S.a_ready(nxt);
            if constexpr (SP2) {
            PG8_LDB(B0, 0, 0); PG8_LDB(B1, 0, 1); PG8_SCHED; PG8_LDA(At, 0, 0); PG8_STAGE(PG8_SA(1, 1), a1 + hstep, voffA);
            PG8_WAIT_V(8); PG8_WAIT_L(0); PG8_BAR; PG8_MMA(0, 0, At, B0); PG8_MMA(0, 1, At, B1); PG8_BAR; PG8_SCHED;
            PG8_LDA(At, 0, 1); PG8_STAGE(PG8_SB(0, 0), b2, voffB); PG8_STAGE(PG8_SB(0, 1), b2 + hstep, voffB); PG8_STAGE(PG8_SA(0, 0), a2, voffA);
            PG8_WAIT_V(8); PG8_WAIT_L(0); PG8_BAR; PG8_MMA(1, 0, At, B0); PG8_MMA(1, 1, At, B1); PG8_BAR; PG8_SCHED;
            PG8_LDB(B0, 1, 0); PG8_LDB(B1, 1, 1); PG8_SCHED; PG8_LDA(At, 1, 0); PG8_STAGE(PG8_SA(0, 1), a2 + hstep, voffA);
            PG8_WAIT_V(8); PG8_WAIT_L(0); PG8_BAR; PG8_MMA(0, 0, At, B0); PG8_MMA(0, 1, At, B1); PG8_BAR; PG8_SCHED;
            PG8_LDA(At, 1, 1); PG8_STAGE(PG8_SB(1, 0), b3, voffB); PG8_STAGE(PG8_SB(1, 1), b3 + hstep, voffB); PG8_STAGE(PG8_SA(1, 0), a3, voffA);
            PG8_WAIT_V(8); PG8_WAIT_L(0); PG8_BAR; PG8_MMA(1, 0, At, B0); PG8_MMA(1, 1, At, B1); PG8_BAR; PG8_SCHED;
            } else {
            PG8_LDB(B0, 0, 0); PG8_SCHED; PG8_LDA(At, 0, 0); PG8_STAGE(PG8_SA(1, 1), a1 + hstep, voffA);
            PG8_WAIT_L(8); PG8_BAR; PG8_WAIT_L(0); PG8_MMA(0, 0, At, B0); PG8_BAR; PG8_SCHED;
            PG8_LDB(B1, 0, 1); PG8_STAGE(PG8_SB(0, 0), b2, voffB);
            PG8_BAR; PG8_WAIT_L(0); PG8_MMA(0, 1, At, B1); PG8_BAR;
            PG8_LDA(At, 0, 1); PG8_STAGE(PG8_SA(0, 0), a2, voffA);
            PG8_BAR; PG8_WAIT_L(0); PG8_MMA(1, 0, At, B0); PG8_BAR; PG8_SCHED;
            PG8_STAGE(PG8_SB(0, 1), b2 + hstep, voffB);
            PG8_WAIT_V(6); PG8_BAR; PG8_MMA(1, 1, At, B1); PG8_BAR;
            PG8_LDB(B0, 1, 0); PG8_SCHED; PG8_LDA(At, 1, 0); PG8_STAGE(PG8_SA(0, 1), a2 + hstep, voffA);
            PG8_WAIT_L(8); PG8_BAR; PG8_WAIT_L(0); PG8_MMA(0, 0, At, B0); PG8_BAR; PG8_SCHED;
            PG8_LDB(B1, 1, 1); PG8_STAGE(PG8_SB(1, 0), b3, voffB);
            PG8_BAR; PG8_WAIT_L(0); PG8_MMA(0, 1, At, B1); PG8_BAR;
            PG8_LDA(At, 1, 1); PG8_STAGE(PG8_SA(1, 0), a3, voffA);
            PG8_BAR; PG8_WAIT_L(0); PG8_MMA(1, 0, At, B0); PG8_BAR; PG8_SCHED;
            PG8_STAGE(PG8_SB(1, 1), b3 + hstep, voffB);
            PG8_WAIT_V(6); PG8_BAR; PG8_MMA(1, 1, At, B1); PG8_BAR;
            }
        }
        if constexpr (ALIGN_EPI) { if (wr == 0) PG8_BAR; }
        if constexpr (!Epi::AFTER_DRAIN) { E(acc, cur, wr, wc, fr, fq); S.done(cur); }
        if (!has_next) break;
#pragma unroll
        for (int a = 0; a < 2; ++a)
#pragma unroll
            for (int b = 0; b < 2; ++b)
#pragma unroll
                for (int m = 0; m < 4; ++m)
#pragma unroll
                    for (int n = 0; n < 2; ++n) acc[a][b][m][n] = (f32x4){0.f, 0.f, 0.f, 0.f};
        cur = nxt; cA = nA; cB = nB; ++ui;
        if constexpr (ALIGN_EPI) { if (wr == 1) PG8_BAR; }
    }
    PG8_WAIT_V(0);
    if constexpr (!ALIGN_EPI) { if (wr == 0) PG8_BAR; }
    PG8_BAR;
    if constexpr (Epi::AFTER_DRAIN) { E.fused(acc, cur, wr, wc, fr, fq, lds, wid, lane); S.done(cur); }
#undef PG8_SA
#undef PG8_SB
#undef PG8_STAGE
#undef PG8_LDA
#undef PG8_LDB
#undef PG8_MMA
#undef PG8_WAIT_V
#undef PG8_WAIT_L
#undef PG8_BAR
#undef PG8_SCHED
}
}
#include <hip/hip_bf16.h>
#include <cmath>
namespace attn_body {
using bf16=__hip_bfloat16;
using bf16x8=__attribute__((ext_vector_type(8)))short;
using s16x4=__attribute__((ext_vector_type(4)))short;
using f32x16=__attribute__((ext_vector_type(16)))float;
using u32x4=__attribute__((ext_vector_type(4)))unsigned;
constexpr int SEQ=4096,D=64,PQ=512,PK=512,PV=512,PO=1024;
constexpr int NW=8,QBLK=32,QB=QBLK*NW,KVBLK=64,NQB=SEQ/QB;
constexpr int ATTN_UNIT_ROWS=QB;
__device__ __forceinline__ int crow(int r,int hi){return (r&3)+8*(r>>2)+4*hi;}
#define SBAR() __builtin_amdgcn_sched_barrier(0)
typedef __attribute__((address_space(3))) const float* lds_fptr;
__device__ __forceinline__ void bmask(f32x16&p0,f32x16&p1,int dist,lds_fptr tb){
  if(dist<0){
    #pragma unroll
    for(int r=0;r<16;++r){p0[r]=-INFINITY;p1[r]=-INFINITY;}
  } else if(dist<=2){
    #pragma unroll
    for(int r=0;r<16;++r){const int o=(r&3)+8*(r>>2); p0[r]+=tb[o]; p1[r]+=tb[o+32];}
  }
}

__device__ __forceinline__ void binit(f32x16&c0,f32x16&c1,int dist,lds_fptr tb){
  if(dist<0){
    #pragma unroll
    for(int r=0;r<16;++r){c0[r]=-INFINITY;c1[r]=-INFINITY;}
  } else if(dist<=2){
    #pragma unroll
    for(int r=0;r<16;++r){const int o=(r&3)+8*(r>>2); c0[r]=tb[o]; c1[r]=tb[o+32];}
  } else {
    #pragma unroll
    for(int r=0;r<16;++r){c0[r]=0.f;c1[r]=0.f;}
  }
}
__device__ __forceinline__ void binit1(f32x16&c,int dist,lds_fptr tb){
  if(dist<0){
    #pragma unroll
    for(int r=0;r<16;++r)c[r]=-INFINITY;
  } else if(dist<=2){
    #pragma unroll
    for(int r=0;r<16;++r)c[r]=tb[(r&3)+8*(r>>2)];
  } else {
    #pragma unroll
    for(int r=0;r<16;++r)c[r]=0.f;
  }
}
__device__ __forceinline__ void bpost(f32x16&c0,f32x16&c1,float mhat){
  #pragma unroll
  for(int r=0;r<16;++r){c0[r]-=mhat;c1[r]-=mhat;}
}
constexpr int NSLOT=3, SLOTB=8192;
constexpr int LDS_K=0, LDS_V=NSLOT*SLOTB, LDS_WS=2*NSLOT*SLOTB, LDS_OST=LDS_WS+NW*64*4, LDS_BYTES=LDS_OST+NW*4096;
constexpr float C2=0.125f*1.4426950408889634f;
__device__ __forceinline__ void glds16(const void*gsrc,unsigned lds_dst){unsigned keep;
  asm volatile("s_mov_b32 %0, m0\n\ts_mov_b32 m0, %2\n\ts_nop 0\n\tglobal_load_lds_dwordx4 %1, off\n\ts_mov_b32 m0, %0":"=&s"(keep):"v"(gsrc),"s"(lds_dst):"memory");}
__device__ __forceinline__ float max3f(float a,float b,float c){float r;asm("v_max3_f32 %0, %1, %2, %3":"=v"(r):"v"(a),"v"(b),"v"(c));return r;}
__device__ __forceinline__ float max2f(float a,float b){float r;asm("v_max_f32_e32 %0, %1, %2":"=v"(r):"v"(a),"v"(b));return r;}
__device__ __forceinline__ float fadd_s(float a,float b){float r;asm("v_add_f32_e32 %0, %1, %2":"=v"(r):"v"(a),"v"(b));return r;}
__device__ __forceinline__ float fsub_s(float a,float b){float r;asm("v_sub_f32_e32 %0, %1, %2":"=v"(r):"v"(a),"v"(b));return r;}
typedef float f32x2_t __attribute__((ext_vector_type(2))); typedef __bf16 bf16x2_t __attribute__((ext_vector_type(2)));
__device__ __forceinline__ unsigned cvtpk_s(float lo,float hi){f32x2_t v={lo,hi};bf16x2_t b=__builtin_convertvector(v,bf16x2_t);return __builtin_bit_cast(unsigned,b);}
#define WAIT_BAR(N) asm volatile("s_waitcnt vmcnt(" #N ") lgkmcnt(0)\n\ts_barrier":::"memory")

__device__ __forceinline__ void qkt(f32x16&p0,f32x16&p1,const char*Kslot,const bf16x8*qr,const f32x16&negm,int r32,int hi){
  const char*kb=Kslot+hi*1024+r32*16;
  #pragma unroll
  for(int d0=0;d0<4;++d0){
    const bf16x8 b0=*reinterpret_cast<const bf16x8*>(kb+d0*2048);
    const bf16x8 b1=*reinterpret_cast<const bf16x8*>(kb+d0*2048+512);
    {p0=__builtin_amdgcn_mfma_f32_32x32x16_bf16(b0,qr[d0],p0,0,0,0);p1=__builtin_amdgcn_mfma_f32_32x32x16_bf16(b1,qr[d0],p1,0,0,0);}}
}
typedef __attribute__((address_space(3))) const char* lds_cptr;
typedef short v4i16_t __attribute__((ext_vector_type(4)));
__device__ __forceinline__ void kload8(bf16x8*kf,lds_cptr kp){
  kf[0]=*(const __attribute__((address_space(3))) bf16x8*)(kp);      kf[1]=*(const __attribute__((address_space(3))) bf16x8*)(kp+512);
  kf[2]=*(const __attribute__((address_space(3))) bf16x8*)(kp+2048); kf[3]=*(const __attribute__((address_space(3))) bf16x8*)(kp+2560);
  kf[4]=*(const __attribute__((address_space(3))) bf16x8*)(kp+4096); kf[5]=*(const __attribute__((address_space(3))) bf16x8*)(kp+4608);
  kf[6]=*(const __attribute__((address_space(3))) bf16x8*)(kp+6144); kf[7]=*(const __attribute__((address_space(3))) bf16x8*)(kp+6656);
}
__device__ __forceinline__ void kload2(bf16x8*kf,lds_cptr kp,int j){ kf[2*j]=*(const __attribute__((address_space(3))) bf16x8*)(kp+j*2048); kf[2*j+1]=*(const __attribute__((address_space(3))) bf16x8*)(kp+j*2048+512); }
__device__ __forceinline__ s16x4 vtr(lds_cptr p){ return __builtin_bit_cast(s16x4,__builtin_amdgcn_ds_read_tr16_b64_v4i16((__attribute__((address_space(3))) v4i16_t*)p)); }
__device__ __forceinline__ float rowmax(const f32x16&p0,const f32x16&p1){
  float a=max3f(p0[0],p0[1],p1[0]),b=max3f(p0[2],p0[3],p1[1]);a=max3f(a,p1[2],p1[3]);
  #pragma unroll
  for(int r=4;r<16;r+=4){a=max3f(a,p0[r],p0[r+1]);b=max3f(b,p0[r+2],p0[r+3]);a=max3f(a,p1[r],p1[r+1]);b=max3f(b,p1[r+2],p1[r+3]);}
  const float m=max2f(a,b);
  auto rr=__builtin_amdgcn_permlane32_swap(__float_as_uint(m),__float_as_uint(m),false,false);
  return max2f(__uint_as_float(rr[0]),__uint_as_float(rr[1]));
}
__device__ __forceinline__ void pv(f32x16*o,int vb,bf16x8 pa0,bf16x8 pa1,bf16x8 pa2,bf16x8 pa3){
  #pragma unroll
  for(int d0=0;d0<2;++d0){s16x4 lo[4],hi[4];
    #pragma unroll
    for(int ks=0;ks<4;++ks){
      asm volatile("ds_read_b64_tr_b16 %0,%1 offset:%c2":"=&v"(lo[ks]):"v"(vb),"i"(d0*4096+ks*1024):"memory");
      asm volatile("ds_read_b64_tr_b16 %0,%1 offset:%c2":"=&v"(hi[ks]):"v"(vb),"i"(d0*4096+ks*1024+512):"memory");}
    asm volatile("s_waitcnt lgkmcnt(0)":::"memory");SBAR();
    #define PK(k) (bf16x8){lo[k][0],lo[k][1],lo[k][2],lo[k][3],hi[k][0],hi[k][1],hi[k][2],hi[k][3]}
    o[d0]=__builtin_amdgcn_mfma_f32_32x32x16_bf16(pa0,PK(0),o[d0],0,0,0);
    o[d0]=__builtin_amdgcn_mfma_f32_32x32x16_bf16(pa1,PK(1),o[d0],0,0,0);
    o[d0]=__builtin_amdgcn_mfma_f32_32x32x16_bf16(pa2,PK(2),o[d0],0,0,0);
    o[d0]=__builtin_amdgcn_mfma_f32_32x32x16_bf16(pa3,PK(3),o[d0],0,0,0);
    #undef PK
  }
}

#ifndef ATTN_STORE16
#define ATTN_STORE16(p,v) (*(u32x4*)(p)=(v))
#endif
template<int THRL> __device__ __forceinline__ void attn_unit(int b,int qcol,int kcol,int vcol,int ocol,int qb,int hd,const float*reltab,const bf16*Q,const bf16*__restrict__ K,const bf16*__restrict__ V,bf16*O,char*shm){
  int tid=threadIdx.x; asm volatile("":"+v"(tid));
  const int lane=tid&63,r32=lane&31,hi=lane>>5; const int wid=__builtin_amdgcn_readfirstlane(tid>>6);
  const long rowbase=(long)b*SEQ; const int q0=qb*QB;
  const bf16*Qw=Q+(rowbase+q0+wid*QBLK)*PQ+qcol;
  const bf16*Kh=K+rowbase*PK+kcol,*Vh=V+rowbase*PV+vcol;
  const lds_cptr shm3=(lds_cptr)shm;
  const unsigned lds0=(unsigned)(uintptr_t)shm;
  float*wsf=(float*)(shm+LDS_WS)+wid*64;
  const bf16*ksrc=Kh+(long)lane*PK+wid*8;
  const bf16*vsrc=Vh+(long)(16*(wid&3)+(lane>>2))*PV+(wid>>2)*32+(lane&3)*8;
  const unsigned kdst=lds0+LDS_K+wid*1024, vdst=lds0+LDS_V+wid*1024;
  #define DMA_K(t,slot) glds16(ksrc+(long)(t)*KVBLK*PK,(unsigned)__builtin_amdgcn_readfirstlane(kdst+(slot)))
  #define DMA_V(t,slot) glds16(vsrc+(long)(t)*KVBLK*PV,(unsigned)__builtin_amdgcn_readfirstlane(vdst+(slot)))
  const int vb0=(int)(lds0+LDS_V)+((lane>>4)&1)*32+(lane&3)*8+(4*hi+((lane&15)>>2))*64;
  const char*Kbase=shm+LDS_K; bf16x8 kf[8];
  const lds_cptr kp0=shm3+LDS_K+hi*1024+r32*16; const lds_cptr vp0=shm3+LDS_V+((lane>>4)&1)*32+(lane&3)*8+(4*hi+((lane&15)>>2))*64;
  const int NT=(q0+QB)/KVBLK;
  DMA_K(0,0);DMA_V(0,0);DMA_K(1,SLOTB);
  if(tid<256){ const int rel_=tid-191, n_=rel_<0?-rel_:rel_; const int bk_=(rel_>0?16:0)+(n_<8?n_:min(15,2+(31-__clz(n_*n_))));
    ((__attribute__((address_space(3))) float*)(shm3+LDS_BYTES))[tid]=(reltab[bk_*4+hd]-reltab[15*4+hd])*1.4426950408889634f; }
  bf16x8 qr[4];
  #pragma unroll
  for(int d0=0;d0<4;++d0)qr[d0]=*reinterpret_cast<const bf16x8*>(&Qw[(long)r32*PQ+d0*16+hi*8]);
  float mhat=0.f,l_reg=0.f;f32x16 o[2];o[0]=f32x16{};o[1]=f32x16{};f32x16 negm=f32x16{};asm volatile("":"+v"(negm));
  const int wc2=wid>>1; const lds_fptr dtl=(lds_fptr)(shm3+LDS_BYTES)+191-(32*(wid&1)+r32)+4*hi;
  bool resc=false;
  #define START(P0,P1) do{ const float rm=rowmax(P0,P1); resc=false; \
    { const float dl=rm; mhat=fadd_s(mhat,dl); \
      _Pragma("unroll") for(int r=0;r<16;++r){P0[r]=fsub_s(P0[r],dl);P1[r]=fsub_s(P1[r],dl);} \
      _Pragma("unroll") for(int r=0;r<16;++r)negm[r]=-mhat; asm volatile("":"+v"(negm)); } \
    _Pragma("unroll") for(int r=0;r<16;++r)P0[r]=__builtin_amdgcn_exp2f(P0[r]); }while(0)
  #define RESC() do{ if(resc){ asm volatile("s_waitcnt lgkmcnt(0)":::"memory"); \
      _Pragma("unroll") for(int d_=0;d_<2;++d_) _Pragma("unroll") for(int r=0;r<16;++r)o[d_][r]*=wsf[crow(r,hi)]; } }while(0)
  f32x16 pA0,pA1,pB0,pB1;
  int sl_prev=0,sl_cur=0,sl_next=SLOTB;
  #define ROT() do{sl_prev=sl_cur;sl_cur=sl_next;sl_next=(sl_next==(NSLOT-1)*SLOTB)?0:sl_next+SLOTB;}while(0)
  DMA_K(2,2*SLOTB);
  WAIT_BAR(3);
  { const int dist_=wc2+(NT-4); binit(pA0,pA1,dist_,dtl-64*dist_); }
  qkt(pA0,pA1,Kbase,qr,negm,r32,hi);asm volatile("s_nop 15\n\ts_nop 7":"+v"(pA0),"+v"(pA1));
  START(pA0,pA1);
  _Pragma("unroll") for(int r=0;r<16;++r)pA1[r]=__builtin_amdgcn_exp2f(pA1[r]);
  WAIT_BAR(0);
  DMA_K(3,0);DMA_V(1,SLOTB);
  ROT();
  kload8(kf,kp0+sl_cur);
  WAIT_BAR(2);
  s16x4 vlo[8],vhi[8]; u32x4 pw0,pw1,pw2,pw3;
  #define PKW(P,B) cvtpk_s(P[B],P[B+1])
  #define PAF(k) __builtin_bit_cast(bf16x8,pw##k)
  #define VFR(i) (bf16x8){vlo[i][0],vlo[i][1],vlo[i][2],vlo[i][3],vhi[i][0],vhi[i][1],vhi[i][2],vhi[i][3]}
  #define PIN(x) asm volatile("":"+v"(x))
  #define MX3(a,b,c) __builtin_fmaxf(__builtin_fmaxf((a),(b)),(c))
  #define GAPA(MF,A0,A1,A2,A3,W0,W1,PW) do{ MF; sacc+=A0; sacc+=A1; sacc+=A2; sacc+=A3; PIN(sacc); W0; W1; PIN(PW); SBAR(); }while(0)
  #define EX(v) __builtin_amdgcn_exp2f(v)
  #define GAPB(MF,X,B) do{ MF; X[B]=EX(X[B]); X[B+1]=EX(X[B+1]); X[B+2]=EX(X[B+2]); X[B+3]=EX(X[B+3]); PIN(X); SBAR(); }while(0)
  #define VRD(i) do{ vlo[i]=vtr(vp_+(((i)>>2)*4096+((i)&3)*1024)); vhi[i]=vtr(vp_+(((i)>>2)*4096+((i)&3)*1024+512)); }while(0)
  #define KRD(G,j) do{ if(G){ kload2(kf,kp0+sl_next,j); SBAR(); } }while(0)
  #define STEP(C0,C1,P0,P1,t,GK,GV,GL) do{ SBAR(); \
    const lds_cptr vp_=vp0+sl_prev; \
    CINIT0(C0,t); VRD(0); SBAR(); float sacc=(P0[0]+P0[1]); \
    GAPA(C0=__builtin_amdgcn_mfma_f32_32x32x16_bf16(kf[0],qr[0],CSRC(C0),0,0,0), P0[2],P0[3],P0[4],P0[5],     pw0[0]=PKW(P0,0), pw0[1]=PKW(P0,2), pw0); \
    CINIT1(C1,t); VRD(4); SBAR(); GAPA(C1=__builtin_amdgcn_mfma_f32_32x32x16_bf16(kf[1],qr[0],CSRC(C1),0,0,0), P0[6],P0[7],P0[8],P0[9],     pw0[2]=PKW(P0,4), pw0[3]=PKW(P0,6), pw0); \
    VRD(1); SBAR(); GAPA(C0=__builtin_amdgcn_mfma_f32_32x32x16_bf16(kf[2],qr[1],C0,0,0,0),   P0[10],P0[11],P0[12],P0[13], pw1[0]=PKW(P0,8), pw1[1]=PKW(P0,10), pw1); \
    VRD(5); SBAR(); GAPA(C1=__builtin_amdgcn_mfma_f32_32x32x16_bf16(kf[3],qr[1],C1,0,0,0),   P0[14],P0[15],P1[0],P1[1],   pw1[2]=PKW(P0,12),pw1[3]=PKW(P0,14), pw1); \
    VRD(2); SBAR(); GAPA(C0=__builtin_amdgcn_mfma_f32_32x32x16_bf16(kf[4],qr[2],C0,0,0,0),   P1[2],P1[3],P1[4],P1[5],     pw2[0]=PKW(P1,0), pw2[1]=PKW(P1,2), pw2); \
    VRD(6); SBAR(); GAPA(C1=__builtin_amdgcn_mfma_f32_32x32x16_bf16(kf[5],qr[2],C1,0,0,0),   P1[6],P1[7],P1[8],P1[9],     pw2[2]=PKW(P1,4), pw2[3]=PKW(P1,6), pw2); \
    VRD(3); SBAR(); GAPA(C0=__builtin_amdgcn_mfma_f32_32x32x16_bf16(kf[6],qr[3],C0,0,0,0),   P1[10],P1[11],P1[12],P1[13], pw3[0]=PKW(P1,8), pw3[1]=PKW(P1,10), pw3); \
    VRD(7); SBAR(); GAPA(C1=__builtin_amdgcn_mfma_f32_32x32x16_bf16(kf[7],qr[3],C1,0,0,0),   P1[14],P1[15],0.f,0.f,       pw3[2]=PKW(P1,12),pw3[3]=PKW(P1,14), pw3); \
    l_reg+=sacc; \
    if(GK){DMA_K((t)+3,sl_cur);} if(GV){DMA_V((t)+1,sl_next);} \
    CPOST(C0,C1); \
    { float a=MX3(C0[0],C0[1],C1[0]),b=MX3(C0[2],C0[3],C1[1]); a=MX3(a,C1[2],C1[3]); \
      _Pragma("unroll") for(int r=4;r<16;r+=4){a=MX3(a,C0[r],C0[r+1]);b=MX3(b,C0[r+2],C0[r+3]);a=MX3(a,C1[r],C1[r+1]);b=MX3(b,C1[r+2],C1[r+3]);} \
      float rm=__builtin_fmaxf(a,b); { auto rr=__builtin_amdgcn_permlane32_swap(__float_as_uint(rm),__float_as_uint(rm),false,false); rm=__builtin_fmaxf(__uint_as_float(rr[0]),__uint_as_float(rr[1])); } \
      resc=false; \
      if(__builtin_expect(__any(rm>(float)THRL),0)){ const float dl=__builtin_fmaxf(rm,0.f); mhat+=dl; \
        _Pragma("unroll") for(int r=0;r<16;++r){C0[r]-=dl;C1[r]-=dl;} \
        NEGM_UPD(); \
        const float f=__builtin_amdgcn_exp2f(-dl); l_reg*=f; if(hi==0)wsf[r32]=f; resc=true; } } \
    SBAR(); \
    GAPB(o[0]=__builtin_amdgcn_mfma_f32_32x32x16_bf16(PAF(0),VFR(0),o[0],0,0,0), C0,0); \
    GAPB(o[1]=__builtin_amdgcn_mfma_f32_32x32x16_bf16(PAF(0),VFR(4),o[1],0,0,0), C0,4); \
    KRD(GL,0); GAPB(o[0]=__builtin_amdgcn_mfma_f32_32x32x16_bf16(PAF(1),VFR(1),o[0],0,0,0), C0,8); \
    KRD(GL,1); GAPB(o[1]=__builtin_amdgcn_mfma_f32_32x32x16_bf16(PAF(1),VFR(5),o[1],0,0,0), C0,12); \
    KRD(GL,2); GAPB(o[0]=__builtin_amdgcn_mfma_f32_32x32x16_bf16(PAF(2),VFR(2),o[0],0,0,0), C1,0); \
    KRD(GL,3); GAPB(o[1]=__builtin_amdgcn_mfma_f32_32x32x16_bf16(PAF(2),VFR(6),o[1],0,0,0), C1,4); \
    GAPB(o[0]=__builtin_amdgcn_mfma_f32_32x32x16_bf16(PAF(3),VFR(3),o[0],0,0,0), C1,8); \
    GAPB(o[1]=__builtin_amdgcn_mfma_f32_32x32x16_bf16(PAF(3),VFR(7),o[1],0,0,0), C1,12); \
    }while(0)
  int t=1;
  #define CINIT0(C,t) do{}while(0)
  #define CINIT1(C,t) do{}while(0)
  #define CSRC(C) negm
  #define CPOST(C0,C1) do{}while(0)
  #define NEGM_UPD() do{ _Pragma("unroll") for(int r=0;r<16;++r)negm[r]=-mhat; asm volatile("":"+v"(negm)); }while(0)
  for(;t+7<NT;t+=2){
    STEP(pB0,pB1,pA0,pA1,t,true,true,true);     WAIT_BAR(2); RESC(); ROT();
    STEP(pA0,pA1,pB0,pB1,t+1,true,true,true);   WAIT_BAR(2); RESC(); ROT();
  }
  #undef CINIT0
  #undef CINIT1
  #undef CSRC
  #undef CPOST
  #undef NEGM_UPD
  #define NEGM_UPD() do{}while(0)
  #define CINIT0(C,t) do{const int dist_=wc2+(NT-4-(t)); binit1(C,dist_,dtl-64*dist_);}while(0)
  #define CINIT1(C,t) do{const int dist_=wc2+(NT-4-(t)); binit1(C,dist_,dtl-64*dist_+32);}while(0)
  #define CSRC(C) C
  #define CPOST(C0,C1) bpost(C0,C1,mhat)
  #define ENDW(tt) do{ if((tt)+3<NT){WAIT_BAR(2);} else if((tt)+2<NT){WAIT_BAR(1);} else {WAIT_BAR(0);} }while(0)
  for(;t+1<NT;t+=2){
    STEP(pB0,pB1,pA0,pA1,t,(t+3<NT),(t+1<NT),(t+1<NT));       ENDW(t);   RESC(); ROT();
    STEP(pA0,pA1,pB0,pB1,t+1,(t+4<NT),(t+2<NT),(t+2<NT));     ENDW(t+1); RESC(); ROT();
  }
  STEP(pB0,pB1,pA0,pA1,NT-1,false,false,false); RESC();
  { float sacc=pB0[0]+pB0[1]; _Pragma("unroll") for(int r=2;r<16;++r)sacc+=pB0[r]; _Pragma("unroll") for(int r=0;r<16;++r)sacc+=pB1[r]; l_reg+=sacc;
    pw0=(u32x4){PKW(pB0,0),PKW(pB0,2),PKW(pB0,4),PKW(pB0,6)};pw1=(u32x4){PKW(pB0,8),PKW(pB0,10),PKW(pB0,12),PKW(pB0,14)};pw2=(u32x4){PKW(pB1,0),PKW(pB1,2),PKW(pB1,4),PKW(pB1,6)};pw3=(u32x4){PKW(pB1,8),PKW(pB1,10),PKW(pB1,12),PKW(pB1,14)};
    SBAR(); pv(o,vb0+sl_cur,PAF(0),PAF(1),PAF(2),PAF(3)); }
  #undef PKW
  #undef PAF
  #undef VFR
  #undef PIN
  #undef MX3
  #undef GAPA
  #undef GAPB
  #undef EX
  #undef VRD
  #undef KRD
  #undef STEP
  #undef ENDW
  {auto rr=__builtin_amdgcn_permlane32_swap(__float_as_uint(l_reg),__float_as_uint(l_reg),false,false);l_reg=__uint_as_float(rr[0])+__uint_as_float(rr[1]);}
  if(hi==0)wsf[32+r32]=l_reg;asm volatile("s_waitcnt lgkmcnt(0)":::"memory");
  float rli[16];
  #pragma unroll
  for(int r=0;r<16;++r)rli[r]=__builtin_amdgcn_rcpf(wsf[32+crow(r,hi)]);
  bf16*Ow=O+(rowbase+q0+wid*QBLK)*PO+ocol;
  { bf16*stg=(bf16*)(shm+LDS_OST)+wid*2048;
    #pragma unroll
    for(int r=0;r<16;++r){const int orow=crow(r,hi);
      #pragma unroll
      for(int d0=0;d0<2;++d0)stg[orow*64+d0*32+r32]=__float2bfloat16(o[d0][r]*rli[r]);}
    asm volatile("s_waitcnt lgkmcnt(0)":::"memory");
    #pragma unroll
    for(int i=0;i<4;++i){const int row=i*8+(lane>>3),ch=lane&7; const u32x4 v=*(const u32x4*)(stg+row*64+ch*8); ATTN_STORE16(Ow+(long)row*PO+ch*8,v);} }
  asm volatile("s_waitcnt lgkmcnt(0)\n\ts_barrier":::"memory");
  #undef DMA_K
  #undef DMA_V
  #undef CINIT0
  #undef CINIT1
  #undef CSRC
  #undef CPOST
  #undef NEGM_UPD
  #undef START
  #undef RESC
  #undef ROT
}
constexpr int ATTN_LDS_BYTES=LDS_BYTES+1024;
#undef SBAR
#undef WAIT_BAR
}

namespace cg = cooperative_groups;
constexpr int NWAVES = 8, NTHREADS = 512;
constexpr int MTOT = 33280, MPR = 32768, MSA = 512;
constexpr int DM = 1024, TP = 4096, TS = 16, NBP = 8, NBS = 32, PAST = 4096;
constexpr float EPS = 1e-6f, LOG2E = 1.4426950408889634f;
constexpr float LAM_INIT = 0.2f;
constexpr size_t O_YP = 0, O_YS = 33554432, O_KP = 34078720, O_VP = 50855936, O_CP = 67633152, O_MK = 67756032, O_MV = 68804608, O_KS = 69853184, O_VS = 70115328, O_CS = 70377472, O_END = 70868992;
constexpr size_t MiB = 1u << 20;
constexpr size_t WS_RS0 = 1 * MiB, WS_RSM = 1 * MiB + 256 * 1024, WS_SSP1 = 2 * MiB, WS_SSP2 = 5 * MiB, WS_QSS = 8 * MiB;
constexpr size_t WS_W1T = 12 * MiB, WS_WOT = 17 * MiB, WS_WMQT = 19 * MiB, WS_WMKVT = 20 * MiB, WS_WMOT = 22 * MiB, WS_WF1T = 23 * MiB, WS_WF2T = 31 * MiB;
constexpr size_t WS_MEMB = 40 * MiB, WS_MKB = 44 * MiB, WS_MVB = 54 * MiB;
constexpr size_t WS_XB = 64 * MiB, WS_Q = 130 * MiB, WS_KB = 163 * MiB, WS_VB = 196 * MiB, WS_C = 229 * MiB, WS_A3 = 294 * MiB, WS_OA = 360 * MiB;
constexpr size_t WS_X1 = 490 * MiB, WS_X1B = 620 * MiB, WS_QM = 685 * MiB, WS_OM = 718 * MiB, WS_X2B = 751 * MiB, WS_END = 816 * MiB;
constexpr size_t WS_U = 64 * MiB;
static_assert(WS_U + (size_t)MTOT * 4096 * 2 <= WS_OA, "U overlay");
#ifndef PHMASK
#define PHMASK 0xFFFFF
#endif
#define PH(k) ((PHMASK >> (k)) & 1)
constexpr int LDS_BYTES = 147456;

#define LAS __attribute__((address_space(3)))
typedef unsigned short bf16;
typedef unsigned v4u __attribute__((ext_vector_type(4)));
typedef unsigned v2u __attribute__((ext_vector_type(2)));
typedef float f32x4 __attribute__((ext_vector_type(4)));
__device__ __forceinline__ unsigned f2bf(float f) { unsigned u = __builtin_bit_cast(unsigned, f); return (u + 0x7fffu + ((u >> 16) & 1u)) >> 16; }
__device__ __forceinline__ unsigned pk2(float lo, float hi) { return f2bf(lo) | (f2bf(hi) << 16); }
__device__ __forceinline__ float bf2f(unsigned h) { return __builtin_bit_cast(float, h << 16); }
__device__ __forceinline__ float wave_sum(float v) {
#pragma unroll
    for (int o = 1; o < 64; o <<= 1) v += __shfl_xor(v, o);
    return v;
}
__device__ __forceinline__ void unpack8(const v4u w, float* f) { f[0] = bf2f(w.x & 0xffffu); f[1] = bf2f(w.x >> 16); f[2] = bf2f(w.y & 0xffffu); f[3] = bf2f(w.y >> 16); f[4] = bf2f(w.z & 0xffffu); f[5] = bf2f(w.z >> 16); f[6] = bf2f(w.w & 0xffffu); f[7] = bf2f(w.w >> 16); }

struct Params { const float* in[31]; float* out; unsigned char* ws; };
enum { I_XP = 0, I_XS, I_CK, I_CV, I_CC, I_CMK, I_CMV, I_MEM, I_REL, I_GMIX, I_WIN, I_GQ, I_GK, I_LAM, I_GSUB, I_WCONV, I_BCONV, I_LNG, I_LNB, I_WOUT, I_GCROSS, I_GMEM, I_WMQ, I_WMK, I_WMV, I_GMQ, I_GMK, I_WMO, I_GFFN, I_WFF1, I_WFF2 };

__device__ __forceinline__ int rel_bucket(int rel) {
    const int n = rel < 0 ? -rel : rel; const int lg = n < 8 ? n : min(15, 2 + (31 - __clz(n * n)));
    return (rel > 0 ? 16 : 0) + lg;
}
#define RDL(x, d) __builtin_bit_cast(float, __builtin_amdgcn_readlane(__builtin_bit_cast(int, (x)), (d)))
__device__ __forceinline__ float compute_lam(const float* lv, int lane) {
    const float a = wave_sum(lv[lane] * lv[64 + lane]), b = wave_sum(lv[128 + lane] * lv[192 + lane]);
    return __expf(a) - __expf(b) + LAM_INIT;
}

__device__ __forceinline__ void p0_transpose_item(const float* W, int K, int N, const float* gain, bf16* WT, int dst_row0, LAS float* scr, int k0, int n0, int lane) {
#pragma unroll 8
    for (int i = 0; i < 32; ++i) { const int kk = 2 * i + (lane >> 5); const float g = gain ? gain[k0 + kk] : 1.0f; scr[kk * 33 + (lane & 31)] = W[(size_t)(k0 + kk) * N + n0 + (lane & 31)] * g; }
    asm volatile("s_waitcnt lgkmcnt(0)" ::: "memory");
    const int c = lane & 7;
#pragma unroll
    for (int j = 0; j < 4; ++j) { const int n = (lane >> 3) + 8 * j; const LAS float* s = scr + (8 * c) * 33 + n;
        v4u o; o.x = pk2(s[0 * 33], s[1 * 33]); o.y = pk2(s[2 * 33], s[3 * 33]); o.z = pk2(s[4 * 33], s[5 * 33]); o.w = pk2(s[6 * 33], s[7 * 33]);
        *(v4u*)(WT + (size_t)(dst_row0 + n) * K + k0 + 8 * c) = o; }
    asm volatile("s_waitcnt lgkmcnt(0)" ::: "memory");
}
__device__ __forceinline__ int w1_row(int a) {
    if (a < 1024) { const int pn = a >> 8, wc = (a >> 6) & 3, bj = (a >> 5) & 1; return 256 * pn + 128 * bj + 32 * wc; }
    if (a < 1536) return a;
    const int g = a >= 2048, ch = a - (g ? 2048 : 1536), t = ch >> 7, wc = (ch >> 5) & 3; return 1536 + 256 * t + 128 * g + 32 * wc;
}
__device__ __forceinline__ void row_to_bf16_rs(const float* xrow, bf16* orow, float* rs_out, int lane) {
    const f32x4* xr = (const f32x4*)xrow + lane; f32x4 v[4]; float s = 0.f;
#pragma unroll
    for (int j = 0; j < 4; ++j) { v[j] = xr[64 * j]; s += (v[j].x * v[j].x + v[j].y * v[j].y) + (v[j].z * v[j].z + v[j].w * v[j].w); }
    s = wave_sum(s);
    unsigned long long* o8 = (unsigned long long*)orow + lane;
#pragma unroll
    for (int j = 0; j < 4; ++j) o8[64 * j] = (unsigned long long)pk2(v[j].x, v[j].y) | ((unsigned long long)pk2(v[j].z, v[j].w) << 32);
    if (lane == 0) *rs_out = 1.0f / sqrtf(s * (1.0f / 1024.0f) + EPS);
}

__global__ void __launch_bounds__(NTHREADS, 2) fwd_kernel(Params p) {
    extern __shared__ __attribute__((aligned(16))) unsigned char lds_raw[];
    LAS unsigned char* lds = (LAS unsigned char*)lds_raw;
    cg::grid_group grid = cg::this_grid();
    const int tid = threadIdx.x, lane = tid & 63, wave = __builtin_amdgcn_readfirstlane(tid >> 6);
    const int G = gridDim.x, gw = blockIdx.x * NWAVES + wave, NGW = G * NWAVES;
    unsigned char* ws = p.ws; float* out = p.out;
    float* RS0 = (float*)(ws + WS_RS0); float* RSM = (float*)(ws + WS_RSM); float* SSP1 = (float*)(ws + WS_SSP1); float* SSP2 = (float*)(ws + WS_SSP2);
    bf16* W1T = (bf16*)(ws + WS_W1T); bf16* WOT = (bf16*)(ws + WS_WOT); bf16* WMQT = (bf16*)(ws + WS_WMQT); bf16* WMKVT = (bf16*)(ws + WS_WMKVT); bf16* WMOT = (bf16*)(ws + WS_WMOT);
    bf16* WF1T = (bf16*)(ws + WS_WF1T); bf16* WF2T = (bf16*)(ws + WS_WF2T); bf16* MEMB = (bf16*)(ws + WS_MEMB);
    bf16* XB = (bf16*)(ws + WS_XB); bf16* QB = (bf16*)(ws + WS_Q); bf16* KB = (bf16*)(ws + WS_KB); bf16* VB = (bf16*)(ws + WS_VB); float* CB = (float*)(ws + WS_C);
    bf16* A3 = (bf16*)(ws + WS_A3); float* OA = (float*)(ws + WS_OA); bf16* OAB = (bf16*)(ws + WS_OA); float* X1 = (float*)(ws + WS_X1); bf16* X1B = (bf16*)(ws + WS_X1B); bf16* QM = (bf16*)(ws + WS_QM); bf16* OM = (bf16*)(ws + WS_OM);
    bf16* X2B = (bf16*)(ws + WS_X2B); bf16* MKB = (bf16*)(ws + WS_MKB); bf16* MVT = (bf16*)(ws + WS_MVB); bf16* UB = (bf16*)(ws + WS_U);

    if constexpr (PH(0)) {
        LAS float* scr = (LAS float*)(lds + wave * 16384);
        constexpr int I1 = 16 * 80, I2 = 16 * 32, I3 = 16 * 16, I6 = 8 * 32, I7 = 16 * 128, I8 = 64 * 32;
        constexpr int NITEMS = I1 + I2 + 3 * I3 + I6 + I7 + I8;
        for (int it = gw; it < NITEMS; it += NGW) {
            int r = it;
            if (r < I1) { const int kb = r / 80, nb = r % 80; p0_transpose_item(p.in[I_WIN], 1024, 2560, p.in[I_GMIX], W1T, w1_row(32 * nb), scr, 64 * kb, 32 * nb, lane); continue; } r -= I1;
            if (r < I2) { const int kb = r / 32, nb = r % 32; p0_transpose_item(p.in[I_WOUT], 1024, 1024, nullptr, WOT, 32 * nb, scr, 64 * kb, 32 * nb, lane); continue; } r -= I2;
            if (r < I3) { const int kb = r / 16, nb = r % 16; p0_transpose_item(p.in[I_WMQ], 1024, 512, p.in[I_GCROSS], WMQT, 32 * nb, scr, 64 * kb, 32 * nb, lane); continue; } r -= I3;
            if (r < I3) { const int kb = r / 16, nb = r % 16; p0_transpose_item(p.in[I_WMK], 1024, 512, p.in[I_GMEM], WMKVT, 32 * nb, scr, 64 * kb, 32 * nb, lane); continue; } r -= I3;
            if (r < I3) { const int kb = r / 16, nb = r % 16; p0_transpose_item(p.in[I_WMV], 1024, 512, p.in[I_GMEM], WMKVT, 512 + 32 * nb, scr, 64 * kb, 32 * nb, lane); continue; } r -= I3;
            if (r < I6) { const int kb = r / 32, nb = r % 32; p0_transpose_item(p.in[I_WMO], 512, 1024, nullptr, WMOT, 32 * nb, scr, 64 * kb, 32 * nb, lane); continue; } r -= I6;
            if (r < I7) { const int kb = r / 128, nb = r % 128; p0_transpose_item(p.in[I_WFF1], 1024, 4096, p.in[I_GFFN], WF1T, 32 * nb, scr, 64 * kb, 32 * nb, lane); continue; } r -= I7;
            { const int kb = r / 32, nb = r % 32; p0_transpose_item(p.in[I_WFF2], 4096, 1024, nullptr, WF2T, 32 * nb, scr, 64 * kb, 32 * nb, lane); }
        }
        for (int m = gw; m < MTOT + 2048; m += NGW) {
            if (m < MPR) row_to_bf16_rs(p.in[I_XP] + (size_t)m * 1024, XB + (size_t)m * 1024, RS0 + m, lane);
            else if (m < MTOT) row_to_bf16_rs(p.in[I_XS] + (size_t)(m - MPR) * 1024, XB + (size_t)m * 1024, RS0 + m, lane);
            else row_to_bf16_rs(p.in[I_MEM] + (size_t)(m - MTOT) * 1024, MEMB + (size_t)(m - MTOT) * 1024, RSM + (m - MTOT), lane);
        }
    }
    grid.sync();

    if constexpr (PH(1)) {
        pg8::Gemm g{XB, W1T, MTOT, 2560, 1024}; pg8::StaticOrder S; S.init(MTOT, 2560, G, (int)blockIdx.x);
        pg8::EpiG1 E{RS0, p.in[I_GQ], p.in[I_GK], QB, KB, VB, CB, out + O_KP, out + O_KS, out + O_VP, out + O_VS};
        pg8::gemm_phase<pg8::EpiG1, pg8::StaticOrder, true, true>(lds, g, S, E);
    }
    if constexpr (PH(2)) {
        pg8::Gemm g{MEMB, WMKVT, 2048, 1024, 1024}; pg8::StaticOrder S; S.init(2048, 1024, G, (int)((blockIdx.x + 128) % G));
        pg8::EpiMem E{RSM, out + O_MK, out + O_MV};
        pg8::gemm_phase<pg8::EpiMem, pg8::StaticOrder, true, true>(lds, g, S, E);
    }
    grid.sync();

    if constexpr (PH(3)) for (int r = gw; r < 40 * 256; r += NGW) {
        f32x4 a, b;
        if (r < 2048) {
            float* mk = out + O_MK + (size_t)r * 512 + lane * 8; a = *(f32x4*)mk; b = *(f32x4*)(mk + 4);
            float ss = (a.x * a.x + a.y * a.y) + (a.z * a.z + a.w * a.w) + (b.x * b.x + b.y * b.y) + (b.z * b.z + b.w * b.w);
            ss += __shfl_xor(ss, 1); ss += __shfl_xor(ss, 2); ss += __shfl_xor(ss, 4); ss += __shfl_xor(ss, 8);
            const float rstd = 1.0f / sqrtf(ss * (1.0f / 128.0f) + EPS); const float* g = p.in[I_GMK] + (lane & 15) * 8;
            a = a * *(const f32x4*)g * rstd; b = b * *(const f32x4*)(g + 4) * rstd;
            *(f32x4*)mk = a; *(f32x4*)(mk + 4) = b;
        } else { const float* mk = p.in[I_CMK] + (size_t)(r - 2048) * 512 + lane * 8; a = *(const f32x4*)mk; b = *(const f32x4*)(mk + 4); }
        const float* gq = p.in[I_GMQ] + (lane & 15) * 8; a = a * *(const f32x4*)gq; b = b * *(const f32x4*)(gq + 4);
        v4u o; o.x = pk2(a.x, a.y); o.y = pk2(a.z, a.w); o.z = pk2(b.x, b.y); o.w = pk2(b.z, b.w);
        *(v4u*)(MKB + (size_t)r * 512 + lane * 8) = o;
    }
    if constexpr (PH(3)) for (int it = gw; it < 40 * 4 * 8; it += NGW) {
        const int kg = it & 7, head = (it >> 3) & 3, bb = it >> 5;
        const float* vsrc = (bb < 8 ? out + O_MV + (size_t)bb * 256 * 512 : p.in[I_CMV] + (size_t)(bb - 8) * 256 * 512) + (size_t)(32 * kg) * 512 + head * 128;
#pragma unroll 1
        for (int half = 0; half < 2; ++half) { const int e = lane + 64 * half; float v[32];
#pragma unroll
            for (int k = 0; k < 32; ++k) v[k] = vsrc[(size_t)k * 512 + e];
            bf16* dst = MVT + ((size_t)(bb * 4 + head) * 128 + e) * 256 + 32 * kg;
#pragma unroll
            for (int g = 0; g < 4; ++g) { v4u o; o.x = pk2(v[4 * g], v[4 * g + 1]); o.y = pk2(v[4 * g + 2], v[4 * g + 3]); o.z = pk2(v[16 + 4 * g], v[16 + 4 * g + 1]); o.w = pk2(v[16 + 4 * g + 2], v[16 + 4 * g + 3]); *(v4u*)(dst + 8 * g) = o; }
        }
    }
    if constexpr (PH(4)) for (int r = gw; r < MTOT; r += NGW) {
        const bool smp = r >= MPR; const int b = smp ? (r - MPR) >> 4 : r >> 12, t = smp ? (r - MPR) & 15 : r & 4095, rb = smp ? MPR + b * 16 : b * 4096, ch0 = lane * 8;
        float acc[8];
        { const f32x4 b0 = *(const f32x4*)(p.in[I_BCONV] + ch0), b1 = *(const f32x4*)(p.in[I_BCONV] + ch0 + 4); acc[0] = b0.x; acc[1] = b0.y; acc[2] = b0.z; acc[3] = b0.w; acc[4] = b1.x; acc[5] = b1.y; acc[6] = b1.z; acc[7] = b1.w; }
        for (int j = 0; j < 31; ++j) { const int tt = t - 30 + j; const float* src;
            if (tt >= 0) src = CB + (size_t)(rb + tt) * 512 + ch0; else if (smp) src = p.in[I_CC] + (size_t)(b * 30 + 30 + tt) * 512 + ch0; else continue;
            const f32x4 c0 = *(const f32x4*)src, c1 = *(const f32x4*)(src + 4), w0 = *(const f32x4*)(p.in[I_WCONV] + j * 512 + ch0), w1 = *(const f32x4*)(p.in[I_WCONV] + j * 512 + ch0 + 4);
            acc[0] += c0.x * w0.x; acc[1] += c0.y * w0.y; acc[2] += c0.z * w0.z; acc[3] += c0.w * w0.w; acc[4] += c1.x * w1.x; acc[5] += c1.y * w1.y; acc[6] += c1.z * w1.z; acc[7] += c1.w * w1.w; }
        float s = 0.f;
#pragma unroll
        for (int e = 0; e < 8; ++e) s += acc[e];
        const float mean = wave_sum(s) * (1.0f / 512.0f); float q = 0.f;
#pragma unroll
        for (int e = 0; e < 8; ++e) { acc[e] -= mean; q += acc[e] * acc[e]; }
        const float rstd = 1.0f / sqrtf(wave_sum(q) * (1.0f / 512.0f) + EPS);
        float y[8];
#pragma unroll
        for (int e = 0; e < 8; ++e) { const float v = acc[e] * rstd * p.in[I_LNG][ch0 + e] + p.in[I_LNB][ch0 + e]; y[e] = v / (1.0f + __expf(-v)); }
        v4u o; o.x = pk2(y[0], y[1]); o.y = pk2(y[2], y[3]); o.z = pk2(y[4], y[5]); o.w = pk2(y[6], y[7]);
        *(v4u*)(A3 + (size_t)r * 1024 + 512 + ch0) = o;
    }
    if constexpr (PH(5)) for (int it = gw; it < (NBP + NBS) * 30; it += NGW) {
        const float* src; float* dst;
        if (it < NBP * 30) { const int b = it / 30, i = it % 30; src = CB + (size_t)(b * 4096 + 4066 + i) * 512; dst = out + O_CP + (size_t)it * 512; }
        else { const int k = it - NBP * 30, b = k / 30, i = k % 30; src = i < 14 ? p.in[I_CC] + (size_t)(b * 30 + 16 + i) * 512 : CB + (size_t)(MPR + b * 16 + i - 14) * 512; dst = out + O_CS + (size_t)k * 512; }
        *(f32x4*)(dst + lane * 8) = *(const f32x4*)(src + lane * 8); *(f32x4*)(dst + lane * 8 + 4) = *(const f32x4*)(src + lane * 8 + 4);
    }
    {
        const float* rel = p.in[I_REL];
        if constexpr (PH(6)) {
            const int vcu = (G % 8 == 0) ? ((int)blockIdx.x % 8) * (G / 8) + (int)blockIdx.x / 8 : (int)blockIdx.x;
            for (int P = vcu; P < 1024; P += G) {
                const int bhv = P >> 3, s = P & 7, b = bhv >> 4, hm = (bhv >> 1) & 7, vh = bhv & 1;
#pragma unroll 1
                for (int k = 0; k < 2; ++k)
                    attn_body::attn_unit<8>(b, hm * 64, hm * 64, (hm >> 1) * 128 + vh * 64, hm * 128 + vh * 64, k ? 15 - s : s, hm >> 1, rel,
                                            (const attn_body::bf16*)QB, (const attn_body::bf16*)KB, (const attn_body::bf16*)VB, (attn_body::bf16*)OAB, (char*)lds_raw);
            }
        }
        if constexpr (PH(7)) for (int it = gw; it < NBS * 16; it += NGW) {
            const int b = it >> 4, hm = (it >> 1) & 7, vh = it & 1, h = hm >> 1, i = lane & 15, r = MPR + b * 16 + i;
            float q[64];
#pragma unroll
            for (int c = 0; c < 8; ++c) unpack8(*(const v4u*)(QB + (size_t)r * 512 + hm * 64 + c * 8), q + c * 8);
            float mx = -1e30f, l = 0.f, o[64];
#pragma unroll
            for (int e = 0; e < 64; ++e) o[e] = 0.f;
            const float* Kc = p.in[I_CK] + (size_t)b * PAST * 512 + hm * 64 + lane; const float* Vc = p.in[I_CV] + (size_t)b * PAST * 512 + h * 128 + vh * 64 + lane;
            const float* Kn = out + O_KS + (size_t)b * 16 * 512 + hm * 64 + lane; const float* Vn = out + O_VS + (size_t)b * 16 * 512 + h * 128 + vh * 64 + lane;
#pragma unroll 1
            for (int j0 = 0; j0 < PAST + 16; j0 += 4) {
                float kk[4], vv[4];
#pragma unroll
                for (int jj = 0; jj < 4; ++jj) { const int j = j0 + jj; kk[jj] = j < PAST ? Kc[(size_t)j * 512] : Kn[(size_t)(j - PAST) * 512]; vv[jj] = j < PAST ? Vc[(size_t)j * 512] : Vn[(size_t)(j - PAST) * 512]; }
#pragma unroll
                for (int jj = 0; jj < 4; ++jj) { float a = 0.f;
#pragma unroll
                    for (int d = 0; d < 64; ++d) a += q[d] * RDL(kk[jj], d);
                    const float sc = a + rel[rel_bucket(j0 + jj - (PAST + i)) * 4 + h] * LOG2E;
                    if (sc > mx) { const float f = exp2f(mx - sc); l *= f;
#pragma unroll
                        for (int e = 0; e < 64; ++e) o[e] *= f;
                        mx = sc; }
                    const float pr = exp2f(sc - mx); l += pr;
#pragma unroll
                    for (int e = 0; e < 64; ++e) o[e] += pr * RDL(vv[jj], e); }
            }
            const float il = 1.0f / l; float* od = OA + (size_t)r * 1024 + hm * 128 + vh * 64;
            if (lane < 16) {
#pragma unroll
                for (int c = 0; c < 16; ++c) *(f32x4*)(od + 4 * c) = (f32x4){o[4 * c] * il, o[4 * c + 1] * il, o[4 * c + 2] * il, o[4 * c + 3] * il}; }
        }
    }
    grid.sync();
    if constexpr (PH(8)) {
        const float lam = compute_lam(p.in[I_LAM], lane);
        for (int r = gw; r < MTOT; r += NGW) {
            const int h = lane >> 4, e0 = (lane & 15) * 8; f32x4 a0, a1, b0, b1;
            if (r < MPR) { float fa[8], fb[8]; unpack8(*(const v4u*)(OAB + (size_t)r * 1024 + (2 * h) * 128 + e0), fa); unpack8(*(const v4u*)(OAB + (size_t)r * 1024 + (2 * h + 1) * 128 + e0), fb);
                a0 = (f32x4){fa[0], fa[1], fa[2], fa[3]}; a1 = (f32x4){fa[4], fa[5], fa[6], fa[7]}; b0 = (f32x4){fb[0], fb[1], fb[2], fb[3]}; b1 = (f32x4){fb[4], fb[5], fb[6], fb[7]}; }
            else { const float* o0 = OA + (size_t)r * 1024 + (2 * h) * 128 + e0; const float* o1 = o0 + 128; a0 = *(const f32x4*)o0; a1 = *(const f32x4*)(o0 + 4); b0 = *(const f32x4*)o1; b1 = *(const f32x4*)(o1 + 4); }
            const f32x4 d0 = a0 - b0 * lam, d1 = a1 - b1 * lam;
            float ss = (d0.x * d0.x + d0.y * d0.y) + (d0.z * d0.z + d0.w * d0.w) + (d1.x * d1.x + d1.y * d1.y) + (d1.z * d1.z + d1.w * d1.w);
            ss += __shfl_xor(ss, 1); ss += __shfl_xor(ss, 2); ss += __shfl_xor(ss, 4); ss += __shfl_xor(ss, 8);
            const float sc = (1.0f - LAM_INIT) / sqrtf(ss * (1.0f / 128.0f) + EPS); const f32x4 g0 = *(const f32x4*)(p.in[I_GSUB] + e0), g1 = *(const f32x4*)(p.in[I_GSUB] + e0 + 4);
            const f32x4 y0 = d0 * g0 * sc, y1 = d1 * g1 * sc;
            v4u o; o.x = pk2(y0.x, y0.y); o.y = pk2(y0.z, y0.w); o.z = pk2(y1.x, y1.y); o.w = pk2(y1.z, y1.w);
            *(v4u*)(A3 + (size_t)r * 1024 + h * 128 + e0) = o;
        }
    }
    grid.sync();
    if constexpr (PH(9)) {
        pg8::Gemm g{A3, WOT, MTOT, 1024, 1024}; pg8::StaticOrder S; S.init(MTOT, 1024, G, (int)blockIdx.x);
        pg8::EpiRes E{p.in[I_XP], p.in[I_XS], X1, X1B, SSP1};
        pg8::gemm_phase<pg8::EpiRes, pg8::StaticOrder, true, true>(lds, g, S, E);
    }
    grid.sync();
    if constexpr (PH(10)) {
        pg8::Gemm g{X1B, WMQT, MTOT, 512, 1024}; pg8::StaticOrder S; S.init(MTOT, 512, G, (int)blockIdx.x);
        pg8::EpiScaleBf16<0> E{SSP1, QM, 512};
        pg8::gemm_phase<pg8::EpiScaleBf16<0>, pg8::StaticOrder, true, true>(lds, g, S, E);
    }
    grid.sync();
    if constexpr (PH(11)) for (int it = gw; it < (MTOT / 16) * 4; it += NGW) {
        const int grp = it >> 2, head = it & 3, c = lane & 15, g = lane >> 4, r = grp * 16 + c, bb = grp < 2048 ? grp >> 8 : 8 + (grp - 2048);
        pg8::bf16x8 qf[4]; float ss = 0.f;
#pragma unroll
        for (int s4 = 0; s4 < 4; ++s4) { const v4u w = *(const v4u*)(QM + (size_t)r * 512 + head * 128 + 32 * s4 + 8 * g); qf[s4] = __builtin_bit_cast(pg8::bf16x8, w); float f[8]; unpack8(w, f);
#pragma unroll
            for (int e = 0; e < 8; ++e) ss += f[e] * f[e]; }
        ss += __shfl_xor(ss, 16); ss += __shfl_xor(ss, 32);
        const float qs = (1.0f / sqrtf(ss * (1.0f / 128.0f) + EPS)) * (0.08838834764831845f * LOG2E);
        const bf16* kb = MKB + (size_t)(bb * 256 + c) * 512 + head * 128 + 8 * g;
        f32x4 st[16]; float mx = -1e30f;
#pragma unroll
        for (int kt = 0; kt < 16; ++kt) { f32x4 acc = (f32x4){0.f, 0.f, 0.f, 0.f};
#pragma unroll
            for (int s4 = 0; s4 < 4; ++s4) { const pg8::bf16x8 kf = *(const pg8::bf16x8*)(kb + (size_t)(16 * kt) * 512 + 32 * s4); acc = __builtin_amdgcn_mfma_f32_16x16x32_bf16(kf, qf[s4], acc, 0, 0, 0); }
            st[kt] = acc * qs; mx = fmaxf(mx, fmaxf(fmaxf(st[kt].x, st[kt].y), fmaxf(st[kt].z, st[kt].w))); }
        mx = fmaxf(mx, __shfl_xor(mx, 16)); mx = fmaxf(mx, __shfl_xor(mx, 32));
        float l = 0.f; pg8::bf16x8 pb[8];
#pragma unroll
        for (int kp = 0; kp < 8; ++kp) { f32x4 p0 = st[2 * kp], p1 = st[2 * kp + 1];
#pragma unroll
            for (int e = 0; e < 4; ++e) { p0[e] = exp2f(p0[e] - mx); p1[e] = exp2f(p1[e] - mx); l += p0[e] + p1[e]; }
            v4u w; w.x = pk2(p0.x, p0.y); w.y = pk2(p0.z, p0.w); w.z = pk2(p1.x, p1.y); w.w = pk2(p1.z, p1.w); pb[kp] = __builtin_bit_cast(pg8::bf16x8, w); }
        l += __shfl_xor(l, 16); l += __shfl_xor(l, 32); const float il = 1.0f / l;
        const bf16* vb = MVT + ((size_t)(bb * 4 + head) * 128 + c) * 256 + 8 * g; bf16* od = OM + (size_t)r * 512 + head * 128 + 4 * g;
#pragma unroll
        for (int et = 0; et < 8; ++et) { f32x4 acc = (f32x4){0.f, 0.f, 0.f, 0.f};
#pragma unroll
            for (int kp = 0; kp < 8; ++kp) { const pg8::bf16x8 vf = *(const pg8::bf16x8*)(vb + (size_t)(16 * et) * 256 + 32 * kp); acc = __builtin_amdgcn_mfma_f32_16x16x32_bf16(vf, pb[kp], acc, 0, 0, 0); }
            v2u w; w.x = pk2(acc.x * il, acc.y * il); w.y = pk2(acc.z * il, acc.w * il); *(v2u*)(od + 16 * et) = w; }
    }
    grid.sync();
    if constexpr (PH(12)) {
        pg8::Gemm g{OM, WMOT, MTOT, 1024, 512}; pg8::StaticOrder S; S.init(MTOT, 1024, G, (int)blockIdx.x);
        pg8::EpiRes E{X1, X1 + (size_t)MPR * 1024, X1, X2B, SSP2};
        pg8::gemm_phase<pg8::EpiRes, pg8::StaticOrder, true, true>(lds, g, S, E);
    }
    grid.sync();
    if constexpr (PH(13)) {
        pg8::Gemm g{X2B, WF1T, MTOT, 4096, 1024}; pg8::StaticOrder S; S.init(MTOT, 4096, G, (int)blockIdx.x);
        pg8::EpiScaleBf16<1> E{SSP2, UB, 4096};
        pg8::gemm_phase<pg8::EpiScaleBf16<1>, pg8::StaticOrder, true, true>(lds, g, S, E);
    }
    grid.sync();
    if constexpr (PH(14)) {
        pg8::Gemm g{UB, WF2T, MTOT, 1024, 4096}; pg8::StaticOrder S; S.init(MTOT, 1024, G, (int)blockIdx.x);
        pg8::EpiOut E{X1, out + O_YP, out + O_YS};
        pg8::gemm_phase<pg8::EpiOut, pg8::StaticOrder, true, true>(lds, g, S, E);
    }
}

extern "C" void kernel_launch(void* const* d_in, const int* in_sizes, int n_in, void* d_out, int out_size, void* d_ws, size_t ws_size, hipStream_t stream) {
    static int grid = 0;
    if (grid == 0) {
        if (n_in != 31 || out_size != (int)O_END || ws_size < WS_END) { fprintf(stderr, "kernel_launch: unexpected shapes (n_in %d, out %d, ws %zu)\n", n_in, out_size, ws_size); grid = -1; return; }
        int dev = 0, cus = 0, per_cu = 0;
        hipGetDevice(&dev); hipDeviceGetAttribute(&cus, hipDeviceAttributeMultiprocessorCount, dev);
        if (hipFuncSetAttribute((const void*)fwd_kernel, hipFuncAttributeMaxDynamicSharedMemorySize, LDS_BYTES) != hipSuccess) { fprintf(stderr, "kernel_launch: hipFuncSetAttribute failed\n"); grid = -1; return; }
        if (hipOccupancyMaxActiveBlocksPerMultiprocessor(&per_cu, (const void*)fwd_kernel, NTHREADS, LDS_BYTES) != hipSuccess || per_cu < 1) { fprintf(stderr, "kernel_launch: occupancy query failed (%d)\n", per_cu); (void)hipGetLastError(); per_cu = 1; }
        if (per_cu > 1) per_cu = 1;
        grid = cus * per_cu;
        if (grid % 8 != 0 || grid < 8) { fprintf(stderr, "kernel_launch: unexpected CU count %d\n", cus); }
    }
    if (grid < 0) return;
    Params p{};
    for (int i = 0; i < 31; ++i) p.in[i] = (const float*)d_in[i];
    p.out = (float*)d_out; p.ws = (unsigned char*)d_ws;
    void* args[] = {&p};
    hipError_t e = hipLaunchCooperativeKernel((const void*)fwd_kernel, dim3(grid), dim3(NTHREADS), args, LDS_BYTES, stream);
    if (e != hipSuccess) fprintf(stderr, "kernel_launch: cooperative launch failed: %s (grid %d)\n", hipGetErrorString(e), grid);
}
```

```cpp
#include <hip/hip_runtime.h>
#include <hip/hip_cooperative_groups.h>
#include <cstdio>
#include <cstdint>
namespace pg8 {
#define PG8_LAS __attribute__((address_space(3)))
typedef unsigned short bf16_t;
typedef short bf16x8 __attribute__((ext_vector_type(8)));
typedef float f32x4 __attribute__((ext_vector_type(4)));
typedef unsigned u32x4 __attribute__((ext_vector_type(4)));
constexpr int BM = 256, BK = 64, HALF = 128, HTB = HALF * BK * 2  , STAGE_BYTES = 8 * HTB, NXCD = 8, WGM = 8;

__host__ __device__ __forceinline__ int lds_byte(int r, int c) { const int st = (r >> 4) * 2 + (c >> 5), rr = r & 15, cc = c & 31, ob = rr * 64 + cc * 2; return st * 1024 + (ob ^ (((ob >> 9) & 1) << 5)); }
__host__ __device__ __forceinline__ void stage_rc(int b, int& R, int& C) { const int st = b / 1024, sb = b % 1024, swz = sb ^ (((sb >> 9) & 1) << 5); R = (st >> 1) * 16 + swz / 64; C = (st & 1) * 32 + (swz % 64) / 2; }
__host__ __device__ __forceinline__ int perm32(int rho) { const int n = rho >> 4, i = rho & 15; return 8 * (i >> 2) + 4 * n + (i & 3); }

struct Unit { int pm, pn; };
struct Gemm { const bf16_t* A; const bf16_t* Bt; int M, N, K; };

struct StaticOrder {
    int nM, nN, nwg, G, c;
    __host__ __device__ void init(int M, int N, int G_, int c_) { nM = M / BM; nN = N / BM; nwg = nM * nN; G = G_; c = c_; }
    __host__ __device__ bool next(int i, Unit& u) const {
        const long L = (long)i * G + c; if (L >= nwg) return false;
        int wgid = (int)L; { const int q = nwg / NXCD, r = nwg % NXCD, xcd = wgid % NXCD, off = wgid / NXCD; wgid = (xcd < r ? xcd * (q + 1) : r * (q + 1) + (xcd - r) * q) + off; }
        const int nig = WGM * nN, gid = wgid / nig, fm = gid * WGM, gsz = (nM - fm) < WGM ? (nM - fm) : WGM;
        u.pm = fm + ((wgid % nig) % gsz); u.pn = (wgid % nig) / gsz; return true;
    }
    __device__ __forceinline__ void a_ready(const Unit&) const {}
    __device__ __forceinline__ void done(const Unit&) const {}
};

__device__ __forceinline__ unsigned cvt_pk_bf16(float lo, float hi) { unsigned r; asm volatile("v_cvt_pk_bf16_f32 %0, %1, %2" : "=v"(r) : "v"(lo), "v"(hi)); return r; }
typedef float f32x2 __attribute__((ext_vector_type(2)));

constexpr int MP = 32768;
constexpr float EPSN = 1e-6f;
constexpr float QC2 = 0.125f * 1.4426950408889634f;
__device__ __forceinline__ void st_bf16x8(bf16_t* p, const f32x4 a, const f32x4 b) { u32x4 w; w.x = cvt_pk_bf16(a[0], a[1]); w.y = cvt_pk_bf16(a[2], a[3]); w.z = cvt_pk_bf16(b[0], b[1]); w.w = cvt_pk_bf16(b[2], b[3]); *(u32x4*)p = w; }
__device__ __forceinline__ float dot4(const f32x4 a) { return (a[0] * a[0] + a[1] * a[1]) + (a[2] * a[2] + a[3] * a[3]); }

struct EpiG1 {
    static constexpr bool PERM = true, AFTER_DRAIN = false;
    const float* rs; const float* gq; const float* gk;
    bf16_t* Q; bf16_t* KB; bf16_t* VB; float* C;
    float* kp; float* ks; float* vp; float* vs;
    __device__ __forceinline__ void operator()(const f32x4 (&acc)[2][2][4][2], const Unit& u, int wr, int wc, int fr, int fq) const {
        const int pn = u.pn;
#pragma unroll
        for (int ai = 0; ai < 2; ++ai)
#pragma unroll
            for (int m = 0; m < 4; ++m) {
                const int r = u.pm * BM + ai * HALF + wr * 64 + m * 16 + fr;
                const float rsv = rs[r];
                if (pn < 4) {
                    f32x4 v[2][2]; float ss = 0.f;
#pragma unroll
                    for (int bj = 0; bj < 2; ++bj)
#pragma unroll
                        for (int n = 0; n < 2; ++n) { v[bj][n] = acc[ai][bj][m][n] * rsv; ss += dot4(v[bj][n]); }
                    ss += __shfl_xor(ss, 16); ss += __shfl_xor(ss, 32);
                    const float rstd = 1.0f / sqrtf(ss * (1.0f / 64.0f) + EPSN);
                    const float* g = pn < 2 ? gq : gk; const float sc = pn < 2 ? rstd * QC2 : rstd;
                    const int grp = 4 * (pn & 1) + wc;
#pragma unroll
                    for (int bj = 0; bj < 2; ++bj) {
                        const int d0 = 32 * bj + 8 * fq; const f32x4 g0 = *(const f32x4*)(g + d0), g1 = *(const f32x4*)(g + d0 + 4);
                        const f32x4 o0 = v[bj][0] * g0 * sc, o1 = v[bj][1] * g1 * sc; const int col = 64 * grp + d0;
                        if (pn < 2) st_bf16x8(Q + (size_t)r * 512 + col, o0, o1);
                        else { float* ko = (r < MP ? kp + (size_t)r * 512 : ks + (size_t)(r - MP) * 512) + col; *(f32x4*)ko = o0; *(f32x4*)(ko + 4) = o1; st_bf16x8(KB + (size_t)r * 512 + col, o0, o1); }
                    }
                } else if (pn < 6) {
#pragma unroll
                    for (int bj = 0; bj < 2; ++bj) {
                        const int col = 256 * (pn - 4) + 128 * bj + 32 * wc + 8 * fq; const f32x4 o0 = acc[ai][bj][m][0] * rsv, o1 = acc[ai][bj][m][1] * rsv;
                        float* vo = (r < MP ? vp + (size_t)r * 512 : vs + (size_t)(r - MP) * 512) + col; *(f32x4*)vo = o0; *(f32x4*)(vo + 4) = o1; st_bf16x8(VB + (size_t)r * 512 + col, o0, o1);
                    }
                } else {
                    const int ch = 128 * (pn - 6) + 32 * wc + 8 * fq;
#pragma unroll
                    for (int n = 0; n < 2; ++n) { const f32x4 a = acc[ai][0][m][n] * rsv, gt = acc[ai][1][m][n] * rsv; f32x4 c;
#pragma unroll
                        for (int e = 0; e < 4; ++e) c[e] = a[e] / (1.0f + __expf(-gt[e]));
                        *(f32x4*)(C + (size_t)r * 512 + ch + 4 * n) = c; }
                }
            }
    }
};
struct EpiMem {
    static constexpr bool PERM = true, AFTER_DRAIN = false;
    const float* rs; float* mk; float* mv;
    __device__ __forceinline__ void operator()(const f32x4 (&acc)[2][2][4][2], const Unit& u, int wr, int wc, int fr, int fq) const {
        float* base = u.pn < 2 ? mk : mv; const int cb = 256 * (u.pn & 1);
#pragma unroll
        for (int ai = 0; ai < 2; ++ai)
#pragma unroll
            for (int m = 0; m < 4; ++m) { const int r = u.pm * BM + ai * HALF + wr * 64 + m * 16 + fr; const float rsv = rs[r];
#pragma unroll
                for (int bj = 0; bj < 2; ++bj) { float* o = base + (size_t)r * 512 + cb + 128 * bj + 32 * wc + 8 * fq; *(f32x4*)o = acc[ai][bj][m][0] * rsv; *(f32x4*)(o + 4) = acc[ai][bj][m][1] * rsv; } }
    }
};
struct EpiRes {
    static constexpr bool PERM = true, AFTER_DRAIN = false;
    const float* res_p; const float* res_s; float* xo; bf16_t* xb; float* ssp;
    __device__ __forceinline__ void operator()(const f32x4 (&acc)[2][2][4][2], const Unit& u, int wr, int wc, int fr, int fq) const {
#pragma unroll
        for (int ai = 0; ai < 2; ++ai)
#pragma unroll
            for (int m = 0; m < 4; ++m) { const int r = u.pm * BM + ai * HALF + wr * 64 + m * 16 + fr;
                const float* rr = r < MP ? res_p + (size_t)r * 1024 : res_s + (size_t)(r - MP) * 1024; float ss = 0.f;
#pragma unroll
                for (int bj = 0; bj < 2; ++bj) { const int col = 256 * u.pn + 128 * bj + 32 * wc + 8 * fq;
                    const f32x4 x0 = *(const f32x4*)(rr + col) + acc[ai][bj][m][0], x1 = *(const f32x4*)(rr + col + 4) + acc[ai][bj][m][1];
                    *(f32x4*)(xo + (size_t)r * 1024 + col) = x0; *(f32x4*)(xo + (size_t)r * 1024 + col + 4) = x1; st_bf16x8(xb + (size_t)r * 1024 + col, x0, x1); ss += dot4(x0) + dot4(x1); }
                ss += __shfl_xor(ss, 16); ss += __shfl_xor(ss, 32);
                if (fq == 0) ssp[(size_t)r * 16 + 4 * u.pn + wc] = ss; }
    }
};
__device__ __forceinline__ float row_rs(const float* ssp, int r) { const f32x4 a = *(const f32x4*)(ssp + (size_t)r * 16), b = *(const f32x4*)(ssp + (size_t)r * 16 + 4), c = *(const f32x4*)(ssp + (size_t)r * 16 + 8), d = *(const f32x4*)(ssp + (size_t)r * 16 + 12);
    const float s = ((a[0] + a[1]) + (a[2] + a[3])) + ((b[0] + b[1]) + (b[2] + b[3])) + ((c[0] + c[1]) + (c[2] + c[3])) + ((d[0] + d[1]) + (d[2] + d[3])); return 1.0f / sqrtf(s * (1.0f / 1024.0f) + EPSN); }
template <int ACT> struct EpiScaleBf16 {
    static constexpr bool PERM = true, AFTER_DRAIN = false;
    const float* ssp; bf16_t* O; int ldc;
    __device__ __forceinline__ void operator()(const f32x4 (&acc)[2][2][4][2], const Unit& u, int wr, int wc, int fr, int fq) const {
#pragma unroll
        for (int ai = 0; ai < 2; ++ai)
#pragma unroll
            for (int m = 0; m < 4; ++m) { const int r = u.pm * BM + ai * HALF + wr * 64 + m * 16 + fr; const float rsv = row_rs(ssp, r);
#pragma unroll
                for (int bj = 0; bj < 2; ++bj) { const int col = 256 * u.pn + 128 * bj + 32 * wc + 8 * fq; f32x4 o0 = acc[ai][bj][m][0] * rsv, o1 = acc[ai][bj][m][1] * rsv;
                    if (ACT == 1) {
#pragma unroll
                        for (int e = 0; e < 4; ++e) { const float a = fmaxf(o0[e], 0.f), b = fmaxf(o1[e], 0.f); o0[e] = a * a; o1[e] = b * b; } }
                    st_bf16x8(O + (size_t)r * ldc + col, o0, o1); } }
    }
};
struct EpiOut {
    static constexpr bool PERM = true, AFTER_DRAIN = false;
    const float* res; float* yp; float* ys;
    __device__ __forceinline__ void operator()(const f32x4 (&acc)[2][2][4][2], const Unit& u, int wr, int wc, int fr, int fq) const {
#pragma unroll
        for (int ai = 0; ai < 2; ++ai)
#pragma unroll
            for (int m = 0; m < 4; ++m) { const int r = u.pm * BM + ai * HALF + wr * 64 + m * 16 + fr;
                const float* rr = res + (size_t)r * 1024; float* yo = r < MP ? yp + (size_t)r * 1024 : ys + (size_t)(r - MP) * 1024;
#pragma unroll
                for (int bj = 0; bj < 2; ++bj) { const int col = 256 * u.pn + 128 * bj + 32 * wc + 8 * fq;
                    *(f32x4*)(yo + col) = *(const f32x4*)(rr + col) + acc[ai][bj][m][0]; *(f32x4*)(yo + col + 4) = *(const f32x4*)(rr + col + 4) + acc[ai][bj][m][1]; } }
    }
};
template <class Epi, class Sched, bool ALIGN_EPI = false, bool SP2 = false>
__device__ __forceinline__ void gemm_phase(PG8_LAS unsigned char* lds, const Gemm g, const Sched& S, const Epi& E) {
    int tid = threadIdx.x; asm volatile("" : "+v"(tid));
    const int wid = __builtin_amdgcn_readfirstlane(tid >> 6), lane = tid & 63, wr = wid >> 2, wc = wid & 3, fr = lane & 15, fq = lane >> 4;
    const int K = g.K, nt = K / BK;
    unsigned voffA[2], voffB[2];
#pragma unroll
    for (int i = 0; i < 2; ++i) { int R, C; stage_rc(tid * 16 + i * 8192, R, C); const int Rb = Epi::PERM ? ((R & ~31) + perm32(R & 31)) : R;
        voffA[i] = (unsigned)(R * K + C) * 2u; voffB[i] = (unsigned)(Rb * K + C) * 2u; }
    const size_t kstep = (size_t)(BK * 2);
    const size_t hstep = (size_t)HALF * K * 2;
    const size_t tstep = 2 * hstep;
    const unsigned ldsw = (unsigned)wid * 1024u;
    const int aoff = lds_byte(wr * 64 + fr, fq * 8), boff = lds_byte(wc * 32 + fr, fq * 8);
#define PG8_SA(b, h) (((b) * 2 + (h)) * HTB)
#define PG8_SB(b, h) ((4 + (b) * 2 + (h)) * HTB)
#define PG8_STAGE(bufoff, gbase, voff) do { _Pragma("unroll") for (int _i = 0; _i < 2; ++_i) \
        __builtin_amdgcn_global_load_lds((const unsigned*)((const char*)(gbase) + (voff)[_i]), (PG8_LAS unsigned*)(lds + (bufoff) + ldsw + _i * 8192), 16, 0, 0); } while (0)
#define PG8_LDA(dst, b, h) do { _Pragma("unroll") for (int m = 0; m < 4; ++m) _Pragma("unroll") for (int k = 0; k < 2; ++k) dst[m][k] = *(const PG8_LAS bf16x8*)(lds + PG8_SA(b, h) + aoff + m * 2048 + k * 1024); } while (0)
#define PG8_LDB(dst, b, h) do { _Pragma("unroll") for (int n = 0; n < 2; ++n) _Pragma("unroll") for (int k = 0; k < 2; ++k) dst[n][k] = *(const PG8_LAS bf16x8*)(lds + PG8_SB(b, h) + boff + n * 2048 + k * 1024); } while (0)
#define PG8_MMA(ai, bj, At, Bt) do { __builtin_amdgcn_s_setprio(1); _Pragma("unroll") for (int m = 0; m < 4; ++m) _Pragma("unroll") for (int n = 0; n < 2; ++n) _Pragma("unroll") for (int k = 0; k < 2; ++k) \
        acc[ai][bj][m][n] = __builtin_amdgcn_mfma_f32_16x16x32_bf16(Bt[n][k], At[m][k], acc[ai][bj][m][n], 0, 0, 0); __builtin_amdgcn_s_setprio(0); } while (0)
#define PG8_WAIT_V(n) asm volatile("s_waitcnt vmcnt(" #n ")" ::: "memory")
#define PG8_WAIT_L(n) asm volatile("s_waitcnt lgkmcnt(" #n ")" ::: "memory")
#define PG8_BAR __builtin_amdgcn_s_barrier()
#define PG8_SCHED __builtin_amdgcn_sched_barrier(0)
    Unit cur, nxt; int ui = 0;
    if (!S.next(0, cur)) return;
    f32x4 acc[2][2][4][2];
#pragma unroll
    for (int a = 0; a < 2; ++a)
#pragma unroll
        for (int b = 0; b < 2; ++b)
#pragma unroll
            for (int m = 0; m < 4; ++m)
#pragma unroll
                for (int n = 0; n < 2; ++n) acc[a][b][m][n] = (f32x4){0.f, 0.f, 0.f, 0.f};
    bf16x8 At[4][2], B0[2][2], B1[2][2];
    const char* cA = (const char*)g.A + (size_t)cur.pm * tstep; const char* cB = (const char*)g.Bt + (size_t)cur.pn * tstep;
    S.a_ready(cur);
    if constexpr (SP2) {
        PG8_STAGE(PG8_SB(0, 0), cB, voffB); PG8_STAGE(PG8_SB(0, 1), cB + hstep, voffB); PG8_STAGE(PG8_SA(0, 0), cA, voffA); PG8_STAGE(PG8_SA(0, 1), cA + hstep, voffA);
        if (wr == 1) PG8_BAR;
        PG8_WAIT_V(2); PG8_BAR;
        PG8_STAGE(PG8_SB(1, 0), cB + kstep, voffB); PG8_STAGE(PG8_SA(1, 0), cA + kstep, voffA); PG8_STAGE(PG8_SB(1, 1), cB + hstep + kstep, voffB);
        PG8_WAIT_V(6); PG8_BAR;
    } else {
        PG8_STAGE(PG8_SB(0, 0), cB, voffB); PG8_STAGE(PG8_SA(0, 0), cA, voffA); PG8_STAGE(PG8_SB(0, 1), cB + hstep, voffB); PG8_STAGE(PG8_SA(0, 1), cA + hstep, voffA);
        if (wr == 1) PG8_BAR;
        PG8_WAIT_V(4); PG8_BAR;
        PG8_STAGE(PG8_SB(1, 0), cB + kstep, voffB); PG8_STAGE(PG8_SA(1, 0), cA + kstep, voffA); PG8_STAGE(PG8_SB(1, 1), cB + hstep + kstep, voffB);
        PG8_WAIT_V(6); PG8_BAR;
    }
    for (;;) {
        const bool has_next = S.next(ui + 1, nxt);
        const char* nA = has_next ? (const char*)g.A + (size_t)nxt.pm * tstep : cA; const char* nB = has_next ? (const char*)g.Bt + (size_t)nxt.pn * tstep : cB;
        for (int t = 0; t < nt; t += 2) {
            const bool last = (t == nt - 2);
            const char* a1 = cA + (size_t)(t + 1) * kstep;
            const char* a2 = last ? nA : cA + (size_t)(t + 2) * kstep; const char* b2 = last ? nB : cB + (size_t)(t + 2) * kstep;
            const char* a3 = a2 + kstep; const char* b3 = b2 + kstep;
            if (last && has_next) S.a_ready(nxt);
            if constexpr (SP2) {
            PG8_LDB(B0, 0, 0); PG8_LDB(B1, 0, 1); PG8_SCHED; PG8_LDA(At, 0, 0); PG8_STAGE(PG8_SA(1, 1), a1 + hstep, voffA);
            PG8_WAIT_V(8); PG8_WAIT_L(0); PG8_BAR; PG8_MMA(0, 0, At, B0); PG8_MMA(0, 1, At, B1); PG8_BAR; PG8_SCHED;
            PG8_LDA(At, 0, 1); PG8_STAGE(PG8_SB(0, 0), b2, voffB); PG8_STAGE(PG8_SB(0, 1), b2 + hstep, voffB); PG8_STAGE(PG8_SA(0, 0), a2, voffA);
            PG8_WAIT_V(8); PG8_WAIT_L(0); PG8_BAR; PG8_MMA(1, 0, At, B0); PG8_MMA(1, 1, At, B1); PG8_BAR; PG8_SCHED;
            PG8_LDB(B0, 1, 0); PG8_LDB(B1, 1, 1); PG8_SCHED; PG8_LDA(At, 1, 0); PG8_STAGE(PG8_SA(0, 1), a2 + hstep, voffA);
            PG8_WAIT_V(8); PG8_WAIT_L(0); PG8_BAR; PG8_MMA(0, 0, At, B0); PG8_MMA(0, 1, At, B1); PG8_BAR; PG8_SCHED;
            PG8_LDA(At, 1, 1); PG8_STAGE(PG8_SB(1, 0), b3, voffB); PG8_STAGE(PG8_SB(1, 1), b3 + hstep, voffB); PG8_STAGE(PG8_SA(1, 0), a3, voffA);
            PG8_WAIT_V(8); PG8_WAIT_L(0); PG8_BAR; PG8_MMA(1, 0, At, B0); PG8_MMA(1, 1, At, B1); PG8_BAR; PG8_SCHED;
            } else {
            PG8_LDB(B0, 0, 0); PG8_SCHED; PG8_LDA(At, 0, 0); PG8_STAGE(PG8_SA(1, 1), a1 + hstep, voffA);
            PG8_WAIT_L(8); PG8_BAR; PG8_WAIT_L(0); PG8_MMA(0, 0, At, B0); PG8_BAR; PG8_SCHED;
            PG8_LDB(B1, 0, 1); PG8_STAGE(PG8_SB(0, 0), b2, voffB);
            PG8_BAR; PG8_WAIT_L(0); PG8_MMA(0, 1, At, B1); PG8_BAR;
            PG8_LDA(At, 0, 1); PG8_STAGE(PG8_SA(0, 0), a2, voffA);
            PG8_BAR; PG8_WAIT_L(0); PG8_MMA(1, 0, At, B0); PG8_BAR; PG8_SCHED;
            PG8_STAGE(PG8_SB(0, 1), b2 + hstep, voffB);
            PG8_WAIT_V(6); PG8_BAR; PG8_MMA(1, 1, At, B1); PG8_BAR;
            PG8_LDB(B0, 1, 0); PG8_SCHED; PG8_LDA(At, 1, 0); PG8_STAGE(PG8_SA(0, 1), a2 + hstep, voffA);
            PG8_WAIT_L(8); PG8_BAR; PG8_WAIT_L(0); PG8_MMA(0, 0, At, B0); PG8_BAR; PG8_SCHED;
            PG8_LDB(B1, 1, 1); PG8_STAGE(PG8_SB(1, 0), b3, voffB);
            PG8_BAR; PG8_WAIT_L(0); PG8_MMA(0, 1, At, B1); PG8_BAR;
            PG8_LDA(At, 1, 1); PG8_STAGE(PG8_SA(1, 0), a3, voffA);
            PG8_BAR; PG8_WAIT_L(0); PG8_MMA(1, 0, At, B0); PG8_BAR; PG8_SCHED;
            PG8_STAGE(PG8_SB(1, 1), b3 + hstep, voffB);
            PG8_WAIT_V(6); PG8_BAR; PG8_MMA(1, 1, At, B1); PG8_BAR;
            }
        }
        if constexpr (ALIGN_EPI) { if (wr == 0) PG8_BAR; }
        if constexpr (!Epi::AFTER_DRAIN) { E(acc, cur, wr, wc, fr, fq); S.done(cur); }
        if (!has_next) break;
#pragma unroll
        for (int a = 0; a < 2; ++a)
#pragma unroll
            for (int b = 0; b < 2; ++b)
#pragma unroll
                for (int m = 0; m < 4; ++m)
#pragma unroll
                    for (int n = 0; n < 2; ++n) acc[a][b][m][n] = (f32x4){0.f, 0.f, 0.f, 0.f};
        cur = nxt; cA = nA; cB = nB; ++ui;
        if constexpr (ALIGN_EPI) { if (wr == 1) PG8_BAR; }
    }
    PG8_WAIT_V(0);
    if constexpr (!ALIGN_EPI) { if (wr == 0) PG8_BAR; }
    PG8_BAR;
    if constexpr (Epi::AFTER_DRAIN) { E.fused(acc, cur, wr, wc, fr, fq, lds, wid, lane); S.done(cur); }
#undef PG8_SA
#undef PG8_SB
#undef PG8_STAGE
#undef PG8_LDA
#undef PG8_LDB
#undef PG8_MMA
#undef PG8_WAIT_V
#undef PG8_WAIT_L
#undef PG8_BAR
#undef PG8_SCHED
}
}
#include <hip/hip_bf16.h>
#include <cmath>
namespace attn_body {
using bf16=__hip_bfloat16;
using bf16x8=__attribute__((ext_vector_type(8)))short;
using s16x4=__attribute__((ext_vector_type(4)))short;
using f32x16=__attribute__((ext_vector_type(16)))float;
using u32x4=__attribute__((ext_vector_type(4)))unsigned;
constexpr int SEQ=4096,D=64,PQ=512,PK=512,PV=512,PO=1024;
constexpr int NW=8,QBLK=32,QB=QBLK*NW,KVBLK=64,NQB=SEQ/QB;
constexpr int ATTN_UNIT_ROWS=QB;
__device__ __forceinline__ int crow(int r,int hi){return (r&3)+8*(r>>2)+4*hi;}
#define SBAR() __builtin_amdgcn_sched_barrier(0)
typedef __attribute__((address_space(3))) const float* lds_fptr;
__device__ __forceinline__ void bmask(f32x16&p0,f32x16&p1,int dist,lds_fptr tb){
  if(dist<0){
    #pragma unroll
    for(int r=0;r<16;++r){p0[r]=-INFINITY;p1[r]=-INFINITY;}
  } else if(dist<=2){
    #pragma unroll
    for(int r=0;r<16;++r){const int o=(r&3)+8*(r>>2); p0[r]+=tb[o]; p1[r]+=tb[o+32];}
  }
}

__device__ __forceinline__ void binit(f32x16&c0,f32x16&c1,int dist,lds_fptr tb){
  if(dist<0){
    #pragma unroll
    for(int r=0;r<16;++r){c0[r]=-INFINITY;c1[r]=-INFINITY;}
  } else if(dist<=2){
    #pragma unroll
    for(int r=0;r<16;++r){const int o=(r&3)+8*(r>>2); c0[r]=tb[o]; c1[r]=tb[o+32];}
  } else {
    #pragma unroll
    for(int r=0;r<16;++r){c0[r]=0.f;c1[r]=0.f;}
  }
}
__device__ __forceinline__ void binit1(f32x16&c,int dist,lds_fptr tb){
  if(dist<0){
    #pragma unroll
    for(int r=0;r<16;++r)c[r]=-INFINITY;
  } else if(dist<=2){
    #pragma unroll
    for(int r=0;r<16;++r)c[r]=tb[(r&3)+8*(r>>2)];
  } else {
    #pragma unroll
    for(int r=0;r<16;++r)c[r]=0.f;
  }
}
__device__ __forceinline__ void bpost(f32x16&c0,f32x16&c1,float mhat){
  #pragma unroll
  for(int r=0;r<16;++r){c0[r]-=mhat;c1[r]-=mhat;}
}
constexpr int NSLOT=3, SLOTB=8192;
constexpr int LDS_K=0, LDS_V=NSLOT*SLOTB, LDS_WS=2*NSLOT*SLOTB, LDS_OST=LDS_WS+NW*64*4, LDS_BYTES=LDS_OST+NW*4096;
constexpr float C2=0.125f*1.4426950408889634f;
__device__ __forceinline__ void glds16(const void*gsrc,unsigned lds_dst){unsigned keep;
  asm volatile("s_mov_b32 %0, m0\n\ts_mov_b32 m0, %2\n\ts_nop 0\n\tglobal_load_lds_dwordx4 %1, off\n\ts_mov_b32 m0, %0":"=&s"(keep):"v"(gsrc),"s"(lds_dst):"memory");}
__device__ __forceinline__ float max3f(float a,float b,float c){float r;asm("v_max3_f32 %0, %1, %2, %3":"=v"(r):"v"(a),"v"(b),"v"(c));return r;}
__device__ __forceinline__ float max2f(float a,float b){float r;asm("v_max_f32_e32 %0, %1, %2":"=v"(r):"v"(a),"v"(b));return r;}
__device__ __forceinline__ float fadd_s(float a,float b){float r;asm("v_add_f32_e32 %0, %1, %2":"=v"(r):"v"(a),"v"(b));return r;}
__device__ __forceinline__ float fsub_s(float a,float b){float r;asm("v_sub_f32_e32 %0, %1, %2":"=v"(r):"v"(a),"v"(b));return r;}
typedef float f32x2_t __attribute__((ext_vector_type(2))); typedef __bf16 bf16x2_t __attribute__((ext_vector_type(2)));
__device__ __forceinline__ unsigned cvtpk_s(float lo,float hi){f32x2_t v={lo,hi};bf16x2_t b=__builtin_convertvector(v,bf16x2_t);return __builtin_bit_cast(unsigned,b);}
#define WAIT_BAR(N) asm volatile("s_waitcnt vmcnt(" #N ") lgkmcnt(0)\n\ts_barrier":::"memory")

__device__ __forceinline__ void qkt(f32x16&p0,f32x16&p1,const char*Kslot,const bf16x8*qr,const f32x16&negm,int r32,int hi){
  const char*kb=Kslot+hi*1024+r32*16;
  #pragma unroll
  for(int d0=0;d0<4;++d0){
    const bf16x8 b0=*reinterpret_cast<const bf16x8*>(kb+d0*2048);
    const bf16x8 b1=*reinterpret_cast<const bf16x8*>(kb+d0*2048+512);
    {p0=__builtin_amdgcn_mfma_f32_32x32x16_bf16(b0,qr[d0],p0,0,0,0);p1=__builtin_amdgcn_mfma_f32_32x32x16_bf16(b1,qr[d0],p1,0,0,0);}}
}
typedef __attribute__((address_space(3))) const char* lds_cptr;
typedef short v4i16_t __attribute__((ext_vector_type(4)));
__device__ __forceinline__ void kload8(bf16x8*kf,lds_cptr kp){
  kf[0]=*(const __attribute__((address_space(3))) bf16x8*)(kp);      kf[1]=*(const __attribute__((address_space(3))) bf16x8*)(kp+512);
  kf[2]=*(const __attribute__((address_space(3))) bf16x8*)(kp+2048); kf[3]=*(const __attribute__((address_space(3))) bf16x8*)(kp+2560);
  kf[4]=*(const __attribute__((address_space(3))) bf16x8*)(kp+4096); kf[5]=*(const __attribute__((address_space(3))) bf16x8*)(kp+4608);
  kf[6]=*(const __attribute__((address_space(3))) bf16x8*)(kp+6144); kf[7]=*(const __attribute__((address_space(3))) bf16x8*)(kp+6656);
}
__device__ __forceinline__ void kload2(bf16x8*kf,lds_cptr kp,int j){ kf[2*j]=*(const __attribute__((address_space(3))) bf16x8*)(kp+j*2048); kf[2*j+1]=*(const __attribute__((address_space(3))) bf16x8*)(kp+j*2048+512); }
__device__ __forceinline__ s16x4 vtr(lds_cptr p){ return __builtin_bit_cast(s16x4,__builtin_amdgcn_ds_read_tr16_b64_v4i16((__attribute__((address_space(3))) v4i16_t*)p)); }
__device__ __forceinline__ float rowmax(const f32x16&p0,const f32x16&p1){
  float a=max3f(p0[0],p0[1],p1[0]),b=max3f(p0[2],p0[3],p1[1]);a=max3f(a,p1[2],p1[3]);
  #pragma unroll
  for(int r=4;r<16;r+=4){a=max3f(a,p0[r],p0[r+1]);b=max3f(b,p0[r+2],p0[r+3]);a=max3f(a,p1[r],p1[r+1]);b=max3f(b,p1[r+2],p1[r+3]);}
  const float m=max2f(a,b);
  auto rr=__builtin_amdgcn_permlane32_swap(__float_as_uint(m),__float_as_uint(m),false,false);
  return max2f(__uint_as_float(rr[0]),__uint_as_float(rr[1]));
}
__device__ __forceinline__ void pv(f32x16*o,int vb,bf16x8 pa0,bf16x8 pa1,bf16x8 pa2,bf16x8 pa3){
  #pragma unroll
  for(int d0=0;d0<2;++d0){s16x4 lo[4],hi[4];
    #pragma unroll
    for(int ks=0;ks<4;++ks){
      asm volatile("ds_read_b64_tr_b16 %0,%1 offset:%c2":"=&v"(lo[ks]):"v"(vb),"i"(d0*4096+ks*1024):"memory");
      asm volatile("ds_read_b64_tr_b16 %0,%1 offset:%c2":"=&v"(hi[ks]):"v"(vb),"i"(d0*4096+ks*1024+512):"memory");}
    asm volatile("s_waitcnt lgkmcnt(0)":::"memory");SBAR();
    #define PK(k) (bf16x8){lo[k][0],lo[k][1],lo[k][2],lo[k][3],hi[k][0],hi[k][1],hi[k][2],hi[k][3]}
    o[d0]=__builtin_amdgcn_mfma_f32_32x32x16_bf16(pa0,PK(0),o[d0],0,0,0);
    o[d0]=__builtin_amdgcn_mfma_f32_32x32x16_bf16(pa1,PK(1),o[d0],0,0,0);
    o[d0]=__builtin_amdgcn_mfma_f32_32x32x16_bf16(pa2,PK(2),o[d0],0,0,0);
    o[d0]=__builtin_amdgcn_mfma_f32_32x32x16_bf16(pa3,PK(3),o[d0],0,0,0);
    #undef PK
  }
}

#ifndef ATTN_STORE16
#define ATTN_STORE16(p,v) (*(u32x4*)(p)=(v))
#endif
template<int THRL> __device__ __forceinline__ void attn_unit(int b,int qcol,int kcol,int vcol,int ocol,int qb,int hd,const float*reltab,const bf16*Q,const bf16*__restrict__ K,const bf16*__restrict__ V,bf16*O,char*shm){
  int tid=threadIdx.x; asm volatile("":"+v"(tid));
  const int lane=tid&63,r32=lane&31,hi=lane>>5; const int wid=__builtin_amdgcn_readfirstlane(tid>>6);
  const long rowbase=(long)b*SEQ; const int q0=qb*QB;
  const bf16*Qw=Q+(rowbase+q0+wid*QBLK)*PQ+qcol;
  const bf16*Kh=K+rowbase*PK+kcol,*Vh=V+rowbase*PV+vcol;
  const lds_cptr shm3=(lds_cptr)shm;
  const unsigned lds0=(unsigned)(uintptr_t)shm;
  float*wsf=(float*)(shm+LDS_WS)+wid*64;
  const bf16*ksrc=Kh+(long)lane*PK+wid*8;
  const bf16*vsrc=Vh+(long)(16*(wid&3)+(lane>>2))*PV+(wid>>2)*32+(lane&3)*8;
  const unsigned kdst=lds0+LDS_K+wid*1024, vdst=lds0+LDS_V+wid*1024;
  #define DMA_K(t,slot) glds16(ksrc+(long)(t)*KVBLK*PK,(unsigned)__builtin_amdgcn_readfirstlane(kdst+(slot)))
  #define DMA_V(t,slot) glds16(vsrc+(long)(t)*KVBLK*PV,(unsigned)__builtin_amdgcn_readfirstlane(vdst+(slot)))
  const int vb0=(int)(lds0+LDS_V)+((lane>>4)&1)*32+(lane&3)*8+(4*hi+((lane&15)>>2))*64;
  const char*Kbase=shm+LDS_K; bf16x8 kf[8];
  const lds_cptr kp0=shm3+LDS_K+hi*1024+r32*16; const lds_cptr vp0=shm3+LDS_V+((lane>>4)&1)*32+(lane&3)*8+(4*hi+((lane&15)>>2))*64;
  const int NT=(q0+QB)/KVBLK;
  DMA_K(0,0);DMA_V(0,0);DMA_K(1,SLOTB);
  if(tid<256){ const int rel_=tid-191, n_=rel_<0?-rel_:rel_; const int bk_=(rel_>0?16:0)+(n_<8?n_:min(15,2+(31-__clz(n_*n_))));
    ((__attribute__((address_space(3))) float*)(shm3+LDS_BYTES))[tid]=(reltab[bk_*4+hd]-reltab[15*4+hd])*1.4426950408889634f; }
  bf16x8 qr[4];
  #pragma unroll
  for(int d0=0;d0<4;++d0)qr[d0]=*reinterpret_cast<const bf16x8*>(&Qw[(long)r32*PQ+d0*16+hi*8]);
  float mhat=0.f,l_reg=0.f;f32x16 o[2];o[0]=f32x16{};o[1]=f32x16{};f32x16 negm=f32x16{};asm volatile("":"+v"(negm));
  const int wc2=wid>>1; const lds_fptr dtl=(lds_fptr)(shm3+LDS_BYTES)+191-(32*(wid&1)+r32)+4*hi;
  bool resc=false;
  #define START(P0,P1) do{ const float rm=rowmax(P0,P1); resc=false; \
    { const float dl=rm; mhat=fadd_s(mhat,dl); \
      _Pragma("unroll") for(int r=0;r<16;++r){P0[r]=fsub_s(P0[r],dl);P1[r]=fsub_s(P1[r],dl);} \
      _Pragma("unroll") for(int r=0;r<16;++r)negm[r]=-mhat; asm volatile("":"+v"(negm)); } \
    _Pragma("unroll") for(int r=0;r<16;++r)P0[r]=__builtin_amdgcn_exp2f(P0[r]); }while(0)
  #define RESC() do{ if(resc){ asm volatile("s_waitcnt lgkmcnt(0)":::"memory"); \
      _Pragma("unroll") for(int d_=0;d_<2;++d_) _Pragma("unroll") for(int r=0;r<16;++r)o[d_][r]*=wsf[crow(r,hi)]; } }while(0)
  f32x16 pA0,pA1,pB0,pB1;
  int sl_prev=0,sl_cur=0,sl_next=SLOTB;
  #define ROT() do{sl_prev=sl_cur;sl_cur=sl_next;sl_next=(sl_next==(NSLOT-1)*SLOTB)?0:sl_next+SLOTB;}while(0)
  DMA_K(2,2*SLOTB);
  WAIT_BAR(3);
  { const int dist_=wc2+(NT-4); binit(pA0,pA1,dist_,dtl-64*dist_); }
  qkt(pA0,pA1,Kbase,qr,negm,r32,hi);asm volatile("s_nop 15\n\ts_nop 7":"+v"(pA0),"+v"(pA1));
  START(pA0,pA1);
  _Pragma("unroll") for(int r=0;r<16;++r)pA1[r]=__builtin_amdgcn_exp2f(pA1[r]);
  WAIT_BAR(0);
  DMA_K(3,0);DMA_V(1,SLOTB);
  ROT();
  kload8(kf,kp0+sl_cur);
  WAIT_BAR(2);
  s16x4 vlo[8],vhi[8]; u32x4 pw0,pw1,pw2,pw3;
  #define PKW(P,B) cvtpk_s(P[B],P[B+1])
  #define PAF(k) __builtin_bit_cast(bf16x8,pw##k)
  #define VFR(i) (bf16x8){vlo[i][0],vlo[i][1],vlo[i][2],vlo[i][3],vhi[i][0],vhi[i][1],vhi[i][2],vhi[i][3]}
  #define PIN(x) asm volatile("":"+v"(x))
  #define MX3(a,b,c) __builtin_fmaxf(__builtin_fmaxf((a),(b)),(c))
  #define GAPA(MF,A0,A1,A2,A3,W0,W1,PW) do{ MF; sacc+=A0; sacc+=A1; sacc+=A2; sacc+=A3; PIN(sacc); W0; W1; PIN(PW); SBAR(); }while(0)
  #define EX(v) __builtin_amdgcn_exp2f(v)
  #define GAPB(MF,X,B) do{ MF; X[B]=EX(X[B]); X[B+1]=EX(X[B+1]); X[B+2]=EX(X[B+2]); X[B+3]=EX(X[B+3]); PIN(X); SBAR(); }while(0)
  #define VRD(i) do{ vlo[i]=vtr(vp_+(((i)>>2)*4096+((i)&3)*1024)); vhi[i]=vtr(vp_+(((i)>>2)*4096+((i)&3)*1024+512)); }while(0)
  #define KRD(G,j) do{ if(G){ kload2(kf,kp0+sl_next,j); SBAR(); } }while(0)
  #define STEP(C0,C1,P0,P1,t,GK,GV,GL) do{ SBAR(); \
    const lds_cptr vp_=vp0+sl_prev; \
    CINIT0(C0,t); VRD(0); SBAR(); float sacc=(P0[0]+P0[1]); \
    GAPA(C0=__builtin_amdgcn_mfma_f32_32x32x16_bf16(kf[0],qr[0],CSRC(C0),0,0,0), P0[2],P0[3],P0[4],P0[5],     pw0[0]=PKW(P0,0), pw0[1]=PKW(P0,2), pw0); \
    CINIT1(C1,t); VRD(4); SBAR(); GAPA(C1=__builtin_amdgcn_mfma_f32_32x32x16_bf16(kf[1],qr[0],CSRC(C1),0,0,0), P0[6],P0[7],P0[8],P0[9],     pw0[2]=PKW(P0,4), pw0[3]=PKW(P0,6), pw0); \
    VRD(1); SBAR(); GAPA(C0=__builtin_amdgcn_mfma_f32_32x32x16_bf16(kf[2],qr[1],C0,0,0,0),   P0[10],P0[11],P0[12],P0[13], pw1[0]=PKW(P0,8), pw1[1]=PKW(P0,10), pw1); \
    VRD(5); SBAR(); GAPA(C1=__builtin_amdgcn_mfma_f32_32x32x16_bf16(kf[3],qr[1],C1,0,0,0),   P0[14],P0[15],P1[0],P1[1],   pw1[2]=PKW(P0,12),pw1[3]=PKW(P0,14), pw1); \
    VRD(2); SBAR(); GAPA(C0=__builtin_amdgcn_mfma_f32_32x32x16_bf16(kf[4],qr[2],C0,0,0,0),   P1[2],P1[3],P1[4],P1[5],     pw2[0]=PKW(P1,0), pw2[1]=PKW(P1,2), pw2); \
    VRD(6); SBAR(); GAPA(C1=__builtin_amdgcn_mfma_f32_32x32x16_bf16(kf[5],qr[2],C1,0,0,0),   P1[6],P1[7],P1[8],P1[9],     pw2[2]=PKW(P1,4), pw2[3]=PKW(P1,6), pw2); \
    VRD(3); SBAR(); GAPA(C0=__builtin_amdgcn_mfma_f32_32x32x16_bf16(kf[6],qr[3],C0,0,0,0),   P1[10],P1[11],P1[12],P1[13], pw3[0]=PKW(P1,8), pw3[1]=PKW(P1,10), pw3); \
    VRD(7); SBAR(); GAPA(C1=__builtin_amdgcn_mfma_f32_32x32x16_bf16(kf[7],qr[3],C1,0,0,0),   P1[14],P1[15],0.f,0.f,       pw3[2]=PKW(P1,12),pw3[3]=PKW(P1,14), pw3); \
    l_reg+=sacc; \
    if(GK){DMA_K((t)+3,sl_cur);} if(GV){DMA_V((t)+1,sl_next);} \
    CPOST(C0,C1); \
    { float a=MX3(C0[0],C0[1],C1[0]),b=MX3(C0[2],C0[3],C1[1]); a=MX3(a,C1[2],C1[3]); \
      _Pragma("unroll") for(int r=4;r<16;r+=4){a=MX3(a,C0[r],C0[r+1]);b=MX3(b,C0[r+2],C0[r+3]);a=MX3(a,C1[r],C1[r+1]);b=MX3(b,C1[r+2],C1[r+3]);} \
      float rm=__builtin_fmaxf(a,b); { auto rr=__builtin_amdgcn_permlane32_swap(__float_as_uint(rm),__float_as_uint(rm),false,false); rm=__builtin_fmaxf(__uint_as_float(rr[0]),__uint_as_float(rr[1])); } \
      resc=false; \
      if(__builtin_expect(__any(rm>(float)THRL),0)){ const float dl=__builtin_fmaxf(rm,0.f); mhat+=dl; \
        _Pragma("unroll") for(int r=0;r<16;++r){C0[r]-=dl;C1[r]-=dl;} \
        NEGM_UPD(); \
        const float f=__builtin_amdgcn_exp2f(-dl); l_reg*=f; if(hi==0)wsf[r32]=f; resc=true; } } \
    SBAR(); \
    GAPB(o[0]=__builtin_amdgcn_mfma_f32_32x32x16_bf16(PAF(0),VFR(0),o[0],0,0,0), C0,0); \
    GAPB(o[1]=__builtin_amdgcn_mfma_f32_32x32x16_bf16(PAF(0),VFR(4),o[1],0,0,0), C0,4); \
    KRD(GL,0); GAPB(o[0]=__builtin_amdgcn_mfma_f32_32x32x16_bf16(PAF(1),VFR(1),o[0],0,0,0), C0,8); \
    KRD(GL,1); GAPB(o[1]=__builtin_amdgcn_mfma_f32_32x32x16_bf16(PAF(1),VFR(5),o[1],0,0,0), C0,12); \
    KRD(GL,2); GAPB(o[0]=__builtin_amdgcn_mfma_f32_32x32x16_bf16(PAF(2),VFR(2),o[0],0,0,0), C1,0); \
    KRD(GL,3); GAPB(o[1]=__builtin_amdgcn_mfma_f32_32x32x16_bf16(PAF(2),VFR(6),o[1],0,0,0), C1,4); \
    GAPB(o[0]=__builtin_amdgcn_mfma_f32_32x32x16_bf16(PAF(3),VFR(3),o[0],0,0,0), C1,8); \
    GAPB(o[1]=__builtin_amdgcn_mfma_f32_32x32x16_bf16(PAF(3),VFR(7),o[1],0,0,0), C1,12); \
    }while(0)
  int t=1;
  #define CINIT0(C,t) do{}while(0)
  #define CINIT1(C,t) do{}while(0)
  #define CSRC(C) negm
  #define CPOST(C0,C1) do{}while(0)
  #define NEGM_UPD() do{ _Pragma("unroll") for(int r=0;r<16;++r)negm[r]=-mhat; asm volatile("":"+v"(negm)); }while(0)
  for(;t+7<NT;t+=2){
    STEP(pB0,pB1,pA0,pA1,t,true,true,true);     WAIT_BAR(2); RESC(); ROT();
    STEP(pA0,pA1,pB0,pB1,t+1,true,true,true);   WAIT_BAR(2); RESC(); ROT();
  }
  #undef CINIT0
  #undef CINIT1
  #undef CSRC
  #undef CPOST
  #undef NEGM_UPD
  #define NEGM_UPD() do{}while(0)
  #define CINIT0(C,t) do{const int dist_=wc2+(NT-4-(t)); binit1(C,dist_,dtl-64*dist_);}while(0)
  #define CINIT1(C,t) do{const int dist_=wc2+(NT-4-(t)); binit1(C,dist_,dtl-64*dist_+32);}while(0)
  #define CSRC(C) C
  #define CPOST(C0,C1) bpost(C0,C1,mhat)
  #define ENDW(tt) do{ if((tt)+3<NT){WAIT_BAR(2);} else if((tt)+2<NT){WAIT_BAR(1);} else {WAIT_BAR(0);} }while(0)
  for(;t+1<NT;t+=2){
    STEP(pB0,pB1,pA0,pA1,t,(t+3<NT),(t+1<NT),(t+1<NT));       ENDW(t);   RESC(); ROT();
    STEP(pA0,pA1,pB0,pB1,t+1,(t+4<NT),(t+2<NT),(t+2<NT));     ENDW(t+1); RESC(); ROT();
  }
  STEP(pB0,pB1,pA0,pA1,NT-1,false,false,false); RESC();
  { float sacc=pB0[0]+pB0[1]; _Pragma("unroll") for(int r=2;r<16;++r)sacc+=pB0[r]; _Pragma("unroll") for(int r=0;r<16;++r)sacc+=pB1[r]; l_reg+=sacc;
    pw0=(u32x4){PKW(pB0,0),PKW(pB0,2),PKW(pB0,4),PKW(pB0,6)};pw1=(u32x4){PKW(pB0,8),PKW(pB0,10),PKW(pB0,12),PKW(pB0,14)};pw2=(u32x4){PKW(pB1,0),PKW(pB1,2),PKW(pB1,4),PKW(pB1,6)};pw3=(u32x4){PKW(pB1,8),PKW(pB1,10),PKW(pB1,12),PKW(pB1,14)};
    SBAR(); pv(o,vb0+sl_cur,PAF(0),PAF(1),PAF(2),PAF(3)); }
  #undef PKW
  #undef PAF
  #undef VFR
  #undef PIN
  #undef MX3
  #undef GAPA
  #undef GAPB
  #undef EX
  #undef VRD
  #undef KRD
  #undef STEP
  #undef ENDW
  {auto rr=__builtin_amdgcn_permlane32_swap(__float_as_uint(l_reg),__float_as_uint(l_reg),false,false);l_reg=__uint_as_float(rr[0])+__uint_as_float(rr[1]);}
  if(hi==0)wsf[32+r32]=l_reg;asm volatile("s_waitcnt lgkmcnt(0)":::"memory");
  float rli[16];
  #pragma unroll
  for(int r=0;r<16;++r)rli[r]=__builtin_amdgcn_rcpf(wsf[32+crow(r,hi)]);
  bf16*Ow=O+(rowbase+q0+wid*QBLK)*PO+ocol;
  { bf16*stg=(bf16*)(shm+LDS_OST)+wid*2048;
    #pragma unroll
    for(int r=0;r<16;++r){const int orow=crow(r,hi);
      #pragma unroll
      for(int d0=0;d0<2;++d0)stg[orow*64+d0*32+r32]=__float2bfloat16(o[d0][r]*rli[r]);}
    asm volatile("s_waitcnt lgkmcnt(0)":::"memory");
    #pragma unroll
    for(int i=0;i<4;++i){const int row=i*8+(lane>>3),ch=lane&7; const u32x4 v=*(const u32x4*)(stg+row*64+ch*8); ATTN_STORE16(Ow+(long)row*PO+ch*8,v);} }
  asm volatile("s_waitcnt lgkmcnt(0)\n\ts_barrier":::"memory");
  #undef DMA_K
  #undef DMA_V
  #undef CINIT0
  #undef CINIT1
  #undef CSRC
  #undef CPOST
  #undef NEGM_UPD
  #undef START
  #undef RESC
  #undef ROT
}
constexpr int ATTN_LDS_BYTES=LDS_BYTES+1024;
#undef SBAR
#undef WAIT_BAR
}

namespace cg = cooperative_groups;
constexpr int NWAVES = 8, NTHREADS = 512;
constexpr int MTOT = 33280, MPR = 32768, MSA = 512;
constexpr int DM = 1024, TP = 4096, TS = 16, NBP = 8, NBS = 32, PAST = 4096;
constexpr float EPS = 1e-6f, LOG2E = 1.4426950408889634f;
constexpr float LAM_INIT = 0.2f;
constexpr size_t O_YP = 0, O_YS = 33554432, O_KP = 34078720, O_VP = 50855936, O_CP = 67633152, O_MK = 67756032, O_MV = 68804608, O_KS = 69853184, O_VS = 70115328, O_CS = 70377472, O_END = 70868992;
constexpr size_t MiB = 1u << 20;
constexpr size_t WS_RS0 = 1 * MiB, WS_RSM = 1 * MiB + 256 * 1024, WS_SSP1 = 2 * MiB, WS_SSP2 = 5 * MiB, WS_QSS = 8 * MiB;
constexpr size_t WS_W1T = 12 * MiB, WS_WOT = 17 * MiB, WS_WMQT = 19 * MiB, WS_WMKVT = 20 * MiB, WS_WMOT = 22 * MiB, WS_WF1T = 23 * MiB, WS_WF2T = 31 * MiB;
constexpr size_t WS_MEMB = 40 * MiB, WS_MKB = 44 * MiB, WS_MVB = 54 * MiB;
constexpr size_t WS_XB = 64 * MiB, WS_Q = 130 * MiB, WS_KB = 163 * MiB, WS_VB = 196 * MiB, WS_C = 229 * MiB, WS_A3 = 294 * MiB, WS_OA = 360 * MiB;
constexpr size_t WS_X1 = 490 * MiB, WS_X1B = 620 * MiB, WS_QM = 685 * MiB, WS_OM = 718 * MiB, WS_X2B = 751 * MiB, WS_END = 816 * MiB;
constexpr size_t WS_PART = 426 * MiB;
constexpr int SNP = 1;
constexpr size_t WS_U = 64 * MiB;
static_assert(WS_U + (size_t)MTOT * 4096 * 2 <= WS_OA, "U overlay");
#ifndef PHMASK
#define PHMASK 0xFFFFF
#endif
#define PH(k) ((PHMASK >> (k)) & 1)
constexpr int LDS_BYTES = 147456;

#define LAS __attribute__((address_space(3)))
typedef unsigned short bf16;
typedef unsigned v4u __attribute__((ext_vector_type(4)));
typedef unsigned v2u __attribute__((ext_vector_type(2)));
typedef float f32x4 __attribute__((ext_vector_type(4)));
__device__ __forceinline__ unsigned f2bf(float f) { unsigned u = __builtin_bit_cast(unsigned, f); return (u + 0x7fffu + ((u >> 16) & 1u)) >> 16; }
__device__ __forceinline__ unsigned pk2(float lo, float hi) { return f2bf(lo) | (f2bf(hi) << 16); }
__device__ __forceinline__ float bf2f(unsigned h) { return __builtin_bit_cast(float, h << 16); }
__device__ __forceinline__ float wave_sum(float v) {
#pragma unroll
    for (int o = 1; o < 64; o <<= 1) v += __shfl_xor(v, o);
    return v;
}
__device__ __forceinline__ void unpack8(const v4u w, float* f) { f[0] = bf2f(w.x & 0xffffu); f[1] = bf2f(w.x >> 16); f[2] = bf2f(w.y & 0xffffu); f[3] = bf2f(w.y >> 16); f[4] = bf2f(w.z & 0xffffu); f[5] = bf2f(w.z >> 16); f[6] = bf2f(w.w & 0xffffu); f[7] = bf2f(w.w >> 16); }

struct Params { const float* in[31]; float* out; unsigned char* ws; };
enum { I_XP = 0, I_XS, I_CK, I_CV, I_CC, I_CMK, I_CMV, I_MEM, I_REL, I_GMIX, I_WIN, I_GQ, I_GK, I_LAM, I_GSUB, I_WCONV, I_BCONV, I_LNG, I_LNB, I_WOUT, I_GCROSS, I_GMEM, I_WMQ, I_WMK, I_WMV, I_GMQ, I_GMK, I_WMO, I_GFFN, I_WFF1, I_WFF2 };

__device__ __forceinline__ int rel_bucket(int rel) {
    const int n = rel < 0 ? -rel : rel; const int lg = n < 8 ? n : min(15, 2 + (31 - __clz(n * n)));
    return (rel > 0 ? 16 : 0) + lg;
}
#define RDL(x, d) __builtin_bit_cast(float, __builtin_amdgcn_readlane(__builtin_bit_cast(int, (x)), (d)))
__device__ __forceinline__ float compute_lam(const float* lv, int lane) {
    const float a = wave_sum(lv[lane] * lv[64 + lane]), b = wave_sum(lv[128 + lane] * lv[192 + lane]);
    return __expf(a) - __expf(b) + LAM_INIT;
}

__device__ __forceinline__ void p0_transpose_item(const float* W, int K, int N, const float* gain, bf16* WT, int dst_row0, LAS float* scr, int k0, int n0, int lane) {
#pragma unroll 8
    for (int i = 0; i < 32; ++i) { const int kk = 2 * i + (lane >> 5); const float g = gain ? gain[k0 + kk] : 1.0f; scr[kk * 33 + (lane & 31)] = W[(size_t)(k0 + kk) * N + n0 + (lane & 31)] * g; }
    asm volatile("s_waitcnt lgkmcnt(0)" ::: "memory");
    const int c = lane & 7;
#pragma unroll
    for (int j = 0; j < 4; ++j) { const int n = (lane >> 3) + 8 * j; const LAS float* s = scr + (8 * c) * 33 + n;
        v4u o; o.x = pk2(s[0 * 33], s[1 * 33]); o.y = pk2(s[2 * 33], s[3 * 33]); o.z = pk2(s[4 * 33], s[5 * 33]); o.w = pk2(s[6 * 33], s[7 * 33]);
        *(v4u*)(WT + (size_t)(dst_row0 + n) * K + k0 + 8 * c) = o; }
    asm volatile("s_waitcnt lgkmcnt(0)" ::: "memory");
}
__device__ __forceinline__ int w1_row(int a) {
    if (a < 1024) { const int pn = a >> 8, wc = (a >> 6) & 3, bj = (a >> 5) & 1; return 256 * pn + 128 * bj + 32 * wc; }
    if (a < 1536) return a;
    const int g = a >= 2048, ch = a - (g ? 2048 : 1536), t = ch >> 7, wc = (ch >> 5) & 3; return 1536 + 256 * t + 128 * g + 32 * wc;
}
__device__ __forceinline__ void row_to_bf16_rs(const float* xrow, bf16* orow, float* rs_out, int lane) {
    const f32x4* xr = (const f32x4*)xrow + lane; f32x4 v[4]; float s = 0.f;
#pragma unroll
    for (int j = 0; j < 4; ++j) { v[j] = xr[64 * j]; s += (v[j].x * v[j].x + v[j].y * v[j].y) + (v[j].z * v[j].z + v[j].w * v[j].w); }
    s = wave_sum(s);
    unsigned long long* o8 = (unsigned long long*)orow + lane;
#pragma unroll
    for (int j = 0; j < 4; ++j) o8[64 * j] = (unsigned long long)pk2(v[j].x, v[j].y) | ((unsigned long long)pk2(v[j].z, v[j].w) << 32);
    if (lane == 0) *rs_out = 1.0f / sqrtf(s * (1.0f / 1024.0f) + EPS);
}


typedef short s16x4 __attribute__((ext_vector_type(4)));
constexpr int PART_STRIDE = 132;
template <int NS> __device__ __forceinline__ void sample_attn_task(int b, int h, int sp, int lane_in, const bf16* QB, const float* ck, const float* cv, const float* kn, const float* vn, const float* rel, float* PART) {
    int lane = lane_in; asm volatile("" : "+v"(lane));
    const int c = lane & 15, g = lane >> 4;
    const int T0 = (257 * sp) / NS, T1 = (257 * (sp + 1)) / NS;
    pg8::bf16x8 qf[2][2];
#pragma unroll
    for (int m = 0; m < 2; ++m)
#pragma unroll
        for (int s2 = 0; s2 < 2; ++s2) qf[m][s2] = *(const pg8::bf16x8*)(QB + (size_t)(MPR + b * 16 + c) * 512 + (2 * h + m) * 64 + 32 * s2 + 8 * g);
    f32x4 O[2][8]; float mx[2], ls[2];
#pragma unroll
    for (int m = 0; m < 2; ++m) { mx[m] = -1e30f; ls[m] = 0.f;
#pragma unroll
        for (int et = 0; et < 8; ++et) O[m][et] = (f32x4){0.f, 0.f, 0.f, 0.f}; }
    const float* Kc = ck + (size_t)b * PAST * 512 + (2 * h) * 64 + 8 * g; const float* Kn = kn + (size_t)b * 16 * 512 + (2 * h) * 64 + 8 * g;
    const float* Vc = cv + (size_t)b * PAST * 512 + h * 128 + c; const float* Vn = vn + (size_t)b * 16 * 512 + h * 128 + c;
    f32x4 rk[2][2][2]; float rv[8][4];
#define SA_LOAD(t) do { const float* kr_ = (t) < 256 ? Kc + (size_t)(16 * (t) + c) * 512 : Kn + (size_t)c * 512; const float* vr_ = (t) < 256 ? Vc + (size_t)(16 * (t) + 4 * g) * 512 : Vn + (size_t)(4 * g) * 512; \
        _Pragma("unroll") for (int m = 0; m < 2; ++m) _Pragma("unroll") for (int s2 = 0; s2 < 2; ++s2) { rk[m][s2][0] = *(const f32x4*)(kr_ + m * 64 + 32 * s2); rk[m][s2][1] = *(const f32x4*)(kr_ + m * 64 + 32 * s2 + 4); } \
        _Pragma("unroll") for (int et = 0; et < 8; ++et) _Pragma("unroll") for (int j = 0; j < 4; ++j) rv[et][j] = vr_[(size_t)j * 512 + 16 * et]; } while (0)
    SA_LOAD(T0);
#pragma unroll 1
    for (int t = T0; t < T1; ++t) {
        pg8::bf16x8 kf[2][2]; s16x4 vf[8];
#pragma unroll
        for (int m = 0; m < 2; ++m)
#pragma unroll
            for (int s2 = 0; s2 < 2; ++s2) { v4u w; w.x = attn_body::cvtpk_s(rk[m][s2][0].x, rk[m][s2][0].y); w.y = attn_body::cvtpk_s(rk[m][s2][0].z, rk[m][s2][0].w); w.z = attn_body::cvtpk_s(rk[m][s2][1].x, rk[m][s2][1].y); w.w = attn_body::cvtpk_s(rk[m][s2][1].z, rk[m][s2][1].w); kf[m][s2] = __builtin_bit_cast(pg8::bf16x8, w); }
#pragma unroll
        for (int et = 0; et < 8; ++et) { v2u w; w.x = attn_body::cvtpk_s(rv[et][0], rv[et][1]); w.y = attn_body::cvtpk_s(rv[et][2], rv[et][3]); vf[et] = __builtin_bit_cast(s16x4, w); }
        if (t + 1 < T1) SA_LOAD(t + 1);
        const bool near = t >= 244;
#pragma unroll
        for (int m = 0; m < 2; ++m) {
            f32x4 sc = (f32x4){0.f, 0.f, 0.f, 0.f};
            sc = __builtin_amdgcn_mfma_f32_16x16x32_bf16(kf[m][0], qf[m][0], sc, 0, 0, 0); sc = __builtin_amdgcn_mfma_f32_16x16x32_bf16(kf[m][1], qf[m][1], sc, 0, 0, 0);
            if (near) { const float far = rel[15 * 4 + h];
#pragma unroll
                for (int r = 0; r < 4; ++r) sc[r] += (rel[rel_bucket(16 * t + 4 * g + r - (PAST + c)) * 4 + h] - far) * LOG2E; }
            float tm = fmaxf(fmaxf(sc.x, sc.y), fmaxf(sc.z, sc.w)); tm = fmaxf(tm, __shfl_xor(tm, 16)); tm = fmaxf(tm, __shfl_xor(tm, 32));
            if (__any(tm > mx[m])) { const float mn = fmaxf(mx[m], tm), al = __builtin_amdgcn_exp2f(mx[m] - mn); mx[m] = mn; ls[m] *= al;
#pragma unroll
                for (int et = 0; et < 8; ++et) O[m][et] *= al; }
            float ps = 0.f;
#pragma unroll
            for (int r = 0; r < 4; ++r) { sc[r] = __builtin_amdgcn_exp2f(sc[r] - mx[m]); ps += sc[r]; }
            ls[m] += ps;
            v2u pw; pw.x = attn_body::cvtpk_s(sc.x, sc.y); pw.y = attn_body::cvtpk_s(sc.z, sc.w); const s16x4 pb = __builtin_bit_cast(s16x4, pw);
#pragma unroll
            for (int et = 0; et < 8; ++et) O[m][et] = __builtin_amdgcn_mfma_f32_16x16x16bf16_1k(vf[et], pb, O[m][et], 0, 0, 0);
        }
    }
#undef SA_LOAD
#pragma unroll
    for (int m = 0; m < 2; ++m) { float l = ls[m]; l += __shfl_xor(l, 16); l += __shfl_xor(l, 32);
        float* pd = PART + ((size_t)(((b * 4 + h) * NS + sp) * 2 + m) * 16 + c) * PART_STRIDE;
#pragma unroll
        for (int et = 0; et < 8; ++et) *(f32x4*)(pd + 16 * et + 4 * g) = O[m][et];
        if (g == 0) { pd[128] = mx[m]; pd[129] = l; } }
}

__device__ __forceinline__ void conv_task(int task, int lane_in, const float* CB, const float* cc, const float* wconv, const float* bconv, const float* lng, const float* lnb, bf16* A3) {
    int lane = lane_in; asm volatile("" : "+v"(lane));
    const int r0 = task * 4; const bool smp = r0 >= MPR; const int b = smp ? (r0 - MPR) >> 4 : r0 >> 12, t0 = smp ? (r0 - MPR) & 15 : r0 & 4095, rb = smp ? MPR + b * 16 : b * 4096, ch0 = lane * 8;
    f32x4 acc[4][2], W[4][2];
    { const f32x4 b0 = *(const f32x4*)(bconv + ch0), b1 = *(const f32x4*)(bconv + ch0 + 4);
#pragma unroll
        for (int o = 0; o < 4; ++o) { acc[o][0] = b0; acc[o][1] = b1; W[o][0] = (f32x4){0.f, 0.f, 0.f, 0.f}; W[o][1] = (f32x4){0.f, 0.f, 0.f, 0.f}; } }
    const float* cbase = CB + (size_t)rb * 512 + ch0; const float* ccb = cc + (size_t)(b * 30 + 30) * 512 + ch0; const float* wb = wconv + ch0;
#pragma unroll 1
    for (int k = 0; k < 9; ++k) {
#pragma unroll
        for (int rr = 0; rr < 4; ++rr) { const int i = 4 * k + rr, tt = t0 - 30 + i;
            f32x4 c0 = (f32x4){0.f, 0.f, 0.f, 0.f}, c1 = c0;
            if (i < 34) { if (tt >= 0) { c0 = *(const f32x4*)(cbase + (size_t)tt * 512); c1 = *(const f32x4*)(cbase + (size_t)tt * 512 + 4); } else if (smp) { c0 = *(const f32x4*)(ccb + (ptrdiff_t)tt * 512); c1 = *(const f32x4*)(ccb + (ptrdiff_t)tt * 512 + 4); } }
            if (i < 31) { W[rr][0] = *(const f32x4*)(wb + i * 512); W[rr][1] = *(const f32x4*)(wb + i * 512 + 4); } else { W[rr][0] = (f32x4){0.f, 0.f, 0.f, 0.f}; W[rr][1] = W[rr][0]; }
#pragma unroll
            for (int o = 0; o < 4; ++o) { acc[o][0] += W[(rr - o) & 3][0] * c0; acc[o][1] += W[(rr - o) & 3][1] * c1; } }
    }
    const f32x4 g0 = *(const f32x4*)(lng + ch0), g1 = *(const f32x4*)(lng + ch0 + 4), bb0 = *(const f32x4*)(lnb + ch0), bb1 = *(const f32x4*)(lnb + ch0 + 4);
#pragma unroll
    for (int o = 0; o < 4; ++o) {
        f32x4 a0 = acc[o][0], a1 = acc[o][1];
        const float mean = wave_sum((a0.x + a0.y) + (a0.z + a0.w) + (a1.x + a1.y) + (a1.z + a1.w)) * (1.0f / 512.0f);
        a0 = a0 - mean; a1 = a1 - mean;
        const float rstd = 1.0f / sqrtf(wave_sum((a0.x * a0.x + a0.y * a0.y) + (a0.z * a0.z + a0.w * a0.w) + (a1.x * a1.x + a1.y * a1.y) + (a1.z * a1.z + a1.w * a1.w)) * (1.0f / 512.0f) + EPS);
        a0 = a0 * rstd * g0 + bb0; a1 = a1 * rstd * g1 + bb1;
        float y[8] = {a0.x, a0.y, a0.z, a0.w, a1.x, a1.y, a1.z, a1.w};
#pragma unroll
        for (int e = 0; e < 8; ++e) y[e] = y[e] / (1.0f + __expf(-y[e]));
        v4u w; w.x = pk2(y[0], y[1]); w.y = pk2(y[2], y[3]); w.z = pk2(y[4], y[5]); w.w = pk2(y[6], y[7]);
        *(v4u*)(A3 + (size_t)(r0 + o) * 1024 + 512 + ch0) = w;
    }
}

__global__ void __launch_bounds__(NTHREADS, 2) fwd_kernel(Params p) {
    extern __shared__ __attribute__((aligned(16))) unsigned char lds_raw[];
    LAS unsigned char* lds = (LAS unsigned char*)lds_raw;
    cg::grid_group grid = cg::this_grid();
    const int tid = threadIdx.x, lane = tid & 63, wave = __builtin_amdgcn_readfirstlane(tid >> 6);
    const int G = gridDim.x, gw = blockIdx.x * NWAVES + wave, NGW = G * NWAVES;
    unsigned char* ws = p.ws; float* out = p.out;
    float* RS0 = (float*)(ws + WS_RS0); float* RSM = (float*)(ws + WS_RSM); float* SSP1 = (float*)(ws + WS_SSP1); float* SSP2 = (float*)(ws + WS_SSP2);
    bf16* W1T = (bf16*)(ws + WS_W1T); bf16* WOT = (bf16*)(ws + WS_WOT); bf16* WMQT = (bf16*)(ws + WS_WMQT); bf16* WMKVT = (bf16*)(ws + WS_WMKVT); bf16* WMOT = (bf16*)(ws + WS_WMOT);
    bf16* WF1T = (bf16*)(ws + WS_WF1T); bf16* WF2T = (bf16*)(ws + WS_WF2T); bf16* MEMB = (bf16*)(ws + WS_MEMB);
    bf16* XB = (bf16*)(ws + WS_XB); bf16* QB = (bf16*)(ws + WS_Q); bf16* KB = (bf16*)(ws + WS_KB); bf16* VB = (bf16*)(ws + WS_VB); float* CB = (float*)(ws + WS_C);
    bf16* A3 = (bf16*)(ws + WS_A3); float* OA = (float*)(ws + WS_OA); bf16* OAB = (bf16*)(ws + WS_OA); float* PART = (float*)(ws + WS_PART); float* X1 = (float*)(ws + WS_X1); bf16* X1B = (bf16*)(ws + WS_X1B); bf16* QM = (bf16*)(ws + WS_QM); bf16* OM = (bf16*)(ws + WS_OM);
    bf16* X2B = (bf16*)(ws + WS_X2B); bf16* MKB = (bf16*)(ws + WS_MKB); bf16* MVT = (bf16*)(ws + WS_MVB); bf16* UB = (bf16*)(ws + WS_U);

    if constexpr (PH(0)) {
        LAS float* scr = (LAS float*)(lds + wave * 16384);
        constexpr int I1 = 16 * 80, I2 = 16 * 32, I3 = 16 * 16, I6 = 8 * 32, I7 = 16 * 128, I8 = 64 * 32;
        constexpr int NITEMS = I1 + I2 + 3 * I3 + I6 + I7 + I8;
        for (int it = gw; it < NITEMS; it += NGW) {
            int r = it;
            if (r < I1) { const int kb = r / 80, nb = r % 80; p0_transpose_item(p.in[I_WIN], 1024, 2560, p.in[I_GMIX], W1T, w1_row(32 * nb), scr, 64 * kb, 32 * nb, lane); continue; } r -= I1;
            if (r < I2) { const int kb = r / 32, nb = r % 32; p0_transpose_item(p.in[I_WOUT], 1024, 1024, nullptr, WOT, 32 * nb, scr, 64 * kb, 32 * nb, lane); continue; } r -= I2;
            if (r < I3) { const int kb = r / 16, nb = r % 16; p0_transpose_item(p.in[I_WMQ], 1024, 512, p.in[I_GCROSS], WMQT, 32 * nb, scr, 64 * kb, 32 * nb, lane); continue; } r -= I3;
            if (r < I3) { const int kb = r / 16, nb = r % 16; p0_transpose_item(p.in[I_WMK], 1024, 512, p.in[I_GMEM], WMKVT, 32 * nb, scr, 64 * kb, 32 * nb, lane); continue; } r -= I3;
            if (r < I3) { const int kb = r / 16, nb = r % 16; p0_transpose_item(p.in[I_WMV], 1024, 512, p.in[I_GMEM], WMKVT, 512 + 32 * nb, scr, 64 * kb, 32 * nb, lane); continue; } r -= I3;
            if (r < I6) { const int kb = r / 32, nb = r % 32; p0_transpose_item(p.in[I_WMO], 512, 1024, nullptr, WMOT, 32 * nb, scr, 64 * kb, 32 * nb, lane); continue; } r -= I6;
            if (r < I7) { const int kb = r / 128, nb = r % 128; p0_transpose_item(p.in[I_WFF1], 1024, 4096, p.in[I_GFFN], WF1T, 32 * nb, scr, 64 * kb, 32 * nb, lane); continue; } r -= I7;
            { const int kb = r / 32, nb = r % 32; p0_transpose_item(p.in[I_WFF2], 4096, 1024, nullptr, WF2T, 32 * nb, scr, 64 * kb, 32 * nb, lane); }
        }
        for (int m = gw; m < MTOT + 2048; m += NGW) {
            if (m < MPR) row_to_bf16_rs(p.in[I_XP] + (size_t)m * 1024, XB + (size_t)m * 1024, RS0 + m, lane);
            else if (m < MTOT) row_to_bf16_rs(p.in[I_XS] + (size_t)(m - MPR) * 1024, XB + (size_t)m * 1024, RS0 + m, lane);
            else row_to_bf16_rs(p.in[I_MEM] + (size_t)(m - MTOT) * 1024, MEMB + (size_t)(m - MTOT) * 1024, RSM + (m - MTOT), lane);
        }
    }
    grid.sync();

    if constexpr (PH(1)) {
        pg8::Gemm g{XB, W1T, MTOT, 2560, 1024}; pg8::StaticOrder S; S.init(MTOT, 2560, G, (int)blockIdx.x);
        pg8::EpiG1 E{RS0, p.in[I_GQ], p.in[I_GK], QB, KB, VB, CB, out + O_KP, out + O_KS, out + O_VP, out + O_VS};
        pg8::gemm_phase<pg8::EpiG1, pg8::StaticOrder, true, true>(lds, g, S, E);
    }
    if constexpr (PH(2)) {
        pg8::Gemm g{MEMB, WMKVT, 2048, 1024, 1024}; pg8::StaticOrder S; S.init(2048, 1024, G, (int)((blockIdx.x + 128) % G));
        pg8::EpiMem E{RSM, out + O_MK, out + O_MV};
        pg8::gemm_phase<pg8::EpiMem, pg8::StaticOrder, true, true>(lds, g, S, E);
    }
    grid.sync();

    if constexpr (PH(3)) for (int r = gw; r < 40 * 256; r += NGW) {
        f32x4 a, b;
        if (r < 2048) {
            float* mk = out + O_MK + (size_t)r * 512 + lane * 8; a = *(f32x4*)mk; b = *(f32x4*)(mk + 4);
            float ss = (a.x * a.x + a.y * a.y) + (a.z * a.z + a.w * a.w) + (b.x * b.x + b.y * b.y) + (b.z * b.z + b.w * b.w);
            ss += __shfl_xor(ss, 1); ss += __shfl_xor(ss, 2); ss += __shfl_xor(ss, 4); ss += __shfl_xor(ss, 8);
            const float rstd = 1.0f / sqrtf(ss * (1.0f / 128.0f) + EPS); const float* g = p.in[I_GMK] + (lane & 15) * 8;
            a = a * *(const f32x4*)g * rstd; b = b * *(const f32x4*)(g + 4) * rstd;
            *(f32x4*)mk = a; *(f32x4*)(mk + 4) = b;
        } else { const float* mk = p.in[I_CMK] + (size_t)(r - 2048) * 512 + lane * 8; a = *(const f32x4*)mk; b = *(const f32x4*)(mk + 4); }
        const float* gq = p.in[I_GMQ] + (lane & 15) * 8; a = a * *(const f32x4*)gq; b = b * *(const f32x4*)(gq + 4);
        v4u o; o.x = pk2(a.x, a.y); o.y = pk2(a.z, a.w); o.z = pk2(b.x, b.y); o.w = pk2(b.z, b.w);
        *(v4u*)(MKB + (size_t)r * 512 + lane * 8) = o;
    }
    if constexpr (PH(3)) for (int it = gw; it < 40 * 4 * 8; it += NGW) {
        const int kg = it & 7, head = (it >> 3) & 3, bb = it >> 5;
        const float* vsrc = (bb < 8 ? out + O_MV + (size_t)bb * 256 * 512 : p.in[I_CMV] + (size_t)(bb - 8) * 256 * 512) + (size_t)(32 * kg) * 512 + head * 128;
#pragma unroll 1
        for (int half = 0; half < 2; ++half) { const int e = lane + 64 * half; float v[32];
#pragma unroll
            for (int k = 0; k < 32; ++k) v[k] = vsrc[(size_t)k * 512 + e];
            bf16* dst = MVT + ((size_t)(bb * 4 + head) * 128 + e) * 256 + 32 * kg;
#pragma unroll
            for (int g = 0; g < 4; ++g) { v4u o; o.x = pk2(v[4 * g], v[4 * g + 1]); o.y = pk2(v[4 * g + 2], v[4 * g + 3]); o.z = pk2(v[16 + 4 * g], v[16 + 4 * g + 1]); o.w = pk2(v[16 + 4 * g + 2], v[16 + 4 * g + 3]); *(v4u*)(dst + 8 * g) = o; }
        }
    }
    if constexpr (PH(5)) for (int it = gw; it < (NBP + NBS) * 30; it += NGW) {
        const float* src; float* dst;
        if (it < NBP * 30) { const int b = it / 30, i = it % 30; src = CB + (size_t)(b * 4096 + 4066 + i) * 512; dst = out + O_CP + (size_t)it * 512; }
        else { const int k = it - NBP * 30, b = k / 30, i = k % 30; src = i < 14 ? p.in[I_CC] + (size_t)(b * 30 + 16 + i) * 512 : CB + (size_t)(MPR + b * 16 + i - 14) * 512; dst = out + O_CS + (size_t)k * 512; }
        *(f32x4*)(dst + lane * 8) = *(const f32x4*)(src + lane * 8); *(f32x4*)(dst + lane * 8 + 4) = *(const f32x4*)(src + lane * 8 + 4);
    }
    if constexpr (PH(6)) {
        const float* rel = p.in[I_REL];
        const int xq = (int)blockIdx.x & 7; unsigned* qctr = (unsigned*)ws + 64 * xq;
        volatile LAS unsigned* qword = (volatile LAS unsigned*)(lds + 131072);
        constexpr int NQ_S = 4 * SNP, NQ_P = 256, NQ_C = MTOT / 32 / 8, NQ = NQ_S + NQ_P + NQ_C;
        for (;;) {
            __syncthreads();
            if (tid == 0) qword[0] = __hip_atomic_fetch_add(qctr, 1u, __ATOMIC_RELAXED, __HIP_MEMORY_SCOPE_AGENT);
            __syncthreads();
            const int item = (int)qword[0];
            if (item >= NQ) break;
            if (item < NQ_S) { const int b = 4 * xq + item / SNP, part = item % SNP;
                if constexpr (PH(7)) sample_attn_task<2 * SNP>(b, wave >> 1, 2 * part + (wave & 1), lane, QB, p.in[I_CK], p.in[I_CV], out + O_KS, out + O_VS, rel, PART);
            } else if (item < NQ_S + NQ_P) { const int j = item - NQ_S, bhv = 16 * xq + (j >> 4), qb = 15 - (j & 15), b = bhv >> 4, hm = (bhv >> 1) & 7, vh = bhv & 1;
                if constexpr (PH(15)) attn_body::attn_unit<8>(b, hm * 64, hm * 64, (hm >> 1) * 128 + vh * 64, hm * 128 + vh * 64, qb, hm >> 1, rel,
                                        (const attn_body::bf16*)QB, (const attn_body::bf16*)KB, (const attn_body::bf16*)VB, (attn_body::bf16*)OAB, (char*)lds_raw);
            } else { const int ct = (item - NQ_S - NQ_P) * 8 + xq;
                if constexpr (PH(4)) conv_task(ct * 8 + wave, lane, CB, p.in[I_CC], p.in[I_WCONV], p.in[I_BCONV], p.in[I_LNG], p.in[I_LNB], A3); }
        }
    }
    grid.sync();
    if constexpr (PH(8)) {
        const float lam = compute_lam(p.in[I_LAM], lane);
        for (int r = gw; r < MTOT; r += NGW) {
            const int h = lane >> 4, e0 = (lane & 15) * 8; f32x4 a0, a1, b0, b1;
            if (r < MPR) { float fa[8], fb[8]; unpack8(*(const v4u*)(OAB + (size_t)r * 1024 + (2 * h) * 128 + e0), fa); unpack8(*(const v4u*)(OAB + (size_t)r * 1024 + (2 * h + 1) * 128 + e0), fb);
                a0 = (f32x4){fa[0], fa[1], fa[2], fa[3]}; a1 = (f32x4){fa[4], fa[5], fa[6], fa[7]}; b0 = (f32x4){fb[0], fb[1], fb[2], fb[3]}; b1 = (f32x4){fb[4], fb[5], fb[6], fb[7]}; }
            else { const int sb = (r - MPR) >> 4, q = (r - MPR) & 15; f32x4 acc[2][2];
#pragma unroll
                for (int m = 0; m < 2; ++m) { const float* pb = PART + ((size_t)((sb * 4 + h) * (2 * SNP) * 2 + m) * 16 + q) * PART_STRIDE; float M = -1e30f;
#pragma unroll
                    for (int sp = 0; sp < 2 * SNP; ++sp) M = fmaxf(M, pb[(size_t)sp * 2 * 16 * PART_STRIDE + 128]);
                    float L = 0.f; f32x4 s0 = (f32x4){0.f, 0.f, 0.f, 0.f}, s1 = s0;
#pragma unroll
                    for (int sp = 0; sp < 2 * SNP; ++sp) { const float* ps = pb + (size_t)sp * 2 * 16 * PART_STRIDE; const float f = exp2f(ps[128] - M); L += ps[129] * f; s0 += *(const f32x4*)(ps + e0) * f; s1 += *(const f32x4*)(ps + e0 + 4) * f; }
                    const float il = 1.0f / L; acc[m][0] = s0 * il; acc[m][1] = s1 * il; }
                a0 = acc[0][0]; a1 = acc[0][1]; b0 = acc[1][0]; b1 = acc[1][1]; }
            const f32x4 d0 = a0 - b0 * lam, d1 = a1 - b1 * lam;
            float ss = (d0.x * d0.x + d0.y * d0.y) + (d0.z * d0.z + d0.w * d0.w) + (d1.x * d1.x + d1.y * d1.y) + (d1.z * d1.z + d1.w * d1.w);
            ss += __shfl_xor(ss, 1); ss += __shfl_xor(ss, 2); ss += __shfl_xor(ss, 4); ss += __shfl_xor(ss, 8);
            const float sc = (1.0f - LAM_INIT) / sqrtf(ss * (1.0f / 128.0f) + EPS); const f32x4 g0 = *(const f32x4*)(p.in[I_GSUB] + e0), g1 = *(const f32x4*)(p.in[I_GSUB] + e0 + 4);
            const f32x4 y0 = d0 * g0 * sc, y1 = d1 * g1 * sc;
            v4u o; o.x = pk2(y0.x, y0.y); o.y = pk2(y0.z, y0.w); o.z = pk2(y1.x, y1.y); o.w = pk2(y1.z, y1.w);
            *(v4u*)(A3 + (size_t)r * 1024 + h * 128 + e0) = o;
        }
    }
    grid.sync();
    if constexpr (PH(9)) {
        pg8::Gemm g{A3, WOT, MTOT, 1024, 1024}; pg8::StaticOrder S; S.init(MTOT, 1024, G, (int)blockIdx.x);
        pg8::EpiRes E{p.in[I_XP], p.in[I_XS], X1, X1B, SSP1};
        pg8::gemm_phase<pg8::EpiRes, pg8::StaticOrder, true, true>(lds, g, S, E);
    }
    grid.sync();
    if constexpr (PH(10)) {
        pg8::Gemm g{X1B, WMQT, MTOT, 512, 1024}; pg8::StaticOrder S; S.init(MTOT, 512, G, (int)blockIdx.x);
        pg8::EpiScaleBf16<0> E{SSP1, QM, 512};
        pg8::gemm_phase<pg8::EpiScaleBf16<0>, pg8::StaticOrder, true, true>(lds, g, S, E);
    }
    grid.sync();
    if constexpr (PH(11)) for (int it = gw; it < (MTOT / 16) * 4; it += NGW) {
        const int grp = it >> 2, head = it & 3, c = lane & 15, g = lane >> 4, r = grp * 16 + c, bb = grp < 2048 ? grp >> 8 : 8 + (grp - 2048);
        pg8::bf16x8 qf[4]; float ss = 0.f;
#pragma unroll
        for (int s4 = 0; s4 < 4; ++s4) { const v4u w = *(const v4u*)(QM + (size_t)r * 512 + head * 128 + 32 * s4 + 8 * g); qf[s4] = __builtin_bit_cast(pg8::bf16x8, w); float f[8]; unpack8(w, f);
#pragma unroll
            for (int e = 0; e < 8; ++e) ss += f[e] * f[e]; }
        ss += __shfl_xor(ss, 16); ss += __shfl_xor(ss, 32);
        const float qs = (1.0f / sqrtf(ss * (1.0f / 128.0f) + EPS)) * (0.08838834764831845f * LOG2E);
        const bf16* kb = MKB + (size_t)(bb * 256 + c) * 512 + head * 128 + 8 * g;
        f32x4 st[16]; float mx = -1e30f;
#pragma unroll
        for (int kt = 0; kt < 16; ++kt) { f32x4 acc = (f32x4){0.f, 0.f, 0.f, 0.f};
#pragma unroll
            for (int s4 = 0; s4 < 4; ++s4) { const pg8::bf16x8 kf = *(const pg8::bf16x8*)(kb + (size_t)(16 * kt) * 512 + 32 * s4); acc = __builtin_amdgcn_mfma_f32_16x16x32_bf16(kf, qf[s4], acc, 0, 0, 0); }
            st[kt] = acc * qs; mx = fmaxf(mx, fmaxf(fmaxf(st[kt].x, st[kt].y), fmaxf(st[kt].z, st[kt].w))); }
        mx = fmaxf(mx, __shfl_xor(mx, 16)); mx = fmaxf(mx, __shfl_xor(mx, 32));
        float l = 0.f; pg8::bf16x8 pb[8];
#pragma unroll
        for (int kp = 0; kp < 8; ++kp) { f32x4 p0 = st[2 * kp], p1 = st[2 * kp + 1];
#pragma unroll
            for (int e = 0; e < 4; ++e) { p0[e] = exp2f(p0[e] - mx); p1[e] = exp2f(p1[e] - mx); l += p0[e] + p1[e]; }
            v4u w; w.x = pk2(p0.x, p0.y); w.y = pk2(p0.z, p0.w); w.z = pk2(p1.x, p1.y); w.w = pk2(p1.z, p1.w); pb[kp] = __builtin_bit_cast(pg8::bf16x8, w); }
        l += __shfl_xor(l, 16); l += __shfl_xor(l, 32); const float il = 1.0f / l;
        const bf16* vb = MVT + ((size_t)(bb * 4 + head) * 128 + c) * 256 + 8 * g; bf16* od = OM + (size_t)r * 512 + head * 128 + 4 * g;
#pragma unroll
        for (int et = 0; et < 8; ++et) { f32x4 acc = (f32x4){0.f, 0.f, 0.f, 0.f};
#pragma unroll
            for (int kp = 0; kp < 8; ++kp) { const pg8::bf16x8 vf = *(const pg8::bf16x8*)(vb + (size_t)(16 * et) * 256 + 32 * kp); acc = __builtin_amdgcn_mfma_f32_16x16x32_bf16(vf, pb[kp], acc, 0, 0, 0); }
            v2u w; w.x = pk2(acc.x * il, acc.y * il); w.y = pk2(acc.z * il, acc.w * il); *(v2u*)(od + 16 * et) = w; }
    }
    grid.sync();
    if constexpr (PH(12)) {
        pg8::Gemm g{OM, WMOT, MTOT, 1024, 512}; pg8::StaticOrder S; S.init(MTOT, 1024, G, (int)blockIdx.x);
        pg8::EpiRes E{X1, X1 + (size_t)MPR * 1024, X1, X2B, SSP2};
        pg8::gemm_phase<pg8::EpiRes, pg8::StaticOrder, true, true>(lds, g, S, E);
    }
    grid.sync();
    if constexpr (PH(13)) {
        pg8::Gemm g{X2B, WF1T, MTOT, 4096, 1024}; pg8::StaticOrder S; S.init(MTOT, 4096, G, (int)blockIdx.x);
        pg8::EpiScaleBf16<1> E{SSP2, UB, 4096};
        pg8::gemm_phase<pg8::EpiScaleBf16<1>, pg8::StaticOrder, true, true>(lds, g, S, E);
    }
    grid.sync();
    if constexpr (PH(14)) {
        pg8::Gemm g{UB, WF2T, MTOT, 1024, 4096}; pg8::StaticOrder S; S.init(MTOT, 1024, G, (int)blockIdx.x);
        pg8::EpiOut E{X1, out + O_YP, out + O_YS};
        pg8::gemm_phase<pg8::EpiOut, pg8::StaticOrder, true, true>(lds, g, S, E);
    }
}

extern "C" void kernel_launch(void* const* d_in, const int* in_sizes, int n_in, void* d_out, int out_size, void* d_ws, size_t ws_size, hipStream_t stream) {
    static int grid = 0;
    if (grid == 0) {
        if (n_in != 31 || out_size != (int)O_END || ws_size < WS_END) { fprintf(stderr, "kernel_launch: unexpected shapes (n_in %d, out %d, ws %zu)\n", n_in, out_size, ws_size); grid = -1; return; }
        int dev = 0, cus = 0, per_cu = 0;
        hipGetDevice(&dev); hipDeviceGetAttribute(&cus, hipDeviceAttributeMultiprocessorCount, dev);
        if (hipFuncSetAttribute((const void*)fwd_kernel, hipFuncAttributeMaxDynamicSharedMemorySize, LDS_BYTES) != hipSuccess) { fprintf(stderr, "kernel_launch: hipFuncSetAttribute failed\n"); grid = -1; return; }
        if (hipOccupancyMaxActiveBlocksPerMultiprocessor(&per_cu, (const void*)fwd_kernel, NTHREADS, LDS_BYTES) != hipSuccess || per_cu < 1) { fprintf(stderr, "kernel_launch: occupancy query failed (%d)\n", per_cu); (void)hipGetLastError(); per_cu = 1; }
        if (per_cu > 1) per_cu = 1;
        grid = cus * per_cu;
        if (grid % 8 != 0 || grid < 8) { fprintf(stderr, "kernel_launch: unexpected CU count %d\n", cus); }
    }
    if (grid < 0) return;
    if (hipMemsetAsync(d_ws, 0, 4096, stream) != hipSuccess) { fprintf(stderr, "kernel_launch: hipMemsetAsync failed\n"); return; }
    Params p{};
    for (int i = 0; i < 31; ++i) p.in[i] = (const float*)d_in[i];
    p.out = (float*)d_out; p.ws = (unsigned char*)d_ws;
    void* args[] = {&p};
    hipError_t e = hipLaunchCooperativeKernel((const void*)fwd_kernel, dim3(grid), dim3(NTHREADS), args, LDS_BYTES, stream);
    if (e != hipSuccess) fprintf(stderr, "kernel_launch: cooperative launch failed: %s (grid %d)\n", hipGetErrorString(e), grid);
}
```

```cpp
#include <hip/hip_runtime.h>
#include <hip/hip_cooperative_groups.h>
#include <cstdio>
#include <cstdint>
namespace pg8 {
#define PG8_LAS __attribute__((address_space(3)))
typedef unsigned short bf16_t;
typedef short bf16x8 __attribute__((ext_vector_type(8)));
typedef float f32x4 __attribute__((ext_vector_type(4)));
typedef unsigned u32x4 __attribute__((ext_vector_type(4)));
constexpr int BM = 256, BK = 64, HALF = 128, HTB = HALF * BK * 2  , STAGE_BYTES = 8 * HTB, NXCD = 8, WGM = 8;

__host__ __device__ __forceinline__ int lds_byte(int r, int c) { const int st = (r >> 4) * 2 + (c >> 5), rr = r & 15, cc = c & 31, ob = rr * 64 + cc * 2; return st * 1024 + (ob ^ (((ob >> 9) & 1) << 5)); }
__host__ __device__ __forceinline__ void stage_rc(int b, int& R, int& C) { const int st = b / 1024, sb = b % 1024, swz = sb ^ (((sb >> 9) & 1) << 5); R = (st >> 1) * 16 + swz / 64; C = (st & 1) * 32 + (swz % 64) / 2; }
__host__ __device__ __forceinline__ int perm32(int rho) { const int n = rho >> 4, i = rho & 15; return 8 * (i >> 2) + 4 * n + (i & 3); }

struct Unit { int pm, pn; };
struct Gemm { const bf16_t* A; const bf16_t* Bt; int M, N, K, ld; };

struct StaticOrder {
    int nM, nN, nwg, G, c;
    __host__ __device__ void init(int M, int N, int G_, int c_) { nM = M / BM; nN = N / BM; nwg = nM * nN; G = G_; c = c_; }
    __host__ __device__ bool next(int i, Unit& u) const {
        const long L = (long)i * G + c; if (L >= nwg) return false;
        int wgid = (int)L; { const int q = nwg / NXCD, r = nwg % NXCD, xcd = wgid % NXCD, off = wgid / NXCD; wgid = (xcd < r ? xcd * (q + 1) : r * (q + 1) + (xcd - r) * q) + off; }
        const int nig = WGM * nN, gid = wgid / nig, fm = gid * WGM, gsz = (nM - fm) < WGM ? (nM - fm) : WGM;
        u.pm = fm + ((wgid % nig) % gsz); u.pn = (wgid % nig) / gsz; return true;
    }
    __device__ __forceinline__ void a_ready(const Unit&) const {}
    __device__ __forceinline__ void done(const Unit&) const {}
};

__device__ __forceinline__ unsigned cvt_pk_bf16(float lo, float hi) { unsigned r; asm volatile("v_cvt_pk_bf16_f32 %0, %1, %2" : "=v"(r) : "v"(lo), "v"(hi)); return r; }
typedef float f32x2 __attribute__((ext_vector_type(2)));

constexpr int MP = 32768;
constexpr float EPSN = 1e-6f;
constexpr float QC2 = 0.125f * 1.4426950408889634f;
__device__ __forceinline__ void st_bf16x8(bf16_t* p, const f32x4 a, const f32x4 b) { u32x4 w; w.x = cvt_pk_bf16(a[0], a[1]); w.y = cvt_pk_bf16(a[2], a[3]); w.z = cvt_pk_bf16(b[0], b[1]); w.w = cvt_pk_bf16(b[2], b[3]); *(u32x4*)p = w; }
__device__ __forceinline__ float dot4(const f32x4 a) { return (a[0] * a[0] + a[1] * a[1]) + (a[2] * a[2] + a[3] * a[3]); }

struct EpiG1 {
    static constexpr bool PERM = true, AFTER_DRAIN = false;
    const float* rs; const float* gq; const float* gk;
    bf16_t* Q; bf16_t* KB; bf16_t* VB; bf16_t* C;
    float* kp; float* ks; float* vp; float* vs; float* cpo; float* cso;
    __device__ __forceinline__ void operator()(const f32x4 (&acc)[2][2][4][2], const Unit& u, int wr, int wc, int fr, int fq) const {
        const int pn = u.pn;
#pragma unroll
        for (int ai = 0; ai < 2; ++ai)
#pragma unroll
            for (int m = 0; m < 4; ++m) {
                const int r = u.pm * BM + ai * HALF + wr * 64 + m * 16 + fr;
                const float rsv = rs[r];
                if (pn < 4) {
                    f32x4 v[2][2]; float ss = 0.f;
#pragma unroll
                    for (int bj = 0; bj < 2; ++bj)
#pragma unroll
                        for (int n = 0; n < 2; ++n) { v[bj][n] = acc[ai][bj][m][n] * rsv; ss += dot4(v[bj][n]); }
                    ss += __shfl_xor(ss, 16); ss += __shfl_xor(ss, 32);
                    const float rstd = 1.0f / sqrtf(ss * (1.0f / 64.0f) + EPSN);
                    const float* g = pn < 2 ? gq : gk; const float sc = pn < 2 ? rstd * QC2 : rstd;
                    const int grp = 4 * (pn & 1) + wc;
#pragma unroll
                    for (int bj = 0; bj < 2; ++bj) {
                        const int d0 = 32 * bj + 8 * fq; const f32x4 g0 = *(const f32x4*)(g + d0), g1 = *(const f32x4*)(g + d0 + 4);
                        const f32x4 o0 = v[bj][0] * g0 * sc, o1 = v[bj][1] * g1 * sc; const int col = 64 * grp + d0;
                        if (pn < 2) st_bf16x8(Q + (size_t)r * 512 + col, o0, o1);
                        else { float* ko = (r < MP ? kp + (size_t)r * 512 : ks + (size_t)(r - MP) * 512) + col; *(f32x4*)ko = o0; *(f32x4*)(ko + 4) = o1; st_bf16x8(KB + (size_t)r * 512 + col, o0, o1); }
                    }
                } else if (pn < 6) {
#pragma unroll
                    for (int bj = 0; bj < 2; ++bj) {
                        const int col = 256 * (pn - 4) + 128 * bj + 32 * wc + 8 * fq; const f32x4 o0 = acc[ai][bj][m][0] * rsv, o1 = acc[ai][bj][m][1] * rsv;
                        float* vo = (r < MP ? vp + (size_t)r * 512 : vs + (size_t)(r - MP) * 512) + col; *(f32x4*)vo = o0; *(f32x4*)(vo + 4) = o1; st_bf16x8(VB + (size_t)r * 512 + col, o0, o1);
                    }
                } else {
                    const int ch = 128 * (pn - 6) + 32 * wc + 8 * fq; f32x4 c[2];
#pragma unroll
                    for (int n = 0; n < 2; ++n) { const f32x4 a = acc[ai][0][m][n] * rsv, gt = acc[ai][1][m][n] * rsv;
#pragma unroll
                        for (int e = 0; e < 4; ++e) c[n][e] = a[e] / (1.0f + __expf(-gt[e])); }
                    st_bf16x8(C + (size_t)r * 512 + ch, c[0], c[1]);
                    float* cs = nullptr;
                    if (r >= MP) cs = cso + ((size_t)((r - MP) >> 4) * 30 + 14 + ((r - MP) & 15)) * 512; else if ((r & 4095) >= 4066) cs = cpo + ((size_t)(r >> 12) * 30 + (r & 4095) - 4066) * 512;
                    if (cs) { *(f32x4*)(cs + ch) = c[0]; *(f32x4*)(cs + ch + 4) = c[1]; }
                }
            }
    }
};
struct EpiMem {
    static constexpr bool PERM = true, AFTER_DRAIN = false;
    const float* rs; float* mk; float* mv;
    __device__ __forceinline__ void operator()(const f32x4 (&acc)[2][2][4][2], const Unit& u, int wr, int wc, int fr, int fq) const {
        float* base = u.pn < 2 ? mk : mv; const int cb = 256 * (u.pn & 1);
#pragma unroll
        for (int ai = 0; ai < 2; ++ai)
#pragma unroll
            for (int m = 0; m < 4; ++m) { const int r = u.pm * BM + ai * HALF + wr * 64 + m * 16 + fr; const float rsv = rs[r];
#pragma unroll
                for (int bj = 0; bj < 2; ++bj) { float* o = base + (size_t)r * 512 + cb + 128 * bj + 32 * wc + 8 * fq; *(f32x4*)o = acc[ai][bj][m][0] * rsv; *(f32x4*)(o + 4) = acc[ai][bj][m][1] * rsv; } }
    }
};
__device__ __forceinline__ void bf8_to_f32(const u32x4 w, f32x4& lo, f32x4& hi) {
    lo = (f32x4){__builtin_bit_cast(float, w.x << 16), __builtin_bit_cast(float, w.x & 0xffff0000u), __builtin_bit_cast(float, w.y << 16), __builtin_bit_cast(float, w.y & 0xffff0000u)};
    hi = (f32x4){__builtin_bit_cast(float, w.z << 16), __builtin_bit_cast(float, w.z & 0xffff0000u), __builtin_bit_cast(float, w.w << 16), __builtin_bit_cast(float, w.w & 0xffff0000u)}; }
struct EpiRes {
    static constexpr bool PERM = true, AFTER_DRAIN = false;
    const bf16_t* resb; bf16_t* xb; float* ssp;
    __device__ __forceinline__ void operator()(const f32x4 (&acc)[2][2][4][2], const Unit& u, int wr, int wc, int fr, int fq) const {
#pragma unroll
        for (int ai = 0; ai < 2; ++ai) {
            u32x4 rb[4][2];
#pragma unroll
            for (int m = 0; m < 4; ++m)
#pragma unroll
                for (int bj = 0; bj < 2; ++bj) rb[m][bj] = *(const u32x4*)(resb + (size_t)(u.pm * BM + ai * HALF + wr * 64 + m * 16 + fr) * 1024 + 256 * u.pn + 128 * bj + 32 * wc + 8 * fq);
#pragma unroll
            for (int m = 0; m < 4; ++m) { const int r = u.pm * BM + ai * HALF + wr * 64 + m * 16 + fr; float ss = 0.f;
#pragma unroll
                for (int bj = 0; bj < 2; ++bj) { const int col = 256 * u.pn + 128 * bj + 32 * wc + 8 * fq; f32x4 x0, x1; bf8_to_f32(rb[m][bj], x0, x1);
                    x0 += acc[ai][bj][m][0]; x1 += acc[ai][bj][m][1];
                    st_bf16x8(xb + (size_t)r * 1024 + col, x0, x1); ss += dot4(x0) + dot4(x1); }
                ss += __shfl_xor(ss, 16); ss += __shfl_xor(ss, 32);
                if (fq == 0) ssp[(size_t)r * 16 + 4 * u.pn + wc] = ss; }
            asm volatile("" ::: "memory"); }
    }
};
__device__ __forceinline__ float row_rs(const float* ssp, int r) { const f32x4 a = *(const f32x4*)(ssp + (size_t)r * 16), b = *(const f32x4*)(ssp + (size_t)r * 16 + 4), c = *(const f32x4*)(ssp + (size_t)r * 16 + 8), d = *(const f32x4*)(ssp + (size_t)r * 16 + 12);
    const float s = ((a[0] + a[1]) + (a[2] + a[3])) + ((b[0] + b[1]) + (b[2] + b[3])) + ((c[0] + c[1]) + (c[2] + c[3])) + ((d[0] + d[1]) + (d[2] + d[3])); return 1.0f / sqrtf(s * (1.0f / 1024.0f) + EPSN); }
__device__ __forceinline__ float row_rs4(const float* ssp, int r, int fq) { const f32x4 a = *(const f32x4*)(ssp + (size_t)r * 16 + 4 * fq);
    float s = (a[0] + a[1]) + (a[2] + a[3]); s += __shfl_xor(s, 16); s += __shfl_xor(s, 32); return 1.0f / sqrtf(s * (1.0f / 1024.0f) + EPSN); }
template <int ACT> struct EpiScaleBf16 {
    static constexpr bool PERM = true, AFTER_DRAIN = false;
    const float* ssp; bf16_t* O; int ldc;
    __device__ __forceinline__ void operator()(const f32x4 (&acc)[2][2][4][2], const Unit& u, int wr, int wc, int fr, int fq) const {
#pragma unroll
        for (int ai = 0; ai < 2; ++ai)
#pragma unroll
            for (int m = 0; m < 4; ++m) { const int r = u.pm * BM + ai * HALF + wr * 64 + m * 16 + fr; const float rsv = row_rs4(ssp, r, fq);
#pragma unroll
                for (int bj = 0; bj < 2; ++bj) { const int col = 256 * u.pn + 128 * bj + 32 * wc + 8 * fq; f32x4 o0 = acc[ai][bj][m][0] * rsv, o1 = acc[ai][bj][m][1] * rsv;
                    if (ACT == 1) {
#pragma unroll
                        for (int e = 0; e < 4; ++e) { const float a = fmaxf(o0[e], 0.f), b = fmaxf(o1[e], 0.f); o0[e] = a * a; o1[e] = b * b; } }
                    st_bf16x8(O + (size_t)r * ldc + col, o0, o1); } }
    }
};
struct EpiOut {
    static constexpr bool PERM = true, AFTER_DRAIN = false;
    const bf16_t* resb; float* yp;
    __device__ __forceinline__ void operator()(const f32x4 (&acc)[2][2][4][2], const Unit& u, int wr, int wc, int fr, int fq) const {
#pragma unroll
        for (int ai = 0; ai < 2; ++ai) {
            u32x4 rb[4][2];
#pragma unroll
            for (int m = 0; m < 4; ++m)
#pragma unroll
                for (int bj = 0; bj < 2; ++bj) rb[m][bj] = *(const u32x4*)(resb + (size_t)(u.pm * BM + ai * HALF + wr * 64 + m * 16 + fr) * 1024 + 256 * u.pn + 128 * bj + 32 * wc + 8 * fq);
#pragma unroll
            for (int m = 0; m < 4; ++m) { const int r = u.pm * BM + ai * HALF + wr * 64 + m * 16 + fr; float* yo = yp + (size_t)r * 1024;
#pragma unroll
                for (int bj = 0; bj < 2; ++bj) { const int col = 256 * u.pn + 128 * bj + 32 * wc + 8 * fq; f32x4 x0, x1; bf8_to_f32(rb[m][bj], x0, x1);
                    *(f32x4*)(yo + col) = x0 + acc[ai][bj][m][0]; *(f32x4*)(yo + col + 4) = x1 + acc[ai][bj][m][1]; } }
            asm volatile("" ::: "memory"); }
    }
};
struct EpiPart {
    static constexpr bool PERM = true, AFTER_DRAIN = false;
    float* part;
    __device__ __forceinline__ void operator()(const f32x4 (&acc)[2][2][4][2], const Unit& u, int wr, int wc, int fr, int fq) const {
#pragma unroll
        for (int ai = 0; ai < 2; ++ai)
#pragma unroll
            for (int m = 0; m < 4; ++m) { const int r = u.pm * BM + ai * HALF + wr * 64 + m * 16 + fr;
#pragma unroll
                for (int bj = 0; bj < 2; ++bj) { float* yo = part + (size_t)r * 1024 + 256 * u.pn + 128 * bj + 32 * wc + 8 * fq; *(f32x4*)yo = acc[ai][bj][m][0]; *(f32x4*)(yo + 4) = acc[ai][bj][m][1]; } }
    }
};
struct OneUnit { int pm, pn;
    __device__ __forceinline__ bool next(int i, Unit& u) const { if (i) return false; u.pm = pm; u.pn = pn; return true; }
    __device__ __forceinline__ void a_ready(const Unit&) const {}
    __device__ __forceinline__ void done(const Unit&) const {}
};
template <class Epi, class Sched, bool ALIGN_EPI = false, bool SP2 = false>
__device__ __forceinline__ void gemm_phase(PG8_LAS unsigned char* lds, const Gemm g, const Sched& S, const Epi& E) {
    int tid = threadIdx.x; asm volatile("" : "+v"(tid));
    const int wid = __builtin_amdgcn_readfirstlane(tid >> 6), lane = tid & 63, wr = wid >> 2, wc = wid & 3, fr = lane & 15, fq = lane >> 4;
    const int K = g.ld, nt = g.K / BK;
    unsigned voffA[2], voffB[2];
#pragma unroll
    for (int i = 0; i < 2; ++i) { int R, C; stage_rc(tid * 16 + i * 8192, R, C); const int Rb = Epi::PERM ? ((R & ~31) + perm32(R & 31)) : R;
        voffA[i] = (unsigned)(R * K + C) * 2u; voffB[i] = (unsigned)(Rb * K + C) * 2u; }
    const size_t kstep = (size_t)(BK * 2);
    const size_t hstep = (size_t)HALF * K * 2;
    const size_t tstep = 2 * hstep;
    const unsigned ldsw = (unsigned)wid * 1024u;
    const int aoff = lds_byte(wr * 64 + fr, fq * 8), boff = lds_byte(wc * 32 + fr, fq * 8);
#define PG8_SA(b, h) (((b) * 2 + (h)) * HTB)
#define PG8_SB(b, h) ((4 + (b) * 2 + (h)) * HTB)
#define PG8_STAGE(bufoff, gbase, voff) do { _Pragma("unroll") for (int _i = 0; _i < 2; ++_i) \
        __builtin_amdgcn_global_load_lds((const unsigned*)((const char*)(gbase) + (voff)[_i]), (PG8_LAS unsigned*)(lds + (bufoff) + ldsw + _i * 8192), 16, 0, 0); } while (0)
#define PG8_LDA(dst, b, h) do { _Pragma("unroll") for (int m = 0; m < 4; ++m) _Pragma("unroll") for (int k = 0; k < 2; ++k) dst[m][k] = *(const PG8_LAS bf16x8*)(lds + PG8_SA(b, h) + aoff + m * 2048 + k * 1024); } while (0)
#define PG8_LDB(dst, b, h) do { _Pragma("unroll") for (int n = 0; n < 2; ++n) _Pragma("unroll") for (int k = 0; k < 2; ++k) dst[n][k] = *(const PG8_LAS bf16x8*)(lds + PG8_SB(b, h) + boff + n * 2048 + k * 1024); } while (0)
#define PG8_MMA(ai, bj, At, Bt) do { __builtin_amdgcn_s_setprio(1); _Pragma("unroll") for (int m = 0; m < 4; ++m) _Pragma("unroll") for (int n = 0; n < 2; ++n) _Pragma("unroll") for (int k = 0; k < 2; ++k) \
        acc[ai][bj][m][n] = __builtin_amdgcn_mfma_f32_16x16x32_bf16(Bt[n][k], At[m][k], acc[ai][bj][m][n], 0, 0, 0); __builtin_amdgcn_s_setprio(0); } while (0)
#define PG8_WAIT_V(n) asm volatile("s_waitcnt vmcnt(" #n ")" ::: "memory")
#define PG8_WAIT_L(n) asm volatile("s_waitcnt lgkmcnt(" #n ")" ::: "memory")
#define PG8_BAR __builtin_amdgcn_s_barrier()
#define PG8_SCHED __builtin_amdgcn_sched_barrier(0)
    Unit cur, nxt; int ui = 0;
    if (!S.next(0, cur)) return;
    f32x4 acc[2][2][4][2];
#pragma unroll
    for (int a = 0; a < 2; ++a)
#pragma unroll
        for (int b = 0; b < 2; ++b)
#pragma unroll
            for (int m = 0; m < 4; ++m)
#pragma unroll
                for (int n = 0; n < 2; ++n) acc[a][b][m][n] = (f32x4){0.f, 0.f, 0.f, 0.f};
    bf16x8 At[4][2], B0[2][2], B1[2][2];
    const char* cA = (const char*)g.A + (size_t)cur.pm * tstep; const char* cB = (const char*)g.Bt + (size_t)cur.pn * tstep;
    S.a_ready(cur);
    if constexpr (SP2) {
        PG8_STAGE(PG8_SB(0, 0), cB, voffB); PG8_STAGE(PG8_SB(0, 1), cB + hstep, voffB); PG8_STAGE(PG8_SA(0, 0), cA, voffA); PG8_STAGE(PG8_SA(0, 1), cA + hstep, voffA);
        if (wr == 1) PG8_BAR;
        PG8_WAIT_V(2); PG8_BAR;
        PG8_STAGE(PG8_SB(1, 0), cB + kstep, voffB); PG8_STAGE(PG8_SA(1, 0), cA + kstep, voffA); PG8_STAGE(PG8_SB(1, 1), cB + hstep + kstep, voffB);
        PG8_WAIT_V(6); PG8_BAR;
    } else {
        PG8_STAGE(PG8_SB(0, 0), cB, voffB); PG8_STAGE(PG8_SA(0, 0), cA, voffA); PG8_STAGE(PG8_SB(0, 1), cB + hstep, voffB); PG8_STAGE(PG8_SA(0, 1), cA + hstep, voffA);
        if (wr == 1) PG8_BAR;
        PG8_WAIT_V(4); PG8_BAR;
        PG8_STAGE(PG8_SB(1, 0), cB + kstep, voffB); PG8_STAGE(PG8_SA(1, 0), cA + kstep, voffA); PG8_STAGE(PG8_SB(1, 1), cB + hstep + kstep, voffB);
        PG8_WAIT_V(6); PG8_BAR;
    }
    for (;;) {
        const bool has_next = S.next(ui + 1, nxt);
        const char* nA = has_next ? (const char*)g.A + (size_t)nxt.pm * tstep : cA; const char* nB = has_next ? (const char*)g.Bt + (size_t)nxt.pn * tstep : cB;
        for (int t = 0; t < nt; t += 2) {
            const bool last = (t == nt - 2);
            const char* a1 = cA + (size_t)(t + 1) * kstep;
            const char* a2 = last ? nA : cA + (size_t)(t + 2) * kstep; const char* b2 = last ? nB : cB + (size_t)(t + 2) * kstep;
            const char* a3 = a2 + kstep; const char* b3 = b2 + kstep;
            if (last && has_next) S.a_ready(nxt);
            if constexpr (SP2) {
            PG8_LDB(B0, 0, 0); PG8_LDB(B1, 0, 1); PG8_SCHED; PG8_LDA(At, 0, 0); PG8_STAGE(PG8_SA(1, 1), a1 + hstep, voffA);
            PG8_WAIT_V(8); PG8_WAIT_L(0); PG8_BAR; PG8_MMA(0, 0, At, B0); PG8_MMA(0, 1, At, B1); PG8_BAR; PG8_SCHED;
            PG8_LDA(At, 0, 1); PG8_STAGE(PG8_SB(0, 0), b2, voffB); PG8_STAGE(PG8_SB(0, 1), b2 + hstep, voffB); PG8_STAGE(PG8_SA(0, 0), a2, voffA);
            PG8_WAIT_V(8); PG8_WAIT_L(0); PG8_BAR; PG8_MMA(1, 0, At, B0); PG8_MMA(1, 1, At, B1); PG8_BAR; PG8_SCHED;
            PG8_LDB(B0, 1, 0); PG8_LDB(B1, 1, 1); PG8_SCHED; PG8_LDA(At, 1, 0); PG8_STAGE(PG8_SA(0, 1), a2 + hstep, voffA);
            PG8_WAIT_V(8); PG8_WAIT_L(0); PG8_BAR; PG8_MMA(0, 0, At, B0); PG8_MMA(0, 1, At, B1); PG8_BAR; PG8_SCHED;
            PG8_LDA(At, 1, 1); PG8_STAGE(PG8_SB(1, 0), b3, voffB); PG8_STAGE(PG8_SB(1, 1), b3 + hstep, voffB); PG8_STAGE(PG8_SA(1, 0), a3, voffA);
            PG8_WAIT_V(8); PG8_WAIT_L(0); PG8_BAR; PG8_MMA(1, 0, At, B0); PG8_MMA(1, 1, At, B1); PG8_BAR; PG8_SCHED;
            } else {
            PG8_LDB(B0, 0, 0); PG8_SCHED; PG8_LDA(At, 0, 0); PG8_STAGE(PG8_SA(1, 1), a1 + hstep, voffA);
            PG8_WAIT_L(8); PG8_BAR; PG8_WAIT_L(0); PG8_MMA(0, 0, At, B0); PG8_BAR; PG8_SCHED;
            PG8_LDB(B1, 0, 1); PG8_STAGE(PG8_SB(0, 0), b2, voffB);
            PG8_BAR; PG8_WAIT_L(0); PG8_MMA(0, 1, At, B1); PG8_BAR;
            PG8_LDA(At, 0, 1); PG8_STAGE(PG8_SA(0, 0), a2, voffA);
            PG8_BAR; PG8_WAIT_L(0); PG8_MMA(1, 0, At, B0); PG8_BAR; PG8_SCHED;
            PG8_STAGE(PG8_SB(0, 1), b2 + hstep, voffB);
            PG8_WAIT_V(6); PG8_BAR; PG8_MMA(1, 1, At, B1); PG8_BAR;
            PG8_LDB(B0, 1, 0); PG8_SCHED; PG8_LDA(At, 1, 0); PG8_STAGE(PG8_SA(0, 1), a2 + hstep, voffA);
            PG8_WAIT_L(8); PG8_BAR; PG8_WAIT_L(0); PG8_MMA(0, 0, At, B0); PG8_BAR; PG8_SCHED;
            PG8_LDB(B1, 1, 1); PG8_STAGE(PG8_SB(1, 0), b3, voffB);
            PG8_BAR; PG8_WAIT_L(0); PG8_MMA(0, 1, At, B1); PG8_BAR;
            PG8_LDA(At, 1, 1); PG8_STAGE(PG8_SA(1, 0), a3, voffA);
            PG8_BAR; PG8_WAIT_L(0); PG8_MMA(1, 0, At, B0); PG8_BAR; PG8_SCHED;
            PG8_STAGE(PG8_SB(1, 1), b3 + hstep, voffB);
            PG8_WAIT_V(6); PG8_BAR; PG8_MMA(1, 1, At, B1); PG8_BAR;
            }
        }
        if constexpr (ALIGN_EPI) { if (wr == 0) PG8_BAR; }
        if constexpr (!Epi::AFTER_DRAIN) { E(acc, cur, wr, wc, fr, fq); S.done(cur); }
        if (!has_next) break;
#pragma unroll
        for (int a = 0; a < 2; ++a)
#pragma unroll
            for (int b = 0; b < 2; ++b)
#pragma unroll
                for (int m = 0; m < 4; ++m)
#pragma unroll
                    for (int n = 0; n < 2; ++n) acc[a][b][m][n] = (f32x4){0.f, 0.f, 0.f, 0.f};
        cur = nxt; cA = nA; cB = nB; ++ui;
        if constexpr (ALIGN_EPI) { if (wr == 1) PG8_BAR; }
    }
    PG8_WAIT_V(0);
    if constexpr (!ALIGN_EPI) { if (wr == 0) PG8_BAR; }
    PG8_BAR;
    if constexpr (Epi::AFTER_DRAIN) { E.fused(acc, cur, wr, wc, fr, fq, lds, wid, lane); S.done(cur); }
#undef PG8_SA
#undef PG8_SB
#undef PG8_STAGE
#undef PG8_LDA
#undef PG8_LDB
#undef PG8_MMA
#undef PG8_WAIT_V
#undef PG8_WAIT_L
#undef PG8_BAR
#undef PG8_SCHED
}
}
#include <hip/hip_bf16.h>
#include <cmath>
namespace attn_body {
using bf16=__hip_bfloat16;
using bf16x8=__attribute__((ext_vector_type(8)))short;
using s16x4=__attribute__((ext_vector_type(4)))short;
using f32x16=__attribute__((ext_vector_type(16)))float;
using u32x4=__attribute__((ext_vector_type(4)))unsigned;
constexpr int SEQ=4096,D=64,PQ=512,PK=512,PV=512,PO=1024;
constexpr int NW=8,QBLK=32,QB=QBLK*NW,KVBLK=64,NQB=SEQ/QB;
constexpr int ATTN_UNIT_ROWS=QB;
__device__ __forceinline__ int crow(int r,int hi){return (r&3)+8*(r>>2)+4*hi;}
#define SBAR() __builtin_amdgcn_sched_barrier(0)
typedef __attribute__((address_space(3))) const float* lds_fptr;
__device__ __forceinline__ void bmask(f32x16&p0,f32x16&p1,int dist,lds_fptr tb){
  if(dist<0){
    #pragma unroll
    for(int r=0;r<16;++r){p0[r]=-INFINITY;p1[r]=-INFINITY;}
  } else if(dist<=2){
    #pragma unroll
    for(int r=0;r<16;++r){const int o=(r&3)+8*(r>>2); p0[r]+=tb[o]; p1[r]+=tb[o+32];}
  }
}

__device__ __forceinline__ void binit(f32x16&c0,f32x16&c1,int dist,lds_fptr tb){
  if(dist<0){
    #pragma unroll
    for(int r=0;r<16;++r){c0[r]=-INFINITY;c1[r]=-INFINITY;}
  } else if(dist<=2){
    #pragma unroll
    for(int r=0;r<16;++r){const int o=(r&3)+8*(r>>2); c0[r]=tb[o]; c1[r]=tb[o+32];}
  } else {
    #pragma unroll
    for(int r=0;r<16;++r){c0[r]=0.f;c1[r]=0.f;}
  }
}
__device__ __forceinline__ void binit1(f32x16&c,int dist,lds_fptr tb){
  if(dist<0){
    #pragma unroll
    for(int r=0;r<16;++r)c[r]=-INFINITY;
  } else if(dist<=2){
    #pragma unroll
    for(int r=0;r<16;++r)c[r]=tb[(r&3)+8*(r>>2)];
  } else {
    #pragma unroll
    for(int r=0;r<16;++r)c[r]=0.f;
  }
}
__device__ __forceinline__ void bpost(f32x16&c0,f32x16&c1,float mhat){
  #pragma unroll
  for(int r=0;r<16;++r){c0[r]-=mhat;c1[r]-=mhat;}
}
constexpr int NSLOT=3, SLOTB=8192;
constexpr int LDS_K=0, LDS_V=NSLOT*SLOTB, LDS_WS=2*NSLOT*SLOTB, LDS_OST=LDS_WS+NW*64*4, LDS_BYTES=LDS_OST+NW*4096;
constexpr float C2=0.125f*1.4426950408889634f;
__device__ __forceinline__ void glds16(const void*gsrc,unsigned lds_dst){unsigned keep;
  asm volatile("s_mov_b32 %0, m0\n\ts_mov_b32 m0, %2\n\ts_nop 0\n\tglobal_load_lds_dwordx4 %1, off\n\ts_mov_b32 m0, %0":"=&s"(keep):"v"(gsrc),"s"(lds_dst):"memory");}
__device__ __forceinline__ float max3f(float a,float b,float c){float r;asm("v_max3_f32 %0, %1, %2, %3":"=v"(r):"v"(a),"v"(b),"v"(c));return r;}
__device__ __forceinline__ float max2f(float a,float b){float r;asm("v_max_f32_e32 %0, %1, %2":"=v"(r):"v"(a),"v"(b));return r;}
__device__ __forceinline__ float fadd_s(float a,float b){float r;asm("v_add_f32_e32 %0, %1, %2":"=v"(r):"v"(a),"v"(b));return r;}
__device__ __forceinline__ float fsub_s(float a,float b){float r;asm("v_sub_f32_e32 %0, %1, %2":"=v"(r):"v"(a),"v"(b));return r;}
typedef float f32x2_t __attribute__((ext_vector_type(2))); typedef __bf16 bf16x2_t __attribute__((ext_vector_type(2)));
__device__ __forceinline__ unsigned cvtpk_s(float lo,float hi){f32x2_t v={lo,hi};bf16x2_t b=__builtin_convertvector(v,bf16x2_t);return __builtin_bit_cast(unsigned,b);}
#define WAIT_BAR(N) asm volatile("s_waitcnt vmcnt(" #N ") lgkmcnt(0)\n\ts_barrier":::"memory")

__device__ __forceinline__ void qkt(f32x16&p0,f32x16&p1,const char*Kslot,const bf16x8*qr,const f32x16&negm,int r32,int hi){
  const char*kb=Kslot+hi*1024+r32*16;
  #pragma unroll
  for(int d0=0;d0<4;++d0){
    const bf16x8 b0=*reinterpret_cast<const bf16x8*>(kb+d0*2048);
    const bf16x8 b1=*reinterpret_cast<const bf16x8*>(kb+d0*2048+512);
    {p0=__builtin_amdgcn_mfma_f32_32x32x16_bf16(b0,qr[d0],p0,0,0,0);p1=__builtin_amdgcn_mfma_f32_32x32x16_bf16(b1,qr[d0],p1,0,0,0);}}
}
typedef __attribute__((address_space(3))) const char* lds_cptr;
typedef short v4i16_t __attribute__((ext_vector_type(4)));
__device__ __forceinline__ void kload8(bf16x8*kf,lds_cptr kp){
  kf[0]=*(const __attribute__((address_space(3))) bf16x8*)(kp);      kf[1]=*(const __attribute__((address_space(3))) bf16x8*)(kp+512);
  kf[2]=*(const __attribute__((address_space(3))) bf16x8*)(kp+2048); kf[3]=*(const __attribute__((address_space(3))) bf16x8*)(kp+2560);
  kf[4]=*(const __attribute__((address_space(3))) bf16x8*)(kp+4096); kf[5]=*(const __attribute__((address_space(3))) bf16x8*)(kp+4608);
  kf[6]=*(const __attribute__((address_space(3))) bf16x8*)(kp+6144); kf[7]=*(const __attribute__((address_space(3))) bf16x8*)(kp+6656);
}
__device__ __forceinline__ void kload2(bf16x8*kf,lds_cptr kp,int j){ kf[2*j]=*(const __attribute__((address_space(3))) bf16x8*)(kp+j*2048); kf[2*j+1]=*(const __attribute__((address_space(3))) bf16x8*)(kp+j*2048+512); }
__device__ __forceinline__ s16x4 vtr(lds_cptr p){ return __builtin_bit_cast(s16x4,__builtin_amdgcn_ds_read_tr16_b64_v4i16((__attribute__((address_space(3))) v4i16_t*)p)); }
__device__ __forceinline__ float rowmax(const f32x16&p0,const f32x16&p1){
  float a=max3f(p0[0],p0[1],p1[0]),b=max3f(p0[2],p0[3],p1[1]);a=max3f(a,p1[2],p1[3]);
  #pragma unroll
  for(int r=4;r<16;r+=4){a=max3f(a,p0[r],p0[r+1]);b=max3f(b,p0[r+2],p0[r+3]);a=max3f(a,p1[r],p1[r+1]);b=max3f(b,p1[r+2],p1[r+3]);}
  const float m=max2f(a,b);
  auto rr=__builtin_amdgcn_permlane32_swap(__float_as_uint(m),__float_as_uint(m),false,false);
  return max2f(__uint_as_float(rr[0]),__uint_as_float(rr[1]));
}
__device__ __forceinline__ void pv(f32x16*o,int vb,bf16x8 pa0,bf16x8 pa1,bf16x8 pa2,bf16x8 pa3){
  #pragma unroll
  for(int d0=0;d0<2;++d0){s16x4 lo[4],hi[4];
    #pragma unroll
    for(int ks=0;ks<4;++ks){
      asm volatile("ds_read_b64_tr_b16 %0,%1 offset:%c2":"=&v"(lo[ks]):"v"(vb),"i"(d0*4096+ks*1024):"memory");
      asm volatile("ds_read_b64_tr_b16 %0,%1 offset:%c2":"=&v"(hi[ks]):"v"(vb),"i"(d0*4096+ks*1024+512):"memory");}
    asm volatile("s_waitcnt lgkmcnt(0)":::"memory");SBAR();
    #define PK(k) (bf16x8){lo[k][0],lo[k][1],lo[k][2],lo[k][3],hi[k][0],hi[k][1],hi[k][2],hi[k][3]}
    o[d0]=__builtin_amdgcn_mfma_f32_32x32x16_bf16(pa0,PK(0),o[d0],0,0,0);
    o[d0]=__builtin_amdgcn_mfma_f32_32x32x16_bf16(pa1,PK(1),o[d0],0,0,0);
    o[d0]=__builtin_amdgcn_mfma_f32_32x32x16_bf16(pa2,PK(2),o[d0],0,0,0);
    o[d0]=__builtin_amdgcn_mfma_f32_32x32x16_bf16(pa3,PK(3),o[d0],0,0,0);
    #undef PK
  }
}

#ifndef ATTN_STORE16
#define ATTN_STORE16(p,v) (*(u32x4*)(p)=(v))
#endif
template<int THRL> __device__ __forceinline__ void attn_unit(int b,int qcol,int kcol,int vcol,int ocol,int qb,int hd,const float*reltab,const bf16*Q,const bf16*__restrict__ K,const bf16*__restrict__ V,bf16*O,char*shm){
  int tid=threadIdx.x; asm volatile("":"+v"(tid));
  const int lane=tid&63,r32=lane&31,hi=lane>>5; const int wid=__builtin_amdgcn_readfirstlane(tid>>6);
  const long rowbase=(long)b*SEQ; const int q0=qb*QB;
  const bf16*Qw=Q+(rowbase+q0+wid*QBLK)*PQ+qcol;
  const bf16*Kh=K+rowbase*PK+kcol,*Vh=V+rowbase*PV+vcol;
  const lds_cptr shm3=(lds_cptr)shm;
  const unsigned lds0=(unsigned)(uintptr_t)shm;
  float*wsf=(float*)(shm+LDS_WS)+wid*64;
  const bf16*ksrc=Kh+(long)lane*PK+wid*8;
  const bf16*vsrc=Vh+(long)(16*(wid&3)+(lane>>2))*PV+(wid>>2)*32+(lane&3)*8;
  const unsigned kdst=lds0+LDS_K+wid*1024, vdst=lds0+LDS_V+wid*1024;
  #define DMA_K(t,slot) glds16(ksrc+(long)(t)*KVBLK*PK,(unsigned)__builtin_amdgcn_readfirstlane(kdst+(slot)))
  #define DMA_V(t,slot) glds16(vsrc+(long)(t)*KVBLK*PV,(unsigned)__builtin_amdgcn_readfirstlane(vdst+(slot)))
  const int vb0=(int)(lds0+LDS_V)+((lane>>4)&1)*32+(lane&3)*8+(4*hi+((lane&15)>>2))*64;
  const char*Kbase=shm+LDS_K; bf16x8 kf[8];
  const lds_cptr kp0=shm3+LDS_K+hi*1024+r32*16; const lds_cptr vp0=shm3+LDS_V+((lane>>4)&1)*32+(lane&3)*8+(4*hi+((lane&15)>>2))*64;
  const int NT=(q0+QB)/KVBLK;
  DMA_K(0,0);DMA_V(0,0);DMA_K(1,SLOTB);
  if(tid<256){ const int rel_=tid-191, n_=rel_<0?-rel_:rel_; const int bk_=(rel_>0?16:0)+(n_<8?n_:min(15,2+(31-__clz(n_*n_))));
    ((__attribute__((address_space(3))) float*)(shm3+LDS_BYTES))[tid]=(reltab[bk_*4+hd]-reltab[15*4+hd])*1.4426950408889634f; }
  bf16x8 qr[4];
  #pragma unroll
  for(int d0=0;d0<4;++d0)qr[d0]=*reinterpret_cast<const bf16x8*>(&Qw[(long)r32*PQ+d0*16+hi*8]);
  float mhat=0.f,l_reg=0.f;f32x16 o[2];o[0]=f32x16{};o[1]=f32x16{};f32x16 negm=f32x16{};asm volatile("":"+v"(negm));
  const int wc2=wid>>1; const lds_fptr dtl=(lds_fptr)(shm3+LDS_BYTES)+191-(32*(wid&1)+r32)+4*hi;
  bool resc=false;
  #define START(P0,P1) do{ const float rm=rowmax(P0,P1); resc=false; \
    { const float dl=rm; mhat=fadd_s(mhat,dl); \
      _Pragma("unroll") for(int r=0;r<16;++r){P0[r]=fsub_s(P0[r],dl);P1[r]=fsub_s(P1[r],dl);} \
      _Pragma("unroll") for(int r=0;r<16;++r)negm[r]=-mhat; asm volatile("":"+v"(negm)); } \
    _Pragma("unroll") for(int r=0;r<16;++r)P0[r]=__builtin_amdgcn_exp2f(P0[r]); }while(0)
  #define RESC() do{ if(resc){ asm volatile("s_waitcnt lgkmcnt(0)":::"memory"); \
      _Pragma("unroll") for(int d_=0;d_<2;++d_) _Pragma("unroll") for(int r=0;r<16;++r)o[d_][r]*=wsf[crow(r,hi)]; } }while(0)
  f32x16 pA0,pA1,pB0,pB1;
  int sl_prev=0,sl_cur=0,sl_next=SLOTB;
  #define ROT() do{sl_prev=sl_cur;sl_cur=sl_next;sl_next=(sl_next==(NSLOT-1)*SLOTB)?0:sl_next+SLOTB;}while(0)
  DMA_K(2,2*SLOTB);
  WAIT_BAR(3);
  { const int dist_=wc2+(NT-4); binit(pA0,pA1,dist_,dtl-64*dist_); }
  qkt(pA0,pA1,Kbase,qr,negm,r32,hi);asm volatile("s_nop 15\n\ts_nop 7":"+v"(pA0),"+v"(pA1));
  START(pA0,pA1);
  _Pragma("unroll") for(int r=0;r<16;++r)pA1[r]=__builtin_amdgcn_exp2f(pA1[r]);
  WAIT_BAR(0);
  DMA_K(3,0);DMA_V(1,SLOTB);
  ROT();
  kload8(kf,kp0+sl_cur);
  WAIT_BAR(2);
  s16x4 vlo[8],vhi[8]; u32x4 pw0,pw1,pw2,pw3;
  #define PKW(P,B) cvtpk_s(P[B],P[B+1])
  #define PAF(k) __builtin_bit_cast(bf16x8,pw##k)
  #define VFR(i) (bf16x8){vlo[i][0],vlo[i][1],vlo[i][2],vlo[i][3],vhi[i][0],vhi[i][1],vhi[i][2],vhi[i][3]}
  #define PIN(x) asm volatile("":"+v"(x))
  #define MX3(a,b,c) __builtin_fmaxf(__builtin_fmaxf((a),(b)),(c))
  #define GAPA(MF,A0,A1,A2,A3,W0,W1,PW) do{ MF; sacc+=A0; sacc+=A1; sacc+=A2; sacc+=A3; PIN(sacc); W0; W1; PIN(PW); SBAR(); }while(0)
  #define EX(v) __builtin_amdgcn_exp2f(v)
  #define GAPB(MF,X,B) do{ MF; X[B]=EX(X[B]); X[B+1]=EX(X[B+1]); X[B+2]=EX(X[B+2]); X[B+3]=EX(X[B+3]); PIN(X); SBAR(); }while(0)
  #define VRD(i) do{ vlo[i]=vtr(vp_+(((i)>>2)*4096+((i)&3)*1024)); vhi[i]=vtr(vp_+(((i)>>2)*4096+((i)&3)*1024+512)); }while(0)
  #define KRD(G,j) do{ if(G){ kload2(kf,kp0+sl_next,j); SBAR(); } }while(0)
  #define STEP(C0,C1,P0,P1,t,GK,GV,GL) do{ SBAR(); \
    const lds_cptr vp_=vp0+sl_prev; \
    CINIT0(C0,t); VRD(0); SBAR(); float sacc=(P0[0]+P0[1]); \
    GAPA(C0=__builtin_amdgcn_mfma_f32_32x32x16_bf16(kf[0],qr[0],CSRC(C0),0,0,0), P0[2],P0[3],P0[4],P0[5],     pw0[0]=PKW(P0,0), pw0[1]=PKW(P0,2), pw0); \
    CINIT1(C1,t); VRD(4); SBAR(); GAPA(C1=__builtin_amdgcn_mfma_f32_32x32x16_bf16(kf[1],qr[0],CSRC(C1),0,0,0), P0[6],P0[7],P0[8],P0[9],     pw0[2]=PKW(P0,4), pw0[3]=PKW(P0,6), pw0); \
    VRD(1); SBAR(); GAPA(C0=__builtin_amdgcn_mfma_f32_32x32x16_bf16(kf[2],qr[1],C0,0,0,0),   P0[10],P0[11],P0[12],P0[13], pw1[0]=PKW(P0,8), pw1[1]=PKW(P0,10), pw1); \
    VRD(5); SBAR(); GAPA(C1=__builtin_amdgcn_mfma_f32_32x32x16_bf16(kf[3],qr[1],C1,0,0,0),   P0[14],P0[15],P1[0],P1[1],   pw1[2]=PKW(P0,12),pw1[3]=PKW(P0,14), pw1); \
    VRD(2); SBAR(); GAPA(C0=__builtin_amdgcn_mfma_f32_32x32x16_bf16(kf[4],qr[2],C0,0,0,0),   P1[2],P1[3],P1[4],P1[5],     pw2[0]=PKW(P1,0), pw2[1]=PKW(P1,2), pw2); \
    VRD(6); SBAR(); GAPA(C1=__builtin_amdgcn_mfma_f32_32x32x16_bf16(kf[5],qr[2],C1,0,0,0),   P1[6],P1[7],P1[8],P1[9],     pw2[2]=PKW(P1,4), pw2[3]=PKW(P1,6), pw2); \
    VRD(3); SBAR(); GAPA(C0=__builtin_amdgcn_mfma_f32_32x32x16_bf16(kf[6],qr[3],C0,0,0,0),   P1[10],P1[11],P1[12],P1[13], pw3[0]=PKW(P1,8), pw3[1]=PKW(P1,10), pw3); \
    VRD(7); SBAR(); GAPA(C1=__builtin_amdgcn_mfma_f32_32x32x16_bf16(kf[7],qr[3],C1,0,0,0),   P1[14],P1[15],0.f,0.f,       pw3[2]=PKW(P1,12),pw3[3]=PKW(P1,14), pw3); \
    l_reg+=sacc; \
    if(GK){DMA_K((t)+3,sl_cur);} if(GV){DMA_V((t)+1,sl_next);} \
    CPOST(C0,C1); \
    { float a=MX3(C0[0],C0[1],C1[0]),b=MX3(C0[2],C0[3],C1[1]); a=MX3(a,C1[2],C1[3]); \
      _Pragma("unroll") for(int r=4;r<16;r+=4){a=MX3(a,C0[r],C0[r+1]);b=MX3(b,C0[r+2],C0[r+3]);a=MX3(a,C1[r],C1[r+1]);b=MX3(b,C1[r+2],C1[r+3]);} \
      float rm=__builtin_fmaxf(a,b); { auto rr=__builtin_amdgcn_permlane32_swap(__float_as_uint(rm),__float_as_uint(rm),false,false); rm=__builtin_fmaxf(__uint_as_float(rr[0]),__uint_as_float(rr[1])); } \
      resc=false; \
      if(__builtin_expect(__any(rm>(float)THRL),0)){ const float dl=__builtin_fmaxf(rm,0.f); mhat+=dl; \
        _Pragma("unroll") for(int r=0;r<16;++r){C0[r]-=dl;C1[r]-=dl;} \
        NEGM_UPD(); \
        const float f=__builtin_amdgcn_exp2f(-dl); l_reg*=f; if(hi==0)wsf[r32]=f; resc=true; } } \
    SBAR(); \
    GAPB(o[0]=__builtin_amdgcn_mfma_f32_32x32x16_bf16(PAF(0),VFR(0),o[0],0,0,0), C0,0); \
    GAPB(o[1]=__builtin_amdgcn_mfma_f32_32x32x16_bf16(PAF(0),VFR(4),o[1],0,0,0), C0,4); \
    KRD(GL,0); GAPB(o[0]=__builtin_amdgcn_mfma_f32_32x32x16_bf16(PAF(1),VFR(1),o[0],0,0,0), C0,8); \
    KRD(GL,1); GAPB(o[1]=__builtin_amdgcn_mfma_f32_32x32x16_bf16(PAF(1),VFR(5),o[1],0,0,0), C0,12); \
    KRD(GL,2); GAPB(o[0]=__builtin_amdgcn_mfma_f32_32x32x16_bf16(PAF(2),VFR(2),o[0],0,0,0), C1,0); \
    KRD(GL,3); GAPB(o[1]=__builtin_amdgcn_mfma_f32_32x32x16_bf16(PAF(2),VFR(6),o[1],0,0,0), C1,4); \
    GAPB(o[0]=__builtin_amdgcn_mfma_f32_32x32x16_bf16(PAF(3),VFR(3),o[0],0,0,0), C1,8); \
    GAPB(o[1]=__builtin_amdgcn_mfma_f32_32x32x16_bf16(PAF(3),VFR(7),o[1],0,0,0), C1,12); \
    }while(0)
  int t=1;
  #define CINIT0(C,t) do{}while(0)
  #define CINIT1(C,t) do{}while(0)
  #define CSRC(C) negm
  #define CPOST(C0,C1) do{}while(0)
  #define NEGM_UPD() do{ _Pragma("unroll") for(int r=0;r<16;++r)negm[r]=-mhat; asm volatile("":"+v"(negm)); }while(0)
  for(;t+7<NT;t+=2){
    STEP(pB0,pB1,pA0,pA1,t,true,true,true);     WAIT_BAR(2); RESC(); ROT();
    STEP(pA0,pA1,pB0,pB1,t+1,true,true,true);   WAIT_BAR(2); RESC(); ROT();
  }
  #undef CINIT0
  #undef CINIT1
  #undef CSRC
  #undef CPOST
  #undef NEGM_UPD
  #define NEGM_UPD() do{}while(0)
  #define CINIT0(C,t) do{const int dist_=wc2+(NT-4-(t)); binit1(C,dist_,dtl-64*dist_);}while(0)
  #define CINIT1(C,t) do{const int dist_=wc2+(NT-4-(t)); binit1(C,dist_,dtl-64*dist_+32);}while(0)
  #define CSRC(C) C
  #define CPOST(C0,C1) bpost(C0,C1,mhat)
  #define ENDW(tt) do{ if((tt)+3<NT){WAIT_BAR(2);} else if((tt)+2<NT){WAIT_BAR(1);} else {WAIT_BAR(0);} }while(0)
  for(;t+1<NT;t+=2){
    STEP(pB0,pB1,pA0,pA1,t,(t+3<NT),(t+1<NT),(t+1<NT));       ENDW(t);   RESC(); ROT();
    STEP(pA0,pA1,pB0,pB1,t+1,(t+4<NT),(t+2<NT),(t+2<NT));     ENDW(t+1); RESC(); ROT();
  }
  STEP(pB0,pB1,pA0,pA1,NT-1,false,false,false); RESC();
  { float sacc=pB0[0]+pB0[1]; _Pragma("unroll") for(int r=2;r<16;++r)sacc+=pB0[r]; _Pragma("unroll") for(int r=0;r<16;++r)sacc+=pB1[r]; l_reg+=sacc;
    pw0=(u32x4){PKW(pB0,0),PKW(pB0,2),PKW(pB0,4),PKW(pB0,6)};pw1=(u32x4){PKW(pB0,8),PKW(pB0,10),PKW(pB0,12),PKW(pB0,14)};pw2=(u32x4){PKW(pB1,0),PKW(pB1,2),PKW(pB1,4),PKW(pB1,6)};pw3=(u32x4){PKW(pB1,8),PKW(pB1,10),PKW(pB1,12),PKW(pB1,14)};
    SBAR(); pv(o,vb0+sl_cur,PAF(0),PAF(1),PAF(2),PAF(3)); }
  #undef PKW
  #undef PAF
  #undef VFR
  #undef PIN
  #undef MX3
  #undef GAPA
  #undef GAPB
  #undef EX
  #undef VRD
  #undef KRD
  #undef STEP
  #undef ENDW
  {auto rr=__builtin_amdgcn_permlane32_swap(__float_as_uint(l_reg),__float_as_uint(l_reg),false,false);l_reg=__uint_as_float(rr[0])+__uint_as_float(rr[1]);}
  if(hi==0)wsf[32+r32]=l_reg;asm volatile("s_waitcnt lgkmcnt(0)":::"memory");
  float rli[16];
  #pragma unroll
  for(int r=0;r<16;++r)rli[r]=__builtin_amdgcn_rcpf(wsf[32+crow(r,hi)]);
  bf16*Ow=O+(rowbase+q0+wid*QBLK)*PO+ocol;
  { bf16*stg=(bf16*)(shm+LDS_OST)+wid*2048;
    #pragma unroll
    for(int r=0;r<16;++r){const int orow=crow(r,hi);
      #pragma unroll
      for(int d0=0;d0<2;++d0)stg[orow*64+d0*32+r32]=__float2bfloat16(o[d0][r]*rli[r]);}
    asm volatile("s_waitcnt lgkmcnt(0)":::"memory");
    #pragma unroll
    for(int i=0;i<4;++i){const int row=i*8+(lane>>3),ch=lane&7; const u32x4 v=*(const u32x4*)(stg+row*64+ch*8); ATTN_STORE16(Ow+(long)row*PO+ch*8,v);} }
  asm volatile("s_waitcnt lgkmcnt(0)\n\ts_barrier":::"memory");
  #undef DMA_K
  #undef DMA_V
  #undef CINIT0
  #undef CINIT1
  #undef CSRC
  #undef CPOST
  #undef NEGM_UPD
  #undef START
  #undef RESC
  #undef ROT
}
constexpr int ATTN_LDS_BYTES=LDS_BYTES+1024;
#undef SBAR
#undef WAIT_BAR
}
#include <hip/hip_bf16.h>
#include <cmath>
namespace attn2 {
using bf16=__hip_bfloat16;
using bf16x8=__attribute__((ext_vector_type(8)))short;
using s16x4=__attribute__((ext_vector_type(4)))short;
using f32x16=__attribute__((ext_vector_type(16)))float;
using u32x4=__attribute__((ext_vector_type(4)))unsigned;
constexpr int SEQ=4096,D=64,PQ=512,PK=512,PV=512,PO=1024;
constexpr int NW=8,QBLK=32,QB=QBLK*NW,KVBLK=64,NQB=SEQ/QB;
constexpr int ATTN_UNIT_ROWS=QB;
__device__ __forceinline__ int crow(int r,int hi){return (r&3)+8*(r>>2)+4*hi;}
#define SBAR() __builtin_amdgcn_sched_barrier(0)
typedef __attribute__((address_space(3))) const float* lds_fptr;
__device__ __forceinline__ void bmask(f32x16&p0,f32x16&p1,int dist,lds_fptr tb){
  if(dist<0){
    #pragma unroll
    for(int r=0;r<16;++r){p0[r]=-INFINITY;p1[r]=-INFINITY;}
  } else if(dist<=2){
    #pragma unroll
    for(int r=0;r<16;++r){const int o=(r&3)+8*(r>>2); p0[r]+=tb[o]; p1[r]+=tb[o+32];}
  }
}

__device__ __forceinline__ void binit(f32x16&c0,f32x16&c1,int dist,lds_fptr tb){
  if(dist<0){
    #pragma unroll
    for(int r=0;r<16;++r){c0[r]=-INFINITY;c1[r]=-INFINITY;}
  } else if(dist<=2){
    #pragma unroll
    for(int r=0;r<16;++r){const int o=(r&3)+8*(r>>2); c0[r]=tb[o]; c1[r]=tb[o+32];}
  } else {
    #pragma unroll
    for(int r=0;r<16;++r){c0[r]=0.f;c1[r]=0.f;}
  }
}
__device__ __forceinline__ void binit1(f32x16&c,int dist,lds_fptr tb){
  if(dist<0){
    #pragma unroll
    for(int r=0;r<16;++r)c[r]=-INFINITY;
  } else if(dist<=2){
    #pragma unroll
    for(int r=0;r<16;++r)c[r]=tb[(r&3)+8*(r>>2)];
  } else {
    #pragma unroll
    for(int r=0;r<16;++r)c[r]=0.f;
  }
}
__device__ __forceinline__ void bpost(f32x16&c0,f32x16&c1,float mhat){
  #pragma unroll
  for(int r=0;r<16;++r){c0[r]-=mhat;c1[r]-=mhat;}
}
constexpr int NSLOT=3, SLOTB=8192;
constexpr int LDS_K=0, LDS_V=NSLOT*SLOTB, LDS_WS=LDS_V+NSLOT*2*SLOTB, LDS_OST=LDS_WS+NW*64*4, LDS_BYTES=LDS_OST+NW*4096;
constexpr float C2=0.125f*1.4426950408889634f;
template<int OFF> __device__ __forceinline__ void glds16s(const void*sbase,unsigned voff,unsigned lds_dst){unsigned keep;
  asm volatile("s_mov_b32 %0, m0\n\ts_mov_b32 m0, %3\n\ts_nop 0\n\tglobal_load_lds_dwordx4 %1, %2 offset:%c4\n\ts_mov_b32 m0, %0":"=&s"(keep):"v"(voff),"s"(sbase),"s"(lds_dst),"i"(OFF):"memory");}
__device__ __forceinline__ void glds16(const void*gsrc,unsigned lds_dst){unsigned keep;
  asm volatile("s_mov_b32 %0, m0\n\ts_mov_b32 m0, %2\n\ts_nop 0\n\tglobal_load_lds_dwordx4 %1, off\n\ts_mov_b32 m0, %0":"=&s"(keep):"v"(gsrc),"s"(lds_dst):"memory");}
__device__ __forceinline__ float max3f(float a,float b,float c){float r;asm("v_max3_f32 %0, %1, %2, %3":"=v"(r):"v"(a),"v"(b),"v"(c));return r;}
__device__ __forceinline__ float max2f(float a,float b){float r;asm("v_max_f32_e32 %0, %1, %2":"=v"(r):"v"(a),"v"(b));return r;}
__device__ __forceinline__ float fadd_s(float a,float b){float r;asm("v_add_f32_e32 %0, %1, %2":"=v"(r):"v"(a),"v"(b));return r;}
__device__ __forceinline__ float fsub_s(float a,float b){float r;asm("v_sub_f32_e32 %0, %1, %2":"=v"(r):"v"(a),"v"(b));return r;}
typedef float f32x2_t __attribute__((ext_vector_type(2))); typedef __bf16 bf16x2_t __attribute__((ext_vector_type(2)));
__device__ __forceinline__ unsigned cvtpk_s(float lo,float hi){f32x2_t v={lo,hi};bf16x2_t b=__builtin_convertvector(v,bf16x2_t);return __builtin_bit_cast(unsigned,b);}
#define WAIT_BAR(N) asm volatile("s_waitcnt vmcnt(" #N ") lgkmcnt(0)\n\ts_barrier":::"memory")

__device__ __forceinline__ void qkt(f32x16&p0,f32x16&p1,const char*Kslot,const bf16x8*qr,int r32,int hi){
  const char*kb=Kslot+hi*1024+r32*16;
  #pragma unroll
  for(int d0=0;d0<4;++d0){
    const bf16x8 b0=*reinterpret_cast<const bf16x8*>(kb+d0*2048);
    const bf16x8 b1=*reinterpret_cast<const bf16x8*>(kb+d0*2048+512);
    {p0=__builtin_amdgcn_mfma_f32_32x32x16_bf16(b0,qr[d0],p0,0,0,0);p1=__builtin_amdgcn_mfma_f32_32x32x16_bf16(b1,qr[d0],p1,0,0,0);}}
}
typedef __attribute__((address_space(3))) const char* lds_cptr;
typedef short v4i16_t __attribute__((ext_vector_type(4)));
__device__ __forceinline__ void kload8(bf16x8*kf,lds_cptr kp){
  kf[0]=*(const __attribute__((address_space(3))) bf16x8*)(kp);      kf[1]=*(const __attribute__((address_space(3))) bf16x8*)(kp+512);
  kf[2]=*(const __attribute__((address_space(3))) bf16x8*)(kp+2048); kf[3]=*(const __attribute__((address_space(3))) bf16x8*)(kp+2560);
  kf[4]=*(const __attribute__((address_space(3))) bf16x8*)(kp+4096); kf[5]=*(const __attribute__((address_space(3))) bf16x8*)(kp+4608);
  kf[6]=*(const __attribute__((address_space(3))) bf16x8*)(kp+6144); kf[7]=*(const __attribute__((address_space(3))) bf16x8*)(kp+6656);
}
__device__ __forceinline__ void kload2(bf16x8*kf,lds_cptr kp,int j){ kf[2*j]=*(const __attribute__((address_space(3))) bf16x8*)(kp+j*2048); kf[2*j+1]=*(const __attribute__((address_space(3))) bf16x8*)(kp+j*2048+512); }
__device__ __forceinline__ s16x4 vtr(lds_cptr p){ return __builtin_bit_cast(s16x4,__builtin_amdgcn_ds_read_tr16_b64_v4i16((__attribute__((address_space(3))) v4i16_t*)p)); }
__device__ __forceinline__ float rowmax(const f32x16&p0,const f32x16&p1){
  float a=max3f(p0[0],p0[1],p1[0]),b=max3f(p0[2],p0[3],p1[1]);a=max3f(a,p1[2],p1[3]);
  #pragma unroll
  for(int r=4;r<16;r+=4){a=max3f(a,p0[r],p0[r+1]);b=max3f(b,p0[r+2],p0[r+3]);a=max3f(a,p1[r],p1[r+1]);b=max3f(b,p1[r+2],p1[r+3]);}
  const float m=max2f(a,b);
  auto rr=__builtin_amdgcn_permlane32_swap(__float_as_uint(m),__float_as_uint(m),false,false);
  return max2f(__uint_as_float(rr[0]),__uint_as_float(rr[1]));
}
__device__ __forceinline__ void pv(f32x16*o,int vb,bf16x8 pa0,bf16x8 pa1,bf16x8 pa2,bf16x8 pa3){
  #pragma unroll
  for(int d0=0;d0<4;++d0){s16x4 lo[4],hi[4];
    #pragma unroll
    for(int ks=0;ks<4;++ks){
      asm volatile("ds_read_b64_tr_b16 %0,%1 offset:%c2":"=&v"(lo[ks]):"v"(vb),"i"(d0*4096+ks*1024):"memory");
      asm volatile("ds_read_b64_tr_b16 %0,%1 offset:%c2":"=&v"(hi[ks]):"v"(vb),"i"(d0*4096+ks*1024+512):"memory");}
    asm volatile("s_waitcnt lgkmcnt(0)":::"memory");SBAR();
    #define PK(k) (bf16x8){lo[k][0],lo[k][1],lo[k][2],lo[k][3],hi[k][0],hi[k][1],hi[k][2],hi[k][3]}
    o[d0]=__builtin_amdgcn_mfma_f32_32x32x16_bf16(pa0,PK(0),o[d0],0,0,0);
    o[d0]=__builtin_amdgcn_mfma_f32_32x32x16_bf16(pa1,PK(1),o[d0],0,0,0);
    o[d0]=__builtin_amdgcn_mfma_f32_32x32x16_bf16(pa2,PK(2),o[d0],0,0,0);
    o[d0]=__builtin_amdgcn_mfma_f32_32x32x16_bf16(pa3,PK(3),o[d0],0,0,0);
    #undef PK
  }
}

#ifndef ATTN_STORE16
#define ATTN_STORE16(p,v) (*(u32x4*)(p)=(v))
#endif
template<int THRL> __device__ __forceinline__ void attn_unit(int b,int qcol,int kcol,int vcol,int ocol,int qb,int hd,const float*reltab,const bf16*Q,const bf16*__restrict__ K,const bf16*__restrict__ V,bf16*O,char*shm){
  int tid=threadIdx.x; asm volatile("":"+v"(tid));
  const int lane=tid&63,r32=lane&31,hi=lane>>5; const int wid=__builtin_amdgcn_readfirstlane(tid>>6);
  const long rowbase=(long)b*SEQ; const int q0=qb*QB;
  const bf16*Qw=Q+(rowbase+q0+wid*QBLK)*PQ+qcol;
  const bf16*Kh=K+rowbase*PK+kcol,*Vh=V+rowbase*PV+vcol;
  const lds_cptr shm3=(lds_cptr)shm;
  const unsigned lds0=(unsigned)(uintptr_t)shm;
  float*wsf=(float*)(shm+LDS_WS)+wid*64;
  const unsigned koff=(unsigned)((lane*PK+wid*8)*2);
  const unsigned voff=(unsigned)(((16*(wid&3)+(lane>>2))*PV+(wid>>2)*32+(lane&3)*8)*2);
  const unsigned kdst=lds0+LDS_K+wid*1024, vdst=lds0+LDS_V+wid*1024;
  #define DMA_K(t,slot) glds16s<0>(Kh+(long)(t)*KVBLK*PK,koff,(unsigned)__builtin_amdgcn_readfirstlane(kdst+(slot)))
  #define DMA_V(t,slot) do{ glds16s<0>(Vh+(long)(t)*KVBLK*PV,voff,(unsigned)__builtin_amdgcn_readfirstlane(vdst+2*(slot))); glds16s<0>(Vh+64+(long)(t)*KVBLK*PV,voff,(unsigned)__builtin_amdgcn_readfirstlane(vdst+2*(slot)+8192)); }while(0)
  const int vb0=(int)(lds0+LDS_V)+((lane>>4)&1)*32+(lane&3)*8+(4*hi+((lane&15)>>2))*64;
  const char*Kbase=shm+LDS_K; bf16x8 kf[8];
  const lds_cptr kp0=shm3+LDS_K+hi*1024+r32*16; const lds_cptr vp0=shm3+LDS_V+((lane>>4)&1)*32+(lane&3)*8+(4*hi+((lane&15)>>2))*64;
  const int NT=(q0+QB)/KVBLK;
  DMA_K(0,0);DMA_V(0,0);DMA_K(1,SLOTB);
  if(tid<256){ const int rel_=tid-191, n_=rel_<0?-rel_:rel_; const int bk_=(rel_>0?16:0)+(n_<8?n_:min(15,2+(31-__clz(n_*n_))));
    ((__attribute__((address_space(3))) float*)(shm3+LDS_BYTES))[tid]=(reltab[bk_*4+hd]-reltab[15*4+hd])*1.4426950408889634f; }
  const lds_cptr qlp0=shm3+LDS_OST+wid*4096+lane*16;
  { bf16x8 qr_[4];
    #pragma unroll
    for(int d0=0;d0<4;++d0)qr_[d0]=*reinterpret_cast<const bf16x8*>(&Qw[(long)r32*PQ+d0*16+hi*8]);
    #pragma unroll
    for(int d0=0;d0<4;++d0)*(__attribute__((address_space(3))) bf16x8*)(qlp0+d0*1024)=qr_[d0]; }
  #define QR(k) (*(const __attribute__((address_space(3))) bf16x8*)(qlp_+(k)*1024))
  bf16x8 qfr0;
  float mhat=0.f,l_reg=0.f;f32x16 o[4];o[0]=f32x16{};o[1]=f32x16{};o[2]=f32x16{};o[3]=f32x16{};
  const int wc2=wid>>1; const lds_fptr dtl=(lds_fptr)(shm3+LDS_BYTES)+191-(32*(wid&1)+r32)+4*hi;
  bool resc=false;
  #define START(P0,P1) do{ const float rm=rowmax(P0,P1); resc=false; \
    { const float dl=rm; mhat=fadd_s(mhat,dl); \
      _Pragma("unroll") for(int r=0;r<16;++r){P0[r]=fsub_s(P0[r],dl);P1[r]=fsub_s(P1[r],dl);} \
      } \
    _Pragma("unroll") for(int r=0;r<16;++r)P0[r]=__builtin_amdgcn_exp2f(P0[r]); }while(0)
  #define RESC() do{ if(resc){ asm volatile("s_waitcnt lgkmcnt(0)":::"memory"); \
      _Pragma("unroll") for(int d_=0;d_<4;++d_) _Pragma("unroll") for(int r=0;r<16;++r)o[d_][r]*=wsf[crow(r,hi)]; } }while(0)
  f32x16 pA0,pA1,pB0,pB1;
  int sl_prev=0,sl_cur=0,sl_next=SLOTB;
  #define ROT() do{sl_prev=sl_cur;sl_cur=sl_next;sl_next=(sl_next==(NSLOT-1)*SLOTB)?0:sl_next+SLOTB;}while(0)
  DMA_K(2,2*SLOTB);
  WAIT_BAR(3);
  { const int dist_=wc2+(NT-4); binit(pA0,pA1,dist_,dtl-64*dist_); }
  { bf16x8 qr_[4]; const lds_cptr qlp_=qlp0;
    #pragma unroll
    for(int d0=0;d0<4;++d0)qr_[d0]=QR(d0);
    qkt(pA0,pA1,Kbase,qr_,r32,hi); qfr0=qr_[0]; }asm volatile("s_nop 15\n\ts_nop 7":"+v"(pA0),"+v"(pA1));
  START(pA0,pA1);
  _Pragma("unroll") for(int r=0;r<16;++r)pA1[r]=__builtin_amdgcn_exp2f(pA1[r]);
  WAIT_BAR(0);
  DMA_K(3,0);DMA_V(1,SLOTB);
  ROT();
  kload8(kf,kp0+sl_cur);
  WAIT_BAR(3);
  s16x4 vlo[8],vhi[8]; u32x4 pw0,pw1,pw2,pw3;
  #define PKW(P,B) cvtpk_s(P[B],P[B+1])
  #define PAF(k) __builtin_bit_cast(bf16x8,pw##k)
  #define VFR(i) (bf16x8){vlo[i][0],vlo[i][1],vlo[i][2],vlo[i][3],vhi[i][0],vhi[i][1],vhi[i][2],vhi[i][3]}
  #define PIN(x) asm volatile("":"+v"(x))
  #define MX3(a,b,c) __builtin_fmaxf(__builtin_fmaxf((a),(b)),(c))
  #define GAPA(MF,A0,A1,A2,A3,W0,W1,PW) do{ MF; sacc+=A0; sacc+=A1; sacc+=A2; sacc+=A3; PIN(sacc); W0; W1; PIN(PW); SBAR(); }while(0)
  #define EX(v) __builtin_amdgcn_exp2f(v)
  #define GAPB2(MF,X,B) do{ MF; X[B]=EX(X[B]); X[B+1]=EX(X[B+1]); PIN(X); SBAR(); }while(0)
  #define VRD2(i) do{ vlo[i]=vtr(vp_+((((i)>>2)+2)*4096+((i)&3)*1024)); vhi[i]=vtr(vp_+((((i)>>2)+2)*4096+((i)&3)*1024+512)); }while(0)
  #define VRD(i) do{ vlo[i]=vtr(vp_+(((i)>>2)*4096+((i)&3)*1024)); vhi[i]=vtr(vp_+(((i)>>2)*4096+((i)&3)*1024+512)); }while(0)
  #define KRD(G,j) do{ if(G){ kload2(kf,kp0+sl_next,j); SBAR(); } }while(0)
  #define STEP(C0,C1,P0,P1,t,GK,GV,GL) do{ SBAR(); \
    const lds_cptr vp_=vp0+2*sl_prev; lds_cptr qlp_=qlp0; asm volatile("":"+v"(qlp_)); \
    const bf16x8 qB_=QR(1); \
    CINIT0(C0,t); VRD(0); SBAR(); float sacc=(P0[0]+P0[1]); \
    GAPA(C0=__builtin_amdgcn_mfma_f32_32x32x16_bf16(kf[0],qfr0,CSRC(C0),0,0,0), P0[2],P0[3],P0[4],P0[5],     pw0[0]=PKW(P0,0), pw0[1]=PKW(P0,2), pw0); \
    CINIT1(C1,t); VRD(4); SBAR(); GAPA(C1=__builtin_amdgcn_mfma_f32_32x32x16_bf16(kf[1],qfr0,CSRC(C1),0,0,0), P0[6],P0[7],P0[8],P0[9],     pw0[2]=PKW(P0,4), pw0[3]=PKW(P0,6), pw0); \
    const bf16x8 qC_=QR(2); VRD(1); SBAR(); GAPA(C0=__builtin_amdgcn_mfma_f32_32x32x16_bf16(kf[2],qB_,C0,0,0,0),   P0[10],P0[11],P0[12],P0[13], pw1[0]=PKW(P0,8), pw1[1]=PKW(P0,10), pw1); \
    VRD(5); SBAR(); GAPA(C1=__builtin_amdgcn_mfma_f32_32x32x16_bf16(kf[3],qB_,C1,0,0,0),   P0[14],P0[15],P1[0],P1[1],   pw1[2]=PKW(P0,12),pw1[3]=PKW(P0,14), pw1); \
    const bf16x8 qD_=QR(3); VRD(2); SBAR(); GAPA(C0=__builtin_amdgcn_mfma_f32_32x32x16_bf16(kf[4],qC_,C0,0,0,0),   P1[2],P1[3],P1[4],P1[5],     pw2[0]=PKW(P1,0), pw2[1]=PKW(P1,2), pw2); \
    VRD(6); SBAR(); GAPA(C1=__builtin_amdgcn_mfma_f32_32x32x16_bf16(kf[5],qC_,C1,0,0,0),   P1[6],P1[7],P1[8],P1[9],     pw2[2]=PKW(P1,4), pw2[3]=PKW(P1,6), pw2); \
    VRD(3); SBAR(); GAPA(C0=__builtin_amdgcn_mfma_f32_32x32x16_bf16(kf[6],qD_,C0,0,0,0),   P1[10],P1[11],P1[12],P1[13], pw3[0]=PKW(P1,8), pw3[1]=PKW(P1,10), pw3); \
    VRD(7); SBAR(); GAPA(C1=__builtin_amdgcn_mfma_f32_32x32x16_bf16(kf[7],qD_,C1,0,0,0),   P1[14],P1[15],0.f,0.f,       pw3[2]=PKW(P1,12),pw3[3]=PKW(P1,14), pw3); \
    l_reg+=sacc; \
    if(GK){DMA_K((t)+3,sl_cur);} if(GV){DMA_V((t)+1,sl_next);} \
    CPOST(C0,C1); \
    { float a=MX3(C0[0],C0[1],C1[0]),b=MX3(C0[2],C0[3],C1[1]); a=MX3(a,C1[2],C1[3]); \
      _Pragma("unroll") for(int r=4;r<16;r+=4){a=MX3(a,C0[r],C0[r+1]);b=MX3(b,C0[r+2],C0[r+3]);a=MX3(a,C1[r],C1[r+1]);b=MX3(b,C1[r+2],C1[r+3]);} \
      float rm=__builtin_fmaxf(a,b); { auto rr=__builtin_amdgcn_permlane32_swap(__float_as_uint(rm),__float_as_uint(rm),false,false); rm=__builtin_fmaxf(__uint_as_float(rr[0]),__uint_as_float(rr[1])); } \
      resc=false; \
      if(__builtin_expect(__any(rm>(float)THRL),0)){ const float dl=__builtin_fmaxf(rm,0.f); mhat+=dl; \
        _Pragma("unroll") for(int r=0;r<16;++r){C0[r]-=dl;C1[r]-=dl;} \
        NEGM_UPD(); \
        const float f=__builtin_amdgcn_exp2f(-dl); l_reg*=f; if(hi==0)wsf[r32]=f; resc=true; } } \
    SBAR(); \
    GAPB2(o[0]=__builtin_amdgcn_mfma_f32_32x32x16_bf16(PAF(0),VFR(0),o[0],0,0,0), C0,0);  VRD2(0); SBAR(); \
    GAPB2(o[1]=__builtin_amdgcn_mfma_f32_32x32x16_bf16(PAF(0),VFR(4),o[1],0,0,0), C0,2);  VRD2(4); SBAR(); \
    KRD(GL,0); GAPB2(o[0]=__builtin_amdgcn_mfma_f32_32x32x16_bf16(PAF(1),VFR(1),o[0],0,0,0), C0,4);  VRD2(1); SBAR(); \
    KRD(GL,1); GAPB2(o[1]=__builtin_amdgcn_mfma_f32_32x32x16_bf16(PAF(1),VFR(5),o[1],0,0,0), C0,6);  VRD2(5); SBAR(); \
    KRD(GL,2); GAPB2(o[0]=__builtin_amdgcn_mfma_f32_32x32x16_bf16(PAF(2),VFR(2),o[0],0,0,0), C0,8);  VRD2(2); SBAR(); \
    KRD(GL,3); GAPB2(o[1]=__builtin_amdgcn_mfma_f32_32x32x16_bf16(PAF(2),VFR(6),o[1],0,0,0), C0,10); VRD2(6); SBAR(); \
    GAPB2(o[0]=__builtin_amdgcn_mfma_f32_32x32x16_bf16(PAF(3),VFR(3),o[0],0,0,0), C0,12); VRD2(3); SBAR(); \
    GAPB2(o[1]=__builtin_amdgcn_mfma_f32_32x32x16_bf16(PAF(3),VFR(7),o[1],0,0,0), C0,14); VRD2(7); SBAR(); \
    GAPB2(o[2]=__builtin_amdgcn_mfma_f32_32x32x16_bf16(PAF(0),VFR(0),o[2],0,0,0), C1,0); \
    GAPB2(o[3]=__builtin_amdgcn_mfma_f32_32x32x16_bf16(PAF(0),VFR(4),o[3],0,0,0), C1,2); \
    GAPB2(o[2]=__builtin_amdgcn_mfma_f32_32x32x16_bf16(PAF(1),VFR(1),o[2],0,0,0), C1,4); \
    GAPB2(o[3]=__builtin_amdgcn_mfma_f32_32x32x16_bf16(PAF(1),VFR(5),o[3],0,0,0), C1,6); \
    GAPB2(o[2]=__builtin_amdgcn_mfma_f32_32x32x16_bf16(PAF(2),VFR(2),o[2],0,0,0), C1,8); \
    GAPB2(o[3]=__builtin_amdgcn_mfma_f32_32x32x16_bf16(PAF(2),VFR(6),o[3],0,0,0), C1,10); \
    GAPB2(o[2]=__builtin_amdgcn_mfma_f32_32x32x16_bf16(PAF(3),VFR(3),o[2],0,0,0), C1,12); \
    GAPB2(o[3]=__builtin_amdgcn_mfma_f32_32x32x16_bf16(PAF(3),VFR(7),o[3],0,0,0), C1,14); \
    }while(0)
  int t=1;
  #define CINIT0(C,t) do{}while(0)
  #define CINIT1(C,t) do{}while(0)
  #define CSRC(C) (f32x16{})
  #define CPOST(C0,C1) bpost(C0,C1,mhat)
  #define NEGM_UPD() do{}while(0)
  for(;t+7<NT;t+=2){
    STEP(pB0,pB1,pA0,pA1,t,true,true,true);     WAIT_BAR(3); RESC(); ROT();
    STEP(pA0,pA1,pB0,pB1,t+1,true,true,true);   WAIT_BAR(3); RESC(); ROT();
  }
  #undef CINIT0
  #undef CINIT1
  #undef CSRC
  #undef CPOST
  #undef NEGM_UPD
  #define NEGM_UPD() do{}while(0)
  #define CINIT0(C,t) do{const int dist_=wc2+(NT-4-(t)); binit1(C,dist_,dtl-64*dist_);}while(0)
  #define CINIT1(C,t) do{const int dist_=wc2+(NT-4-(t)); binit1(C,dist_,dtl-64*dist_+32);}while(0)
  #define CSRC(C) C
  #define CPOST(C0,C1) bpost(C0,C1,mhat)
  #define ENDW(tt) do{ if((tt)+3<NT){WAIT_BAR(3);} else if((tt)+2<NT){WAIT_BAR(2);} else {WAIT_BAR(0);} }while(0)
  for(;t+1<NT;t+=2){
    STEP(pB0,pB1,pA0,pA1,t,(t+3<NT),(t+1<NT),(t+1<NT));       ENDW(t);   RESC(); ROT();
    STEP(pA0,pA1,pB0,pB1,t+1,(t+4<NT),(t+2<NT),(t+2<NT));     ENDW(t+1); RESC(); ROT();
  }
  STEP(pB0,pB1,pA0,pA1,NT-1,false,false,false); RESC();
  { float sacc=pB0[0]+pB0[1]; _Pragma("unroll") for(int r=2;r<16;++r)sacc+=pB0[r]; _Pragma("unroll") for(int r=0;r<16;++r)sacc+=pB1[r]; l_reg+=sacc;
    pw0=(u32x4){PKW(pB0,0),PKW(pB0,2),PKW(pB0,4),PKW(pB0,6)};pw1=(u32x4){PKW(pB0,8),PKW(pB0,10),PKW(pB0,12),PKW(pB0,14)};pw2=(u32x4){PKW(pB1,0),PKW(pB1,2),PKW(pB1,4),PKW(pB1,6)};pw3=(u32x4){PKW(pB1,8),PKW(pB1,10),PKW(pB1,12),PKW(pB1,14)};
    SBAR(); pv(o,vb0+2*sl_cur,PAF(0),PAF(1),PAF(2),PAF(3)); }
  #undef PKW
  #undef PAF
  #undef VFR
  #undef PIN
  #undef MX3
  #undef GAPA
  #undef GAPB2
  #undef VRD2
  #undef EX
  #undef VRD
  #undef KRD
  #undef STEP
  #undef ENDW
  {auto rr=__builtin_amdgcn_permlane32_swap(__float_as_uint(l_reg),__float_as_uint(l_reg),false,false);l_reg=__uint_as_float(rr[0])+__uint_as_float(rr[1]);}
  if(hi==0)wsf[32+r32]=l_reg;asm volatile("s_waitcnt lgkmcnt(0)":::"memory");
  float rli[16];
  #pragma unroll
  for(int r=0;r<16;++r)rli[r]=__builtin_amdgcn_rcpf(wsf[32+crow(r,hi)]);
  bf16*Ow=O+(rowbase+q0+wid*QBLK)*PO+ocol;
  { bf16*stg=(bf16*)(shm+LDS_OST)+wid*2048;
    #pragma unroll
    for(int hh=0;hh<2;++hh){
      #pragma unroll
      for(int r=0;r<16;++r){const int orow=crow(r,hi);
        #pragma unroll
        for(int d0=0;d0<2;++d0)stg[orow*64+d0*32+r32]=__float2bfloat16(o[2*hh+d0][r]*rli[r]);}
      asm volatile("s_waitcnt lgkmcnt(0)":::"memory");
      #pragma unroll
      for(int i=0;i<4;++i){const int row=i*8+(lane>>3),ch=lane&7; const u32x4 v=*(const u32x4*)(stg+row*64+ch*8); ATTN_STORE16(Ow+(long)row*PO+hh*64+ch*8,v);}
      asm volatile("s_waitcnt lgkmcnt(0)":::"memory"); } }
  asm volatile("s_waitcnt lgkmcnt(0)\n\ts_barrier":::"memory");
  #undef DMA_K
  #undef DMA_V
  #undef QR
  #undef CINIT0
  #undef CINIT1
  #undef CSRC
  #undef CPOST
  #undef NEGM_UPD
  #undef START
  #undef RESC
  #undef ROT
}
constexpr int ATTN_LDS_BYTES=LDS_BYTES+1024;
#undef SBAR
#undef WAIT_BAR
}

namespace cg = cooperative_groups;
constexpr int NWAVES = 8, NTHREADS = 512;
constexpr int MTOT = 33280, MPR = 32768, MSA = 512;
constexpr int DM = 1024, TP = 4096, TS = 16, NBP = 8, NBS = 32, PAST = 4096;
constexpr float EPS = 1e-6f, LOG2E = 1.4426950408889634f;
constexpr float LAM_INIT = 0.2f;
constexpr size_t O_YP = 0, O_YS = 33554432, O_KP = 34078720, O_VP = 50855936, O_CP = 67633152, O_MK = 67756032, O_MV = 68804608, O_KS = 69853184, O_VS = 70115328, O_CS = 70377472, O_END = 70868992;
constexpr size_t MiB = 1u << 20;
constexpr size_t WS_RS0 = 1 * MiB, WS_RSM = 1 * MiB + 256 * 1024, WS_SSP1 = 2 * MiB, WS_SSP2 = 5 * MiB, WS_QSS = 8 * MiB;
constexpr size_t WS_W1T = 12 * MiB, WS_WOT = 17 * MiB, WS_WMQT = 19 * MiB, WS_WMKVT = 20 * MiB, WS_WMOT = 22 * MiB, WS_WF1T = 23 * MiB, WS_WF2T = 31 * MiB;
constexpr size_t WS_MEMB = 40 * MiB, WS_MKB = 44 * MiB, WS_MVB = 54 * MiB;
constexpr size_t WS_XB = 64 * MiB, WS_Q = 130 * MiB, WS_KB = 163 * MiB, WS_VB = 196 * MiB, WS_C = 229 * MiB, WS_A3 = 294 * MiB, WS_OA = 360 * MiB;
constexpr size_t WS_X1 = 490 * MiB, WS_X1B = 620 * MiB, WS_QM = 685 * MiB, WS_OM = 718 * MiB, WS_X2B = 751 * MiB, WS_END = 816 * MiB;
constexpr size_t WS_PART = 426 * MiB;
#ifndef XREP
#define XREP 1
#endif
#ifndef SREP
#define SREP 1
#endif
constexpr int SNP = 4;
constexpr size_t WS_U = 64 * MiB;
static_assert(WS_U + (size_t)MTOT * 4096 * 2 <= WS_OA, "U overlay");
#ifndef PHMASK
#define PHMASK 0xFFFFF
#endif
#define PH(k) ((PHMASK >> (k)) & 1)
constexpr int LDS_BYTES = 147456;

#define LAS __attribute__((address_space(3)))
typedef unsigned short bf16;
typedef unsigned v4u __attribute__((ext_vector_type(4)));
typedef unsigned v2u __attribute__((ext_vector_type(2)));
typedef float f32x4 __attribute__((ext_vector_type(4)));
__device__ __forceinline__ unsigned f2bf(float f) { unsigned u = __builtin_bit_cast(unsigned, f); return (u + 0x7fffu + ((u >> 16) & 1u)) >> 16; }
__device__ __forceinline__ unsigned pk2(float lo, float hi) { return f2bf(lo) | (f2bf(hi) << 16); }
__device__ __forceinline__ float bf2f(unsigned h) { return __builtin_bit_cast(float, h << 16); }
__device__ __forceinline__ float wave_sum(float v) {
#pragma unroll
    for (int o = 1; o < 64; o <<= 1) v += __shfl_xor(v, o);
    return v;
}
__device__ __forceinline__ void unpack8(const v4u w, float* f) { f[0] = bf2f(w.x & 0xffffu); f[1] = bf2f(w.x >> 16); f[2] = bf2f(w.y & 0xffffu); f[3] = bf2f(w.y >> 16); f[4] = bf2f(w.z & 0xffffu); f[5] = bf2f(w.z >> 16); f[6] = bf2f(w.w & 0xffffu); f[7] = bf2f(w.w >> 16); }

struct Params { const float* in[31]; float* out; unsigned char* ws; };
enum { I_XP = 0, I_XS, I_CK, I_CV, I_CC, I_CMK, I_CMV, I_MEM, I_REL, I_GMIX, I_WIN, I_GQ, I_GK, I_LAM, I_GSUB, I_WCONV, I_BCONV, I_LNG, I_LNB, I_WOUT, I_GCROSS, I_GMEM, I_WMQ, I_WMK, I_WMV, I_GMQ, I_GMK, I_WMO, I_GFFN, I_WFF1, I_WFF2 };

__device__ __forceinline__ int rel_bucket(int rel) {
    const int n = rel < 0 ? -rel : rel; const int lg = n < 8 ? n : min(15, 2 + (31 - __clz(n * n)));
    return (rel > 0 ? 16 : 0) + lg;
}
#define RDL(x, d) __builtin_bit_cast(float, __builtin_amdgcn_readlane(__builtin_bit_cast(int, (x)), (d)))
__device__ __forceinline__ float compute_lam(const float* lv, int lane) {
    const float a = wave_sum(lv[lane] * lv[64 + lane]), b = wave_sum(lv[128 + lane] * lv[192 + lane]);
    return __expf(a) - __expf(b) + LAM_INIT;
}

__device__ __forceinline__ void p0_transpose_item(const float* W, int K, int N, const float* gain, bf16* WT, int dst_row0, LAS float* scr, int k0, int n0, int lane) {
    float wv[32];
#pragma unroll
    for (int i = 0; i < 32; ++i) wv[i] = W[(size_t)(k0 + 2 * i + (lane >> 5)) * N + n0 + (lane & 31)];
#pragma unroll
    for (int i = 0; i < 32; ++i) { const int kk = 2 * i + (lane >> 5); const float g = gain ? gain[k0 + kk] : 1.0f; scr[kk * 33 + (lane & 31)] = wv[i] * g; }
    asm volatile("s_waitcnt lgkmcnt(0)" ::: "memory");
    const int c = lane & 7;
#pragma unroll
    for (int j = 0; j < 4; ++j) { const int n = (lane >> 3) + 8 * j; const LAS float* s = scr + (8 * c) * 33 + n;
        v4u o; o.x = pk2(s[0 * 33], s[1 * 33]); o.y = pk2(s[2 * 33], s[3 * 33]); o.z = pk2(s[4 * 33], s[5 * 33]); o.w = pk2(s[6 * 33], s[7 * 33]);
        *(v4u*)(WT + (size_t)(dst_row0 + n) * K + k0 + 8 * c) = o; }
    asm volatile("s_waitcnt lgkmcnt(0)" ::: "memory");
}
__device__ __forceinline__ int w1_row(int a) {
    if (a < 1024) { const int pn = a >> 8, wc = (a >> 6) & 3, bj = (a >> 5) & 1; return 256 * pn + 128 * bj + 32 * wc; }
    if (a < 1536) return a;
    const int g = a >= 2048, ch = a - (g ? 2048 : 1536), t = ch >> 7, wc = (ch >> 5) & 3; return 1536 + 256 * t + 128 * g + 32 * wc;
}
template <int NR> __device__ __forceinline__ void rows_to_bf16_rs(const float* x0, bf16* o0, float* rs0, size_t row_step, int lane) {
    f32x4 v[NR][4];
#pragma unroll
    for (int i = 0; i < NR; ++i)
#pragma unroll
        for (int j = 0; j < 4; ++j) v[i][j] = __builtin_nontemporal_load((const f32x4*)(x0 + (size_t)i * row_step * 1024) + lane + 64 * j);
#pragma unroll
    for (int i = 0; i < NR; ++i) { float s = 0.f;
#pragma unroll
        for (int j = 0; j < 4; ++j) s += (v[i][j].x * v[i][j].x + v[i][j].y * v[i][j].y) + (v[i][j].z * v[i][j].z + v[i][j].w * v[i][j].w);
        s = wave_sum(s);
        unsigned long long* o8 = (unsigned long long*)(o0 + (size_t)i * row_step * 1024) + lane;
#pragma unroll
        for (int j = 0; j < 4; ++j) o8[64 * j] = (unsigned long long)pk2(v[i][j].x, v[i][j].y) | ((unsigned long long)pk2(v[i][j].z, v[i][j].w) << 32);
        if (lane == 0) rs0[(size_t)i * row_step] = 1.0f / sqrtf(s * (1.0f / 1024.0f) + EPS); }
}


#define XB_TMO      128
#define XB_XCNT(j)  (256  + 64 * (j))
#define XB_XSUB(j)  (1280 + 64 * (j))
#define XB_XGEN(j)  (2304 + 64 * (j))
#define XB_TOP      3328
#define XB_TOPGEN   3392
#define XCD_BAR_WORDS 3456
#define XB_SPIN_CAP (1u << 18)

__device__ __forceinline__ unsigned xb_ld(unsigned* p)              { return __hip_atomic_load(p, __ATOMIC_RELAXED, __HIP_MEMORY_SCOPE_AGENT); }
__device__ __forceinline__ unsigned xb_add(unsigned* p, unsigned v) { return __hip_atomic_fetch_add(p, v, __ATOMIC_RELAXED, __HIP_MEMORY_SCOPE_AGENT); }
__device__ __forceinline__ unsigned xb_xcc_id() { return (unsigned)__builtin_amdgcn_s_getreg((3 << 11) | 20) & 0xFu; }
#define XB_SPIN(cond, bar) do { unsigned _sp = 0; while (cond) { __builtin_amdgcn_s_sleep(1); \
    if ((++_sp & 255u) == 0u) { if (xb_ld(&(bar)[XB_TMO])) break; if (_sp > XB_SPIN_CAP) { atomicAdd(&(bar)[XB_TMO], 1u); break; } } } } while (0)

struct XcdBarrier {
    unsigned* bar; unsigned x;
    volatile LAS unsigned* st;
};

__device__ __forceinline__ XcdBarrier xcd_barrier_post(unsigned* bar, volatile LAS unsigned* st) {
    XcdBarrier b; b.bar = bar; b.x = xb_xcc_id(); b.st = st;
    if (threadIdx.x == 0) (void)xb_add(&bar[XB_XCNT(b.x)], 1u);
    return b;
}
__device__ __forceinline__ void xcd_barrier_complete(unsigned* bar, unsigned x, unsigned& nloc, unsigned& nx) {
    const unsigned G = gridDim.x * gridDim.y * gridDim.z;
    unsigned sum, cnt, mine, sp = 0u;
    for (;;) {
        sum = 0u; cnt = 0u; mine = 0u;
#pragma unroll
        for (unsigned j = 0; j < 16; ++j) { const unsigned c = xb_ld(&bar[XB_XCNT(j)]); sum += c; cnt += (c > 0u) ? 1u : 0u; mine = (j == x) ? c : mine; }
        if (sum == G) break;
        __builtin_amdgcn_s_sleep(1);
        if ((++sp & 255u) == 0u) { if (xb_ld(&bar[XB_TMO])) break; if (sp > XB_SPIN_CAP) { atomicAdd(&bar[XB_TMO], 1u); break; } }
    }
    nloc = mine > 0u ? mine : 1u; nx = cnt > 0u ? cnt : 1u;
}

__device__ __forceinline__ void xcd_barrier(const XcdBarrier& b) {
    asm volatile("s_waitcnt vmcnt(0)" ::: "memory");
    __syncthreads();
    if (threadIdx.x == 0) {
        unsigned* bar = b.bar;
        __builtin_amdgcn_s_waitcnt(0);
        unsigned nloc = b.st[0], nx = b.st[1];
        if (nloc == 0u) { xcd_barrier_complete(bar, b.x, nloc, nx); b.st[0] = nloc; b.st[1] = nx; }
        const unsigned old = xb_add(&bar[XB_XSUB(b.x)], 1u);
        const unsigned gen = old / nloc;
        if (old + 1u == (gen + 1u) * nloc) {
            __builtin_amdgcn_fence(__ATOMIC_RELEASE, "agent");
            asm volatile("s_waitcnt vmcnt(0)" ::: "memory");
            const unsigned og = xb_add(&bar[XB_TOP], 1u);
            const unsigned tg = og / nx;
            if (og + 1u == (tg + 1u) * nx) xb_add(&bar[XB_TOPGEN], 1u);
            else XB_SPIN(xb_ld(&bar[XB_TOPGEN]) == tg, bar);
            __builtin_amdgcn_fence(__ATOMIC_ACQUIRE, "agent");
            xb_add(&bar[XB_XGEN(b.x)], 1u);
            asm volatile("s_waitcnt vmcnt(0)" ::: "memory");
        } else {
            XB_SPIN(xb_ld(&bar[XB_XGEN(b.x)]) == gen, bar);
            __builtin_amdgcn_fence(__ATOMIC_ACQUIRE, "agent");
            asm volatile("s_waitcnt vmcnt(0)" ::: "memory");
        }
    }
    __syncthreads();
}


__device__ __forceinline__ void mk_row(int r, int lane, float* mko, const float* cmk, const float* gmk, const float* gmq, bf16* MKB) {
    f32x4 a, b;
    if (r < 2048) {
        float* mk = mko + (size_t)r * 512 + lane * 8; a = *(f32x4*)mk; b = *(f32x4*)(mk + 4);
        float ss = (a.x * a.x + a.y * a.y) + (a.z * a.z + a.w * a.w) + (b.x * b.x + b.y * b.y) + (b.z * b.z + b.w * b.w);
        ss += __shfl_xor(ss, 1); ss += __shfl_xor(ss, 2); ss += __shfl_xor(ss, 4); ss += __shfl_xor(ss, 8);
        const float rstd = 1.0f / sqrtf(ss * (1.0f / 128.0f) + EPS); const float* g = gmk + (lane & 15) * 8;
        a = a * *(const f32x4*)g * rstd; b = b * *(const f32x4*)(g + 4) * rstd;
        *(f32x4*)mk = a; *(f32x4*)(mk + 4) = b;
    } else { const float* mk = cmk + (size_t)(r - 2048) * 512 + lane * 8; a = *(const f32x4*)mk; b = *(const f32x4*)(mk + 4); }
    const float* gq = gmq + (lane & 15) * 8; a = a * *(const f32x4*)gq; b = b * *(const f32x4*)(gq + 4);
    v4u o; o.x = pk2(a.x, a.y); o.y = pk2(a.z, a.w); o.z = pk2(b.x, b.y); o.w = pk2(b.z, b.w);
    *(v4u*)(MKB + (size_t)r * 512 + lane * 8) = o;
}
__device__ __forceinline__ void mvt_item(int it, int lane, const float* mvp, const float* cmv, bf16* MVT) {
    const int kg = it & 7, head = (it >> 3) & 3, bb = it >> 5;
    const float* vsrc = (bb < 8 ? mvp + (size_t)bb * 256 * 512 : cmv + (size_t)(bb - 8) * 256 * 512) + (size_t)(32 * kg) * 512 + head * 128;
#pragma unroll 1
    for (int half = 0; half < 2; ++half) { const int e = lane + 64 * half; float v[32];
#pragma unroll
        for (int k = 0; k < 32; ++k) v[k] = vsrc[(size_t)k * 512 + e];
        bf16* dst = MVT + ((size_t)(bb * 4 + head) * 128 + e) * 256 + 32 * kg;
#pragma unroll
        for (int g = 0; g < 4; ++g) { v4u o; o.x = pk2(v[4 * g], v[4 * g + 1]); o.y = pk2(v[4 * g + 2], v[4 * g + 3]); o.z = pk2(v[16 + 4 * g], v[16 + 4 * g + 1]); o.w = pk2(v[16 + 4 * g + 2], v[16 + 4 * g + 3]); *(v4u*)(dst + 8 * g) = o; }
    }
}

__device__ __forceinline__ bool static_unit0(int nM, int nN, int G, int c, int& pm, int& pn) {
    const int nwg = nM * nN; if (c >= nwg) return false;
    const int q = nwg / 8, r = nwg % 8, xcd = c % 8, off = c / 8; const int wgid = (xcd < r ? xcd * (q + 1) : r * (q + 1) + (xcd - r) * q) + off;
    const int nig = 8 * nN, gid = wgid / nig, fm = gid * 8, gsz = (nM - fm) < 8 ? (nM - fm) : 8;
    pm = fm + ((wgid % nig) % gsz); pn = (wgid % nig) / gsz; return true;
}

typedef short s16x4 __attribute__((ext_vector_type(4)));
constexpr int PART_STRIDE = 132;
template <int NS> __device__ __forceinline__ void sample_attn_task(int b, int h, int sp, int lane_in, int wave, LAS unsigned char* lds, const bf16* QB, const float* ck, const float* cv, const float* kn, const float* vn, const float* rel, float* PART) {
    int lane = lane_in; asm volatile("" : "+v"(lane));
    const int c = lane & 15, g = lane >> 4;
    const int T0 = (257 * sp) / NS, T1 = (257 * (sp + 1)) / NS;
#if QEXP
    const int tmask_ = (PART == nullptr) ? 0 : -1; if (PART == nullptr) PART = (float*)QB + (490u << 18) - (130u << 18);
#endif
    pg8::bf16x8 qf[2][2];
#pragma unroll
    for (int m = 0; m < 2; ++m)
#pragma unroll
        for (int s2 = 0; s2 < 2; ++s2) qf[m][s2] = *(const pg8::bf16x8*)(QB + (size_t)(MPR + b * 16 + c) * 512 + (2 * h + m) * 64 + 32 * s2 + 8 * g);
    f32x4 O[2][8]; float mx[2], ls[2];
#pragma unroll
    for (int m = 0; m < 2; ++m) { mx[m] = -1e30f; ls[m] = 0.f;
#pragma unroll
        for (int et = 0; et < 8; ++et) O[m][et] = (f32x4){0.f, 0.f, 0.f, 0.f}; }
    const float* Kc = ck + (size_t)b * PAST * 512; const float* Kn = kn + (size_t)b * 16 * 512;
    const unsigned kl = (unsigned)(size_t)(lds + wave * 16384);
    const unsigned dA = (unsigned)((lane >> 5) * 2048 + (2 * h + ((lane >> 4) & 1)) * 256), dP = (unsigned)((lane & 15) ^ (lane >> 5));
    const unsigned rA = kl + (unsigned)(2 * c * 256), rX = (unsigned)(c ^ (2 * g));
    const float* Vc = cv + (size_t)b * PAST * 512; const float* Vn = vn + (size_t)b * 16 * 512;
    const unsigned voff = (unsigned)((4 * g * 512 + h * 128 + 4 * c) * 4);
    f32x4 rk[2][2][2]; f32x4 rvA[2][4], rvB[2][4];
#define SA_VLD(dst, base, IMM) asm volatile("global_load_dwordx4 %0, %1, %2 offset:" #IMM : "=&v"(dst) : "v"(voff), "s"(base) : "memory")
#define SA_ISSUE(rv, buf, tt) do { const int tq_ = (tt); const float* kb_ = tq_ < 256 ? Kc + (size_t)(16 * tq_) * 512 : Kn; const char* vb_ = (const char*)(tq_ < 256 ? Vc + (size_t)(16 * tq_) * 512 : Vn); const char* vb2_ = vb_ + 4096; \
        SA_VLD(rv[0][0], vb_, 0); SA_VLD(rv[0][1], vb_, 2048); SA_VLD(rv[0][2], vb2_, 0); SA_VLD(rv[0][3], vb2_, 2048); \
        SA_VLD(rv[1][0], vb_, 256); SA_VLD(rv[1][1], vb_, 2304); SA_VLD(rv[1][2], vb2_, 256); SA_VLD(rv[1][3], vb2_, 2304); \
        _Pragma("unroll") for (int i = 0; i < 8; ++i) attn2::glds16s<0>(kb_, dA + i * 4096 + ((dP ^ (2 * i)) << 4), (unsigned)__builtin_amdgcn_readfirstlane(kl + (buf) * 8192 + i * 1024)); } while (0)
    float relv = rel[(lane & 31) * 4 + h];
    SA_ISSUE(rvA, 0, T0); SA_ISSUE(rvB, 1, min(T0 + 1, T1 - 1));
#pragma unroll
    for (int m = 0; m < 2; ++m)
#pragma unroll
        for (int s2 = 0; s2 < 2; ++s2) asm volatile("" : "+v"(qf[m][s2]));
    asm volatile("" : "+v"(relv));
    const float far = __builtin_bit_cast(float, __builtin_amdgcn_readlane(__builtin_bit_cast(int, relv), 15));
#define SA_STEP(rv, buf, tt, PADCHK) do { const int t_ = (tt); \
        pg8::bf16x8 kf[2][2]; s16x4 vf[8]; \
        asm volatile("s_waitcnt vmcnt(16)" : "+v"(rv[0][0]), "+v"(rv[0][1]), "+v"(rv[0][2]), "+v"(rv[0][3]), "+v"(rv[1][0]), "+v"(rv[1][1]), "+v"(rv[1][2]), "+v"(rv[1][3]) :: "memory");     \
        _Pragma("unroll") for (int m = 0; m < 2; ++m) _Pragma("unroll") for (int s2 = 0; s2 < 2; ++s2) _Pragma("unroll") for (int e = 0; e < 2; ++e) rk[m][s2][e] = *(const LAS f32x4*)(size_t)(rA + (buf) * 8192 + m * 256 + ((rX ^ (8 * s2 + e)) << 4)); \
        _Pragma("unroll") for (int m = 0; m < 2; ++m) _Pragma("unroll") for (int s2 = 0; s2 < 2; ++s2) { v4u w; w.x = attn_body::cvtpk_s(rk[m][s2][0].x, rk[m][s2][0].y); w.y = attn_body::cvtpk_s(rk[m][s2][0].z, rk[m][s2][0].w); w.z = attn_body::cvtpk_s(rk[m][s2][1].x, rk[m][s2][1].y); w.w = attn_body::cvtpk_s(rk[m][s2][1].z, rk[m][s2][1].w); kf[m][s2] = __builtin_bit_cast(pg8::bf16x8, w); } \
        _Pragma("unroll") for (int et = 0; et < 8; ++et) { v2u w; w.x = attn_body::cvtpk_s(rv[et >> 2][0][et & 3], rv[et >> 2][1][et & 3]); w.y = attn_body::cvtpk_s(rv[et >> 2][2][et & 3], rv[et >> 2][3][et & 3]); vf[et] = __builtin_bit_cast(s16x4, w); } \
        asm volatile("s_waitcnt lgkmcnt(0)" :: "v"(vf[0]), "v"(vf[1]), "v"(vf[2]), "v"(vf[3]), "v"(vf[4]), "v"(vf[5]), "v"(vf[6]), "v"(vf[7]) : "memory");      \
        SA_ISSUE(rv, buf, min(t_ + 2, T1 - 1)); \
        const bool near = t_ >= 244;                       \
        _Pragma("unroll") for (int m = 0; m < 2; ++m) { \
            f32x4 sc = (f32x4){0.f, 0.f, 0.f, 0.f}; \
            sc = __builtin_amdgcn_mfma_f32_16x16x32_bf16(kf[m][0], qf[m][0], sc, 0, 0, 0); sc = __builtin_amdgcn_mfma_f32_16x16x32_bf16(kf[m][1], qf[m][1], sc, 0, 0, 0); \
            if (near) { _Pragma("unroll") for (int r = 0; r < 4; ++r) sc[r] += (__builtin_bit_cast(float, __builtin_amdgcn_ds_bpermute(rel_bucket(16 * t_ + 4 * g + r - (PAST + c)) * 4, __builtin_bit_cast(int, relv))) - far) * LOG2E; } \
            if (PADCHK) { const bool pad_ = t_ >= T1;         \
                _Pragma("unroll") for (int r = 0; r < 4; ++r) sc[r] = pad_ ? -1e30f : sc[r]; } \
            float tm = fmaxf(fmaxf(sc.x, sc.y), fmaxf(sc.z, sc.w)); tm = fmaxf(tm, __shfl_xor(tm, 16)); tm = fmaxf(tm, __shfl_xor(tm, 32)); \
            if (__any(tm > mx[m])) { const float mn = fmaxf(mx[m], tm), al = __builtin_amdgcn_exp2f(mx[m] - mn); mx[m] = mn; ls[m] *= al; \
                _Pragma("unroll") for (int et = 0; et < 8; ++et) O[m][et] *= al; } \
            float ps = 0.f; \
            _Pragma("unroll") for (int r = 0; r < 4; ++r) { sc[r] = __builtin_amdgcn_exp2f(sc[r] - mx[m]); ps += sc[r]; } \
            ls[m] += ps; \
            v2u pw; pw.x = attn_body::cvtpk_s(sc.x, sc.y); pw.y = attn_body::cvtpk_s(sc.z, sc.w); const s16x4 pb = __builtin_bit_cast(s16x4, pw); \
            _Pragma("unroll") for (int et = 0; et < 8; ++et) O[m][et] = __builtin_amdgcn_mfma_f32_16x16x16bf16_1k(vf[et], pb, O[m][et], 0, 0, 0); } \
    } while (0)
#pragma unroll 1
    for (int t = T0; t < T1; t += 2) {
        SA_STEP(rvA, 0, t, false);
        SA_STEP(rvB, 1, t + 1, true);
    }
    asm volatile("s_waitcnt vmcnt(0)" : "+v"(rvA[0][0]), "+v"(rvA[0][1]), "+v"(rvA[0][2]), "+v"(rvA[0][3]), "+v"(rvA[1][0]), "+v"(rvA[1][1]), "+v"(rvA[1][2]), "+v"(rvA[1][3]) :: "memory");
    asm volatile("" : "+v"(rvB[0][0]), "+v"(rvB[0][1]), "+v"(rvB[0][2]), "+v"(rvB[0][3]), "+v"(rvB[1][0]), "+v"(rvB[1][1]), "+v"(rvB[1][2]), "+v"(rvB[1][3]) :: "memory");
#undef SA_STEP
#undef SA_ISSUE
#undef SA_VLD
#pragma unroll
    for (int m = 0; m < 2; ++m) { float l = ls[m]; l += __shfl_xor(l, 16); l += __shfl_xor(l, 32);
        float* pd = PART + ((size_t)(((b * 4 + h) * NS + sp) * 2 + m) * 16 + c) * PART_STRIDE;
#pragma unroll
        for (int hf = 0; hf < 2; ++hf)
#pragma unroll
            for (int r = 0; r < 4; ++r) *(f32x4*)(pd + 64 * hf + 16 * g + 4 * r) = (f32x4){O[m][4 * hf][r], O[m][4 * hf + 1][r], O[m][4 * hf + 2][r], O[m][4 * hf + 3][r]};
        if (g == 0) { pd[128] = mx[m]; pd[129] = l; } }
}

__device__ __forceinline__ void conv_finish(f32x4 (&acc)[4][2], int r0, int ch0, const float* lng, const float* lnb, bf16* A3) {
    const f32x4 g0 = *(const f32x4*)(lng + ch0), g1 = *(const f32x4*)(lng + ch0 + 4), bb0 = *(const f32x4*)(lnb + ch0), bb1 = *(const f32x4*)(lnb + ch0 + 4);
#pragma unroll
    for (int o = 0; o < 4; ++o) {
        f32x4 a0 = acc[o][0], a1 = acc[o][1];
        const float mean = wave_sum((a0.x + a0.y) + (a0.z + a0.w) + (a1.x + a1.y) + (a1.z + a1.w)) * (1.0f / 512.0f);
        a0 = a0 - mean; a1 = a1 - mean;
        const float rstd = 1.0f / sqrtf(wave_sum((a0.x * a0.x + a0.y * a0.y) + (a0.z * a0.z + a0.w * a0.w) + (a1.x * a1.x + a1.y * a1.y) + (a1.z * a1.z + a1.w * a1.w)) * (1.0f / 512.0f) + EPS);
        a0 = a0 * rstd * g0 + bb0; a1 = a1 * rstd * g1 + bb1;
        float y[8] = {a0.x, a0.y, a0.z, a0.w, a1.x, a1.y, a1.z, a1.w};
#pragma unroll
        for (int e = 0; e < 8; ++e) y[e] = y[e] / (1.0f + __expf(-y[e]));
        v4u w; w.x = pk2(y[0], y[1]); w.y = pk2(y[2], y[3]); w.z = pk2(y[4], y[5]); w.w = pk2(y[6], y[7]);
        *(v4u*)(A3 + (size_t)(r0 + o) * 1024 + 512 + ch0) = w;
    }
}
constexpr int CONV_TAPS_BYTES = 31 * 2048, CONV_ROWS_OFF = CONV_TAPS_BYTES;
__device__ __forceinline__ void conv_item_prompt(int ct, int tid_in, const bf16* CB, LAS unsigned char* lds, const float* bconv, const float* lng, const float* lnb, bf16* A3) {
    int tid = tid_in; asm volatile("" : "+v"(tid));
    const int lane = tid & 63, wave = __builtin_amdgcn_readfirstlane(tid >> 6);
    const int r0b = ct * 32, b = r0b >> 12, t0b = r0b & 4095;
    const bf16* cbase = CB + (size_t)(b * 4096) * 512;
#pragma unroll
    for (int q = 0; q < 8; ++q) { const int i = tid + 512 * q; if (i < 62 * 64) { const int j = i >> 6, tt = t0b - 30 + j; const unsigned msk = tt >= 0 ? 0xffffffffu : 0u;
        v4u v = *(const v4u*)(cbase + (size_t)(tt >= 0 ? tt : 0) * 512 + (i & 63) * 8); v.x &= msk; v.y &= msk; v.z &= msk; v.w &= msk;
        *(LAS v4u*)(lds + CONV_ROWS_OFF + (size_t)i * 16) = v; } }
    __syncthreads();
    const int ch0 = lane * 8, r0 = r0b + 4 * wave;
    f32x4 acc[4][2], W[4][2];
    { const f32x4 b0 = *(const f32x4*)(bconv + ch0), b1 = *(const f32x4*)(bconv + ch0 + 4);
#pragma unroll
        for (int o = 0; o < 4; ++o) { acc[o][0] = b0; acc[o][1] = b1; W[o][0] = (f32x4){0.f, 0.f, 0.f, 0.f}; W[o][1] = (f32x4){0.f, 0.f, 0.f, 0.f}; } }
    const LAS unsigned char* crow = lds + CONV_ROWS_OFF + (size_t)(4 * wave) * 1024 + lane * 16; const LAS unsigned char* wl = lds + lane * 16;
#pragma unroll 1
    for (int k = 0; k < 9; ++k) {
#pragma unroll
        for (int rr = 0; rr < 4; ++rr) { const int i = 4 * k + rr;
            f32x4 c0 = (f32x4){0.f, 0.f, 0.f, 0.f}, c1 = c0;
            if (i < 34) { float f[8]; unpack8(*(const LAS v4u*)(crow + (size_t)i * 1024), f); c0 = (f32x4){f[0], f[1], f[2], f[3]}; c1 = (f32x4){f[4], f[5], f[6], f[7]}; }
            if (i < 31) { W[rr][0] = *(const LAS f32x4*)(wl + (size_t)i * 2048); W[rr][1] = *(const LAS f32x4*)(wl + (size_t)i * 2048 + 1024); } else { W[rr][0] = (f32x4){0.f, 0.f, 0.f, 0.f}; W[rr][1] = W[rr][0]; }
#pragma unroll
            for (int o = 0; o < 4; ++o) { acc[o][0] += W[(rr - o) & 3][0] * c0; acc[o][1] += W[(rr - o) & 3][1] * c1; } }
    }
    conv_finish(acc, r0, ch0, lng, lnb, A3);
}
__device__ __forceinline__ void conv_task_sample(int task, int lane_in, const bf16* CB, const float* cc, const float* wconv, const float* bconv, const float* lng, const float* lnb, bf16* A3) {
    int lane = lane_in; asm volatile("" : "+v"(lane));
    const int r0 = MPR + task * 4, b = (r0 - MPR) >> 4, t0 = (r0 - MPR) & 15, rb = MPR + b * 16, ch0 = lane * 8;
    f32x4 acc[4][2], W[4][2];
    { const f32x4 b0 = *(const f32x4*)(bconv + ch0), b1 = *(const f32x4*)(bconv + ch0 + 4);
#pragma unroll
        for (int o = 0; o < 4; ++o) { acc[o][0] = b0; acc[o][1] = b1; W[o][0] = (f32x4){0.f, 0.f, 0.f, 0.f}; W[o][1] = (f32x4){0.f, 0.f, 0.f, 0.f}; } }
    const bf16* cbase = CB + (size_t)rb * 512 + ch0; const float* ccb = cc + (size_t)(b * 30 + 30) * 512 + ch0; const float* wb = wconv + ch0;
#pragma unroll 1
    for (int k = 0; k < 9; ++k) {
#pragma unroll
        for (int rr = 0; rr < 4; ++rr) { const int i = 4 * k + rr, tt = t0 - 30 + i;
            f32x4 c0 = (f32x4){0.f, 0.f, 0.f, 0.f}, c1 = c0;
            if (i < 34) { if (tt >= 0) { float f[8]; unpack8(*(const v4u*)(cbase + (size_t)tt * 512), f); c0 = (f32x4){f[0], f[1], f[2], f[3]}; c1 = (f32x4){f[4], f[5], f[6], f[7]}; } else { c0 = *(const f32x4*)(ccb + (ptrdiff_t)tt * 512); c1 = *(const f32x4*)(ccb + (ptrdiff_t)tt * 512 + 4); } }
            if (i < 31) { W[rr][0] = *(const f32x4*)(wb + i * 512); W[rr][1] = *(const f32x4*)(wb + i * 512 + 4); } else { W[rr][0] = (f32x4){0.f, 0.f, 0.f, 0.f}; W[rr][1] = W[rr][0]; }
#pragma unroll
            for (int o = 0; o < 4; ++o) { acc[o][0] += W[(rr - o) & 3][0] * c0; acc[o][1] += W[(rr - o) & 3][1] * c1; } }
    }
    conv_finish(acc, r0, ch0, lng, lnb, A3);
}

#define XATTN_GROUP(qrow, od, g, KLD, VLD) do { \
    pg8::bf16x8 qf[4]; float ss = 0.f; \
    _Pragma("unroll") for (int s4 = 0; s4 < 4; ++s4) { const v4u w = *(const v4u*)((qrow) + 32 * s4 + 8 * (g)); qf[s4] = __builtin_bit_cast(pg8::bf16x8, w); float f[8]; unpack8(w, f); \
        _Pragma("unroll") for (int e = 0; e < 8; ++e) ss += f[e] * f[e]; } \
    ss += __shfl_xor(ss, 16); ss += __shfl_xor(ss, 32); \
    const float qs = (1.0f / sqrtf(ss * (1.0f / 128.0f) + EPS)) * (0.08838834764831845f * LOG2E); \
    f32x4 Oacc[8]; float mx = -1e30f, l = 0.f; \
    _Pragma("unroll") for (int et = 0; et < 8; ++et) Oacc[et] = (f32x4){0.f, 0.f, 0.f, 0.f}; \
    _Pragma("unroll 1") for (int ch = 0; ch < 4; ++ch) {        \
        f32x4 st[4]; float cm = -1e30f; \
        _Pragma("unroll") for (int kt = 0; kt < 4; ++kt) { f32x4 acc = (f32x4){0.f, 0.f, 0.f, 0.f}; \
            _Pragma("unroll") for (int s4 = 0; s4 < 4; ++s4) { const pg8::bf16x8 kf = KLD(4 * ch + kt, s4); acc = __builtin_amdgcn_mfma_f32_16x16x32_bf16(kf, qf[s4], acc, 0, 0, 0); } \
            st[kt] = acc * qs; cm = fmaxf(cm, fmaxf(fmaxf(st[kt].x, st[kt].y), fmaxf(st[kt].z, st[kt].w))); } \
        cm = fmaxf(cm, __shfl_xor(cm, 16)); cm = fmaxf(cm, __shfl_xor(cm, 32)); \
        const float mn = fmaxf(mx, cm), al = __builtin_amdgcn_exp2f(mx - mn); mx = mn; l *= al; \
        _Pragma("unroll") for (int et = 0; et < 8; ++et) Oacc[et] *= al; \
        pg8::bf16x8 pb[2]; \
        _Pragma("unroll") for (int kp = 0; kp < 2; ++kp) { f32x4 p0 = st[2 * kp], p1 = st[2 * kp + 1]; \
            _Pragma("unroll") for (int e = 0; e < 4; ++e) { p0[e] = __builtin_amdgcn_exp2f(p0[e] - mx); p1[e] = __builtin_amdgcn_exp2f(p1[e] - mx); l += p0[e] + p1[e]; } \
            v4u w; w.x = attn_body::cvtpk_s(p0.x, p0.y); w.y = attn_body::cvtpk_s(p0.z, p0.w); w.z = attn_body::cvtpk_s(p1.x, p1.y); w.w = attn_body::cvtpk_s(p1.z, p1.w); pb[kp] = __builtin_bit_cast(pg8::bf16x8, w); } \
        _Pragma("unroll") for (int et = 0; et < 8; ++et) \
            _Pragma("unroll") for (int kp = 0; kp < 2; ++kp) { const pg8::bf16x8 vf = VLD(et, 2 * ch + kp); Oacc[et] = __builtin_amdgcn_mfma_f32_16x16x32_bf16(vf, pb[kp], Oacc[et], 0, 0, 0); } \
    } \
    l += __shfl_xor(l, 16); l += __shfl_xor(l, 32); const float il = 1.0f / l; \
    _Pragma("unroll") for (int et = 0; et < 8; ++et) { v2u w; w.x = attn_body::cvtpk_s(Oacc[et].x * il, Oacc[et].y * il); w.y = attn_body::cvtpk_s(Oacc[et].z * il, Oacc[et].w * il); *(v2u*)((od) + 16 * et) = w; } \
} while (0)
#define XATTN_GROUP2(qrow0, qrow1, od0, od1, g, KLD, VLD) do { \
    pg8::bf16x8 qf[2][4]; float qs[2]; \
    _Pragma("unroll") for (int u = 0; u < 2; ++u) { float ss = 0.f; const bf16* qrow_ = u ? (qrow1) : (qrow0); \
        _Pragma("unroll") for (int s4 = 0; s4 < 4; ++s4) { const v4u w = *(const v4u*)(qrow_ + 32 * s4 + 8 * (g)); qf[u][s4] = __builtin_bit_cast(pg8::bf16x8, w); float f[8]; unpack8(w, f); \
            _Pragma("unroll") for (int e = 0; e < 8; ++e) ss += f[e] * f[e]; } \
        ss += __shfl_xor(ss, 16); ss += __shfl_xor(ss, 32); \
        qs[u] = (1.0f / sqrtf(ss * (1.0f / 128.0f) + EPS)) * (0.08838834764831845f * LOG2E); } \
    f32x4 Oacc[2][8]; float mx[2] = {-1e30f, -1e30f}, l[2] = {0.f, 0.f}; \
    _Pragma("unroll") for (int u = 0; u < 2; ++u) _Pragma("unroll") for (int et = 0; et < 8; ++et) Oacc[u][et] = (f32x4){0.f, 0.f, 0.f, 0.f}; \
    _Pragma("unroll 1") for (int ch = 0; ch < 4; ++ch) {        \
        f32x4 st[2][4]; float cm[2] = {-1e30f, -1e30f}; \
        _Pragma("unroll") for (int kt = 0; kt < 4; ++kt) { f32x4 acc0 = (f32x4){0.f, 0.f, 0.f, 0.f}, acc1 = acc0; \
            _Pragma("unroll") for (int s4 = 0; s4 < 4; ++s4) { const pg8::bf16x8 kf = KLD(4 * ch + kt, s4); acc0 = __builtin_amdgcn_mfma_f32_16x16x32_bf16(kf, qf[0][s4], acc0, 0, 0, 0); acc1 = __builtin_amdgcn_mfma_f32_16x16x32_bf16(kf, qf[1][s4], acc1, 0, 0, 0); } \
            st[0][kt] = acc0 * qs[0]; st[1][kt] = acc1 * qs[1]; \
            cm[0] = fmaxf(cm[0], fmaxf(fmaxf(st[0][kt].x, st[0][kt].y), fmaxf(st[0][kt].z, st[0][kt].w))); cm[1] = fmaxf(cm[1], fmaxf(fmaxf(st[1][kt].x, st[1][kt].y), fmaxf(st[1][kt].z, st[1][kt].w))); } \
        pg8::bf16x8 pb[2][2]; \
        _Pragma("unroll") for (int u = 0; u < 2; ++u) { \
            cm[u] = fmaxf(cm[u], __shfl_xor(cm[u], 16)); cm[u] = fmaxf(cm[u], __shfl_xor(cm[u], 32)); \
            const float mn = fmaxf(mx[u], cm[u]), al = __builtin_amdgcn_exp2f(mx[u] - mn); mx[u] = mn; l[u] *= al; \
            _Pragma("unroll") for (int et = 0; et < 8; ++et) Oacc[u][et] *= al; \
            _Pragma("unroll") for (int kp = 0; kp < 2; ++kp) { f32x4 p0 = st[u][2 * kp], p1 = st[u][2 * kp + 1]; \
                _Pragma("unroll") for (int e = 0; e < 4; ++e) { p0[e] = __builtin_amdgcn_exp2f(p0[e] - mx[u]); p1[e] = __builtin_amdgcn_exp2f(p1[e] - mx[u]); l[u] += p0[e] + p1[e]; } \
                v4u w; w.x = attn_body::cvtpk_s(p0.x, p0.y); w.y = attn_body::cvtpk_s(p0.z, p0.w); w.z = attn_body::cvtpk_s(p1.x, p1.y); w.w = attn_body::cvtpk_s(p1.z, p1.w); pb[u][kp] = __builtin_bit_cast(pg8::bf16x8, w); } } \
        _Pragma("unroll") for (int et = 0; et < 8; ++et) \
            _Pragma("unroll") for (int kp = 0; kp < 2; ++kp) { const pg8::bf16x8 vf = VLD(et, 2 * ch + kp); \
                Oacc[0][et] = __builtin_amdgcn_mfma_f32_16x16x32_bf16(vf, pb[0][kp], Oacc[0][et], 0, 0, 0); Oacc[1][et] = __builtin_amdgcn_mfma_f32_16x16x32_bf16(vf, pb[1][kp], Oacc[1][et], 0, 0, 0); } \
    } \
    _Pragma("unroll") for (int u = 0; u < 2; ++u) { float lt = l[u]; lt += __shfl_xor(lt, 16); lt += __shfl_xor(lt, 32); const float il = 1.0f / lt; bf16* od_ = u ? (od1) : (od0); \
        _Pragma("unroll") for (int et = 0; et < 8; ++et) { v2u w; w.x = attn_body::cvtpk_s(Oacc[u][et].x * il, Oacc[u][et].y * il); w.y = attn_body::cvtpk_s(Oacc[u][et].z * il, Oacc[u][et].w * il); *(v2u*)(od_ + 16 * et) = w; } } \
} while (0)
#ifndef DMASK
#define DMASK 0
#endif
#ifndef QEXP
#define QEXP 0
#endif
#ifndef SREP2
#define SREP2 1
#endif
#ifndef SMODE
#define SMODE 0
#endif
#ifndef SGAP
#define SGAP 4
#endif
#ifdef PROBE_A
#define GSYNC(k) do { if ((k) == 1) grid.sync(); else xcd_barrier(xbar); if (blockIdx.x == 0 && threadIdx.x == 0) ((unsigned long long*)(p.ws + 2048))[k] = __builtin_amdgcn_s_memrealtime(); } while (0)
#else
#define GSYNC(k) do { if ((k) == 1 && p.ws == nullptr) grid.sync(); xcd_barrier(xbar); } while (0)
#endif
__global__ void __launch_bounds__(NTHREADS, 2) fwd_kernel(Params p) {
    extern __shared__ __attribute__((aligned(16))) unsigned char lds_raw[];
    LAS unsigned char* lds = (LAS unsigned char*)lds_raw;
    cg::grid_group grid = cg::this_grid();
    const int tid = threadIdx.x, lane = tid & 63, wave = __builtin_amdgcn_readfirstlane(tid >> 6);
    const int G = gridDim.x, gw = blockIdx.x * NWAVES + wave, NGW = G * NWAVES;
    unsigned char* ws = p.ws; float* out = p.out;
    if (tid < 2) ((volatile LAS unsigned*)(lds + LDS_BYTES - 128))[tid] = 0u;
    __syncthreads();
    const XcdBarrier xbar = xcd_barrier_post((unsigned*)ws + 1024, (volatile LAS unsigned*)(lds + LDS_BYTES - 128));
#ifdef PROBE_A
    if (blockIdx.x == 0 && threadIdx.x == 0) ((unsigned long long*)(p.ws + 2048))[0] = __builtin_amdgcn_s_memrealtime();
#endif
    float* RS0 = (float*)(ws + WS_RS0); float* RSM = (float*)(ws + WS_RSM); float* SSP1 = (float*)(ws + WS_SSP1); float* SSP2 = (float*)(ws + WS_SSP2);
    bf16* W1T = (bf16*)(ws + WS_W1T); bf16* WOT = (bf16*)(ws + WS_WOT); bf16* WMQT = (bf16*)(ws + WS_WMQT); bf16* WMKVT = (bf16*)(ws + WS_WMKVT); bf16* WMOT = (bf16*)(ws + WS_WMOT);
    bf16* WF1T = (bf16*)(ws + WS_WF1T); bf16* WF2T = (bf16*)(ws + WS_WF2T); bf16* MEMB = (bf16*)(ws + WS_MEMB);
    bf16* XB = (bf16*)(ws + WS_XB); bf16* QB = (bf16*)(ws + WS_Q); bf16* KB = (bf16*)(ws + WS_KB); bf16* VB = (bf16*)(ws + WS_VB); bf16* CB = (bf16*)(ws + WS_C);
    bf16* A3 = (bf16*)(ws + WS_A3); float* OA = (float*)(ws + WS_OA); bf16* OAB = (bf16*)(ws + WS_OA); float* PART = (float*)(ws + WS_PART); float* PARTY = (float*)(ws + WS_PART + 16 * MiB); float* X1 = (float*)(ws + WS_X1); bf16* X1B = (bf16*)(ws + WS_X1B); bf16* QM = (bf16*)(ws + WS_QM); bf16* OM = (bf16*)(ws + WS_OM);
    bf16* X2B = (bf16*)(ws + WS_X2B); bf16* MKB = (bf16*)(ws + WS_MKB); bf16* MVT = (bf16*)(ws + WS_MVB); bf16* UB = (bf16*)(ws + WS_U);

    for (int rep_ = 0; rep_ < 1 + ((DMASK >> 0) & 1); ++rep_) { if (rep_) xcd_barrier(xbar);
    if constexpr (PH(0)) {
        LAS float* scr = (LAS float*)(lds + wave * 16384);
        constexpr int I1 = 16 * 80, I2 = 16 * 32, I3 = 16 * 16, I6 = 8 * 32, I7 = 16 * 128, I8 = 64 * 32;
        constexpr int NITEMS = I1 + I2 + 3 * I3 + I6 + I7 + I8;
        for (int it = gw; it < NITEMS; it += NGW) {
            int r = it;
            if (r < I1) { const int kb = r / 80, nb = r % 80; p0_transpose_item(p.in[I_WIN], 1024, 2560, p.in[I_GMIX], W1T, w1_row(32 * nb), scr, 64 * kb, 32 * nb, lane); continue; } r -= I1;
            if (r < I2) { const int kb = r / 32, nb = r % 32; p0_transpose_item(p.in[I_WOUT], 1024, 1024, nullptr, WOT, 32 * nb, scr, 64 * kb, 32 * nb, lane); continue; } r -= I2;
            if (r < I3) { const int kb = r / 16, nb = r % 16; p0_transpose_item(p.in[I_WMQ], 1024, 512, p.in[I_GCROSS], WMQT, 32 * nb, scr, 64 * kb, 32 * nb, lane); continue; } r -= I3;
            if (r < I3) { const int kb = r / 16, nb = r % 16; p0_transpose_item(p.in[I_WMK], 1024, 512, p.in[I_GMEM], WMKVT, 32 * nb, scr, 64 * kb, 32 * nb, lane); continue; } r -= I3;
            if (r < I3) { const int kb = r / 16, nb = r % 16; p0_transpose_item(p.in[I_WMV], 1024, 512, p.in[I_GMEM], WMKVT, 512 + 32 * nb, scr, 64 * kb, 32 * nb, lane); continue; } r -= I3;
            if (r < I6) { const int kb = r / 32, nb = r % 32; p0_transpose_item(p.in[I_WMO], 512, 1024, nullptr, WMOT, 32 * nb, scr, 64 * kb, 32 * nb, lane); continue; } r -= I6;
            if (r < I7) { const int kb = r / 128, nb = r % 128; p0_transpose_item(p.in[I_WFF1], 1024, 4096, p.in[I_GFFN], WF1T, 32 * nb, scr, 64 * kb, 32 * nb, lane); continue; } r -= I7;
            { const int kb = r / 32, nb = r % 32; p0_transpose_item(p.in[I_WFF2], 4096, 1024, nullptr, WF2T, 32 * nb, scr, 64 * kb, 32 * nb, lane); }
        }
        for (int m = 4 * gw; m < MTOT + 2048; m += 4 * NGW) {
            if (m < MPR) rows_to_bf16_rs<4>(p.in[I_XP] + (size_t)m * 1024, XB + (size_t)m * 1024, RS0 + m, 1, lane);
            else if (m < MTOT) rows_to_bf16_rs<4>(p.in[I_XS] + (size_t)(m - MPR) * 1024, XB + (size_t)m * 1024, RS0 + m, 1, lane);
            else rows_to_bf16_rs<4>(p.in[I_MEM] + (size_t)(m - MTOT) * 1024, MEMB + (size_t)(m - MTOT) * 1024, RSM + (m - MTOT), 1, lane);
        }
    }
    }
    GSYNC(1);

    for (int rep_ = 0; rep_ < 1 + ((DMASK >> 1) & 1); ++rep_) { if (rep_) xcd_barrier(xbar);
    if constexpr (PH(1)) {
        pg8::Gemm g{XB, W1T, MPR, 2560, 1024, 1024}; pg8::StaticOrder S; S.init(MPR, 2560, G, (int)blockIdx.x);
        pg8::EpiG1 E{RS0, p.in[I_GQ], p.in[I_GK], QB, KB, VB, CB, out + O_KP, out + O_KS, out + O_VP, out + O_VS, out + O_CP, out + O_CS};
        pg8::gemm_phase<pg8::EpiG1, pg8::StaticOrder, true, true>(lds, g, S, E);
    }
    }
    GSYNC(2);

    if constexpr (PH(5)) for (int it = gw; it < NBS * 14; it += NGW) {
        const int b = it / 14, i = it % 14; const float* src = p.in[I_CC] + (size_t)(b * 30 + 16 + i) * 512; float* dst = out + O_CS + (size_t)(b * 30 + i) * 512;
        *(f32x4*)(dst + lane * 8) = *(const f32x4*)(src + lane * 8); *(f32x4*)(dst + lane * 8 + 4) = *(const f32x4*)(src + lane * 8 + 4);
    }
    if constexpr (PH(6)) {
        const float* rel = p.in[I_REL];
        const int xq = (int)blockIdx.x & 7;
        for (int qrep = 0; qrep < 1 + ((QEXP) ? 1 : 0); ++qrep) {
        unsigned* qctr = (unsigned*)ws + 64 * xq + 512 * qrep;
        volatile LAS unsigned* qword = (volatile LAS unsigned*)(lds + LDS_BYTES - 256);
        constexpr int NQ_G = 3, NQ_M = 4, NQ_P0 = 24, NQ_S = 4 * SNP, NQ_P = 128, NQ_C = MTOT / 32 / 8, NQ_X = 24, NQ = NQ_G + NQ_M + NQ_S + NQ_P + NQ_C + NQ_X;
        unsigned* g1ctr = (unsigned*)ws + 4736;
        bool conv_lds = false;
        unsigned qnext = 0u; if (tid == 0) qnext = __hip_atomic_fetch_add(qctr, 1u, __ATOMIC_RELAXED, __HIP_MEMORY_SCOPE_AGENT);
        for (;;) {
            __syncthreads();
            if (tid == 0) qword[0] = qnext;
            __syncthreads();
            const int item = (int)qword[0];
            if (item >= NQ) break;
            if (tid == 0) qnext = __hip_atomic_fetch_add(qctr, 1u, __ATOMIC_RELAXED, __HIP_MEMORY_SCOPE_AGENT);
            int kind, idx;
            if (item < NQ_G) { kind = 0; idx = item; } else if (item < NQ_G + NQ_M) { kind = 1; idx = item - NQ_G; }
            else if (item < NQ_G + NQ_M + NQ_P0) { kind = 2; idx = item - NQ_G - NQ_M; }
            else if (item < NQ_G + NQ_M + NQ_P0 + NQ_S * (1 + SGAP)) { const int r = item - NQ_G - NQ_M - NQ_P0, rq = r / (1 + SGAP), rm = r % (1 + SGAP);
                if (rm == 0) { kind = 3; idx = rq; } else { kind = 2; idx = NQ_P0 + rq * SGAP + rm - 1; } }
            else if (item < NQ_G + NQ_M + NQ_S + NQ_P) { kind = 2; idx = item - NQ_G - NQ_M - NQ_S; } else if (item < NQ_G + NQ_M + NQ_S + NQ_P + NQ_C) { kind = 4; idx = item - NQ_G - NQ_M - NQ_S - NQ_P; }
            else { kind = 5; idx = item - NQ_G - NQ_M - NQ_S - NQ_P - NQ_C; }
            if (qrep && ((QEXP) == 1) && kind != 2) continue;
            if (qrep && ((QEXP) == 2) && kind != 3 && kind != 4 && kind != 5) continue;
            if (qrep && ((QEXP) == 3) && kind != 3) continue;
            if (kind == 5) { const int wt = (idx * 8 + xq) * 8 + wave;
                int ln5 = lane; asm volatile("" : "+v"(ln5));
                if (wt < 512) {
#pragma unroll 1
                    for (int i = 0; i < 16; ++i) mk_row(2048 + 16 * wt + i, ln5, out + O_MK, p.in[I_CMK], p.in[I_GMK], p.in[I_GMQ], MKB); }
                else mvt_item(256 + (wt - 512), ln5, out + O_MV, p.in[I_CMV], MVT);
                continue; }
            if (kind == 0) { const int u = xq + 8 * idx;
                if (u < 20) { pg8::Gemm g{XB, W1T, MTOT, 2560, 1024, 1024}; pg8::OneUnit S{128 + u / 10, u % 10};
                    pg8::EpiG1 E{RS0, p.in[I_GQ], p.in[I_GK], QB, KB, VB, CB, out + O_KP, out + O_KS, out + O_VP, out + O_VS, out + O_CP, out + O_CS};
                    pg8::gemm_phase<pg8::EpiG1, pg8::OneUnit, true, true>(lds, g, S, E);
                    if (tid == 0 && !qrep) { __builtin_amdgcn_fence(__ATOMIC_RELEASE, "agent"); asm volatile("s_waitcnt vmcnt(0)" ::: "memory"); __hip_atomic_fetch_add(g1ctr, 1u, __ATOMIC_RELAXED, __HIP_MEMORY_SCOPE_AGENT); } }
            } else if (kind == 1) { const int u = xq + 8 * idx;
                pg8::Gemm g{MEMB, WMKVT, 2048, 1024, 1024, 1024}; pg8::OneUnit S{u >> 2, u & 3};
                pg8::EpiMem E{RSM, out + O_MK, out + O_MV};
                pg8::gemm_phase<pg8::EpiMem, pg8::OneUnit, true, true>(lds, g, S, E);
            } else if (kind == 3) { const int b = 4 * xq + idx / SNP, part = idx % SNP;
                if (tid == 0) { unsigned sp = 0; while (__hip_atomic_load(g1ctr, __ATOMIC_RELAXED, __HIP_MEMORY_SCOPE_AGENT) < 20u && ++sp < (1u << 22)) __builtin_amdgcn_s_sleep(4);
                    __builtin_amdgcn_fence(__ATOMIC_ACQUIRE, "agent"); asm volatile("s_waitcnt vmcnt(0)" ::: "memory"); }
                __syncthreads();
                if constexpr (PH(7))
#pragma unroll 1
                  for (int sr_ = 0; sr_ < (qrep ? SREP2 : SREP); ++sr_) sample_attn_task<2 * SNP>(b, wave >> 1, 2 * part + (wave & 1), lane, wave, lds, QB, p.in[I_CK], p.in[I_CV], out + O_KS, out + O_VS, rel, (QEXP == 3 && SMODE && qrep) ? nullptr : PART);
            } else if (kind == 2) { const int j = idx, bhm = 8 * xq + (j >> 4), qb = 15 - (j & 15), b = bhm >> 3, hm = bhm & 7;
                if constexpr (PH(15)) attn2::attn_unit<8>(b, hm * 64, hm * 64, (hm >> 1) * 128, hm * 128, qb, hm >> 1, rel,
                                        (const attn2::bf16*)QB, (const attn2::bf16*)KB, (const attn2::bf16*)VB, (attn2::bf16*)OAB, (char*)lds_raw);
            } else { const int ct = idx * 8 + xq;
                if constexpr (PH(4)) {
                    if (!conv_lds) { conv_lds = true;
                        int tl = tid; asm volatile("" : "+v"(tl));
                        for (int i = tl; i < 31 * 128; i += NTHREADS) { const int j = i >> 7, q = i & 127; *(LAS f32x4*)(lds + (size_t)((j * 2 + (q & 1)) * 64 + (q >> 1)) * 16) = *(const f32x4*)(p.in[I_WCONV] + (size_t)i * 4); } }
                    if (ct < 1024) conv_item_prompt(ct, tid, CB, lds, p.in[I_BCONV], p.in[I_LNG], p.in[I_LNB], A3);
                    else conv_task_sample((ct - 1024) * 8 + wave, lane, CB, p.in[I_CC], p.in[I_WCONV], p.in[I_BCONV], p.in[I_LNG], p.in[I_LNB], A3); } }
        }
        }
    }
    GSYNC(3);
    for (int rep_ = 0; rep_ < 1 + ((DMASK >> 3) & 1); ++rep_) { if (rep_) xcd_barrier(xbar);
    if constexpr (PH(3)) for (int r = gw; r < 2048; r += NGW) mk_row(r, lane, out + O_MK, p.in[I_CMK], p.in[I_GMK], p.in[I_GMQ], MKB);
    if constexpr (PH(3)) for (int it = gw; it < 8 * 4 * 8; it += NGW) mvt_item(it, lane, out + O_MV, p.in[I_CMV], MVT);
    if constexpr (PH(8)) {
        const float lam = compute_lam(p.in[I_LAM], lane);
        for (int r = gw; r < MTOT; r += NGW) {
            const int h = lane >> 4, e0 = (lane & 15) * 8; f32x4 a0, a1, b0, b1;
            if (r < MPR) { float fa[8], fb[8]; unpack8(*(const v4u*)(OAB + (size_t)r * 1024 + (2 * h) * 128 + e0), fa); unpack8(*(const v4u*)(OAB + (size_t)r * 1024 + (2 * h + 1) * 128 + e0), fb);
                a0 = (f32x4){fa[0], fa[1], fa[2], fa[3]}; a1 = (f32x4){fa[4], fa[5], fa[6], fa[7]}; b0 = (f32x4){fb[0], fb[1], fb[2], fb[3]}; b1 = (f32x4){fb[4], fb[5], fb[6], fb[7]}; }
            else { const int sb = (r - MPR) >> 4, q = (r - MPR) & 15; f32x4 acc[2][2];
#pragma unroll
                for (int m = 0; m < 2; ++m) { const float* pb = PART + ((size_t)((sb * 4 + h) * (2 * SNP) * 2 + m) * 16 + q) * PART_STRIDE; float M = -1e30f;
#pragma unroll
                    for (int sp = 0; sp < 2 * SNP; ++sp) M = fmaxf(M, pb[(size_t)sp * 2 * 16 * PART_STRIDE + 128]);
                    float L = 0.f; f32x4 s0 = (f32x4){0.f, 0.f, 0.f, 0.f}, s1 = s0;
#pragma unroll
                    for (int sp = 0; sp < 2 * SNP; ++sp) { const float* ps = pb + (size_t)sp * 2 * 16 * PART_STRIDE; const float f = exp2f(ps[128] - M); L += ps[129] * f; s0 += *(const f32x4*)(ps + e0) * f; s1 += *(const f32x4*)(ps + e0 + 4) * f; }
                    const float il = 1.0f / L; acc[m][0] = s0 * il; acc[m][1] = s1 * il; }
                a0 = acc[0][0]; a1 = acc[0][1]; b0 = acc[1][0]; b1 = acc[1][1]; }
            const f32x4 d0 = a0 - b0 * lam, d1 = a1 - b1 * lam;
            float ss = (d0.x * d0.x + d0.y * d0.y) + (d0.z * d0.z + d0.w * d0.w) + (d1.x * d1.x + d1.y * d1.y) + (d1.z * d1.z + d1.w * d1.w);
            ss += __shfl_xor(ss, 1); ss += __shfl_xor(ss, 2); ss += __shfl_xor(ss, 4); ss += __shfl_xor(ss, 8);
            const float sc = (1.0f - LAM_INIT) / sqrtf(ss * (1.0f / 128.0f) + EPS); const f32x4 g0 = *(const f32x4*)(p.in[I_GSUB] + e0), g1 = *(const f32x4*)(p.in[I_GSUB] + e0 + 4);
            const f32x4 y0 = d0 * g0 * sc, y1 = d1 * g1 * sc;
            v4u o; o.x = pk2(y0.x, y0.y); o.y = pk2(y0.z, y0.w); o.z = pk2(y1.x, y1.y); o.w = pk2(y1.z, y1.w);
            *(v4u*)(A3 + (size_t)r * 1024 + h * 128 + e0) = o;
        }
    }
    }
    for (int rep_ = 0; rep_ < ((DMASK >> 12) & 1) * 10; ++rep_) xcd_barrier(xbar);
    GSYNC(4);
    for (int rep_ = 0; rep_ < 1 + ((DMASK >> 4) & 1); ++rep_) { if (rep_) xcd_barrier(xbar);
    if constexpr (PH(9)) {
        pg8::Gemm g{A3, WOT, MPR, 1024, 1024, 1024}; pg8::StaticOrder S; S.init(MPR, 1024, G, (int)blockIdx.x);
        pg8::EpiRes E{XB, X1B, SSP1};
        pg8::gemm_phase<pg8::EpiRes, pg8::StaticOrder, true, true>(lds, g, S, E);
    }
    }
    GSYNC(5);
    for (int rep_ = 0; rep_ < 1 + ((DMASK >> 5) & 1); ++rep_) { if (rep_) xcd_barrier(xbar);
    if constexpr (PH(10)) {
        unsigned* g3ctr = (unsigned*)ws + 4672;
        unsigned* g4sctr = (unsigned*)ws + 4864; unsigned* xtctr = (unsigned*)ws + 4928; unsigned* g4ctr = (unsigned*)ws + 5120;
        { const int cs = (int)((blockIdx.x + G - 8) % G);
          pg8::Gemm g{A3 + (size_t)MPR * 1024, WOT, MSA, 1024, 1024, 1024}; pg8::StaticOrder S; S.init(MSA, 1024, G, cs);
          pg8::EpiRes E{XB + (size_t)MPR * 1024, X1B + (size_t)MPR * 1024, SSP1 + (size_t)MPR * 16};
          pg8::gemm_phase<pg8::EpiRes, pg8::StaticOrder, true, true>(lds, g, S, E);
          if (cs < 8 && tid == 0) { __builtin_amdgcn_fence(__ATOMIC_RELEASE, "agent"); asm volatile("s_waitcnt vmcnt(0)" ::: "memory"); __hip_atomic_fetch_add(g3ctr, 1u, __ATOMIC_RELAXED, __HIP_MEMORY_SCOPE_AGENT); } }
        { pg8::Gemm g{X1B, WMQT, MPR, 512, 1024, 1024}; pg8::StaticOrder S; S.init(MPR, 512, G, (int)blockIdx.x);
          pg8::EpiScaleBf16<0> E{SSP1, QM, 512};
          pg8::gemm_phase<pg8::EpiScaleBf16<0>, pg8::StaticOrder, true, true>(lds, g, S, E);
          int upm, upn; if (static_unit0(MPR / 256, 2, G, (int)blockIdx.x, upm, upn) && tid == 0) {
              __builtin_amdgcn_fence(__ATOMIC_RELEASE, "agent"); asm volatile("s_waitcnt vmcnt(0)" ::: "memory"); __hip_atomic_fetch_add(g4ctr + ((upm >> 1) * 2 + upn) * 16, 1u, __ATOMIC_RELAXED, __HIP_MEMORY_SCOPE_AGENT); } }
        if (blockIdx.x >= 64 && blockIdx.x < 68) {
            if (tid == 0) { unsigned sp = 0; while (__hip_atomic_load(g3ctr, __ATOMIC_RELAXED, __HIP_MEMORY_SCOPE_AGENT) < 8u * (unsigned)(rep_ + 1) && ++sp < (1u << 22)) __builtin_amdgcn_s_sleep(4);
                __builtin_amdgcn_fence(__ATOMIC_ACQUIRE, "agent"); asm volatile("s_waitcnt vmcnt(0)" ::: "memory"); }
            __syncthreads(); }
        { pg8::Gemm g{X1B + (size_t)MPR * 1024, WMQT, MSA, 512, 1024, 1024}; pg8::StaticOrder S; S.init(MSA, 512, G, (int)((blockIdx.x + G - 64) % G));
          pg8::EpiScaleBf16<0> E{SSP1 + (size_t)MPR * 16, QM + (size_t)MPR * 512, 512};
          pg8::gemm_phase<pg8::EpiScaleBf16<0>, pg8::StaticOrder, true, true>(lds, g, S, E);
          if (blockIdx.x >= 64 && blockIdx.x < 68 && tid == 0) { __builtin_amdgcn_fence(__ATOMIC_RELEASE, "agent"); asm volatile("s_waitcnt vmcnt(0)" ::: "memory"); __hip_atomic_fetch_add(g4sctr, 1u, __ATOMIC_RELAXED, __HIP_MEMORY_SCOPE_AGENT); } }
    {
        const int vcu = (G % 8 == 0) ? ((int)blockIdx.x % 8) * (G / 8) + (int)blockIdx.x / 8 : (int)blockIdx.x;
        constexpr int KS = 136, VS = 264, VOFF = 256 * KS * 2;
        volatile LAS unsigned* tword = (volatile LAS unsigned*)(lds + LDS_BYTES - 256);
        for (;;) {
            __syncthreads();
            if (tid == 0) { const unsigned t_ = __hip_atomic_fetch_add(xtctr, 1u, __ATOMIC_RELAXED, __HIP_MEMORY_SCOPE_AGENT); tword[0] = t_;
                if (t_ < 256u + NBS * 4) { const bool sm_ = t_ >= 256u; const unsigned* dep = sm_ ? g4sctr : g4ctr + ((((t_ >> 5) * 8 + (t_ & 7)) * 2 + ((t_ >> 4) & 1)) * 16); const unsigned need = sm_ ? 4u : 2u;
                    unsigned sp = 0; while (__hip_atomic_load(dep, __ATOMIC_RELAXED, __HIP_MEMORY_SCOPE_AGENT) < need && ++sp < (1u << 22)) __builtin_amdgcn_s_sleep(4);
                    __builtin_amdgcn_fence(__ATOMIC_ACQUIRE, "agent"); asm volatile("s_waitcnt vmcnt(0)" ::: "memory"); } }
            __syncthreads();
            const int bt = (int)tword[0]; if (bt >= 256 + NBS * 4) break;
            const bool smp = bt >= 256; const int bb = smp ? 8 + ((bt - 256) >> 2) : bt >> 5, head = smp ? (bt - 256) & 3 : (bt >> 3) & 3, part = bt & 7;
            int td = tid; asm volatile("" : "+v"(td)); const int ln = td & 63;
            __syncthreads();
#pragma unroll
            for (int i = 0; i < 8; ++i) { const int ch = td + 512 * i, row = ch >> 4, cc = ch & 15;
                *(LAS v4u*)(lds + (row * KS + cc * 8) * 2) = *(const v4u*)(MKB + (size_t)(bb * 256 + row) * 512 + head * 128 + cc * 8); }
#pragma unroll
            for (int i = 0; i < 8; ++i) { const int ch = td + 512 * i, row = ch >> 5, cc = ch & 31;
                *(LAS v4u*)(lds + VOFF + (row * VS + cc * 8) * 2) = *(const v4u*)(MVT + ((size_t)(bb * 4 + head) * 128 + row) * 256 + cc * 8); }
            __syncthreads();
            const int c = ln & 15, g = ln >> 4;
            const LAS unsigned char* kl = lds + (c * KS + 8 * g) * 2; const LAS unsigned char* vl = lds + VOFF + (c * VS + 8 * g) * 2;
#define XK_L(kt, s4) (*(const LAS pg8::bf16x8*)(kl + ((16 * (kt)) * KS + 32 * (s4)) * 2))
#define XV_L(et, kp) (*(const LAS pg8::bf16x8*)(vl + ((16 * (et)) * VS + 32 * (kp)) * 2))
            if (smp) { if (wave == 0) { int cl = c; asm volatile("" : "+v"(cl)); const int r = MPR + (bb - 8) * 16 + cl;
                    XATTN_GROUP(QM + (size_t)r * 512 + head * 128, OM + (size_t)r * 512 + head * 128 + 4 * g, g, XK_L, XV_L); } }
            else
#pragma unroll 1
            for (int gi = 0; gi < 4; gi += 2) { int cl = c; asm volatile("" : "+v"(cl)); const int r = bb * 4096 + part * 512 + (wave * 4 + gi) * 16 + cl;
                XATTN_GROUP2(QM + (size_t)r * 512 + head * 128, QM + (size_t)(r + 16) * 512 + head * 128, OM + (size_t)r * 512 + head * 128 + 4 * g, OM + (size_t)(r + 16) * 512 + head * 128 + 4 * g, g, XK_L, XV_L); }
#undef XK_L
#undef XV_L
        }
        __syncthreads();
    }
    }
    }
    GSYNC(7);
    if constexpr (PH(12)) {
        pg8::Gemm g{OM, WMOT, MPR, 1024, 512, 512}; pg8::StaticOrder S; S.init(MPR, 1024, G, (int)blockIdx.x);
        pg8::EpiRes E{X1B, X2B, SSP2};
        pg8::gemm_phase<pg8::EpiRes, pg8::StaticOrder, true, true>(lds, g, S, E);
    }
    GSYNC(8);
    for (int rep_ = 0; rep_ < 1 + ((DMASK >> 8) & 1); ++rep_) { if (rep_) xcd_barrier(xbar);
    if constexpr (PH(13)) {
        { pg8::Gemm g{OM + (size_t)MPR * 512, WMOT, MSA, 1024, 512, 512}; pg8::StaticOrder S; S.init(MSA, 1024, G, (int)blockIdx.x);
          pg8::EpiRes E{X1B + (size_t)MPR * 1024, X2B + (size_t)MPR * 1024, SSP2 + (size_t)MPR * 16};
          pg8::gemm_phase<pg8::EpiRes, pg8::StaticOrder, true, true>(lds, g, S, E); }
        { pg8::Gemm g{X2B, WF1T, MPR, 4096, 1024, 1024}; pg8::StaticOrder S; S.init(MPR, 4096, G, (int)blockIdx.x);
          pg8::EpiScaleBf16<1> E{SSP2, UB, 4096};
          pg8::gemm_phase<pg8::EpiScaleBf16<1>, pg8::StaticOrder, true, true>(lds, g, S, E); }
    }
    }
    GSYNC(9);
    for (int rep_ = 0; rep_ < 1 + ((DMASK >> 9) & 1); ++rep_) { if (rep_) xcd_barrier(xbar);
    if constexpr (PH(14)) {
        unsigned* g7ctr = (unsigned*)ws + 4608;
        { const int cs = (int)((blockIdx.x + G - 8) % G);
          pg8::Gemm g{X2B + (size_t)MPR * 1024, WF1T, MSA, 4096, 1024, 1024}; pg8::StaticOrder S; S.init(MSA, 4096, G, cs);
          pg8::EpiScaleBf16<1> E{SSP2 + (size_t)MPR * 16, UB + (size_t)MPR * 4096, 4096};
          pg8::gemm_phase<pg8::EpiScaleBf16<1>, pg8::StaticOrder, true, true>(lds, g, S, E);
          if (cs < 32 && tid == 0) {
              __builtin_amdgcn_fence(__ATOMIC_RELEASE, "agent"); asm volatile("s_waitcnt vmcnt(0)" ::: "memory");
              __hip_atomic_fetch_add(g7ctr, 1u, __ATOMIC_RELAXED, __HIP_MEMORY_SCOPE_AGENT); } }
        { pg8::Gemm g{UB, WF2T, MPR, 1024, 4096, 4096}; pg8::StaticOrder S; S.init(MPR, 1024, G, (int)blockIdx.x);
          pg8::EpiOut E{X2B, out + O_YP};
          pg8::gemm_phase<pg8::EpiOut, pg8::StaticOrder, true, true>(lds, g, S, E); }
        if (blockIdx.x >= 64 && blockIdx.x < 96) {
            if (tid == 0) { unsigned sp = 0; while (__hip_atomic_load(g7ctr, __ATOMIC_RELAXED, __HIP_MEMORY_SCOPE_AGENT) < 32u * (unsigned)(rep_ + 1) && ++sp < (1u << 22)) __builtin_amdgcn_s_sleep(4);
                __builtin_amdgcn_fence(__ATOMIC_ACQUIRE, "agent"); asm volatile("s_waitcnt vmcnt(0)" ::: "memory"); }
            __syncthreads(); }
#pragma unroll 1
        for (int kq = 0; kq < 4; ++kq) { pg8::Gemm g{UB + (size_t)MPR * 4096 + kq * 1024, WF2T + kq * 1024, MSA, 1024, 1024, 4096}; pg8::StaticOrder S; S.init(MSA, 1024, G, (int)((blockIdx.x + G - 8 * kq - 64) % G));
          pg8::EpiPart E{PARTY + (size_t)kq * MSA * 1024};
          pg8::gemm_phase<pg8::EpiPart, pg8::StaticOrder, true, true>(lds, g, S, E); }
        if (rep_ == ((DMASK >> 9) & 1)) {
            xcd_barrier(xbar);
            for (int r = gw; r < MSA; r += NGW) {
#pragma unroll
                for (int j = 0; j < 4; ++j) { const size_t o = (size_t)r * 1024 + 4 * lane + 256 * j; const v2u xw = *(const v2u*)(X2B + (size_t)MPR * 1024 + o); f32x4 v = (f32x4){bf2f(xw.x & 0xffffu), bf2f(xw.x >> 16), bf2f(xw.y & 0xffffu), bf2f(xw.y >> 16)};
#pragma unroll
                    for (int kq = 0; kq < 4; ++kq) v += *(const f32x4*)(PARTY + (size_t)kq * MSA * 1024 + o);
                    *(f32x4*)(out + O_YS + o) = v; } }
        }
    }
    }
#ifdef PROBE_A
    GSYNC(10);
    if (blockIdx.x == 0 && threadIdx.x == 0) { const unsigned long long* ts = (const unsigned long long*)(p.ws + 2048);
        out[O_YP] += floorf((float)(ts[PROBE_A + 1] - ts[PROBE_A]) * 0.001f + 0.5f) * 10.0f;
        out[O_YS] += PROBE_B < 0 ? 100.0f : floorf((float)(ts[PROBE_B + 1] - ts[PROBE_B]) * 0.001f + 0.5f) * 10.0f; }
#endif
}

extern "C" void kernel_launch(void* const* d_in, const int* in_sizes, int n_in, void* d_out, int out_size, void* d_ws, size_t ws_size, hipStream_t stream) {
    static int grid = 0;
    if (grid == 0) {
        if (n_in != 31 || out_size != (int)O_END || ws_size < WS_END) { fprintf(stderr, "kernel_launch: unexpected shapes (n_in %d, out %d, ws %zu)\n", n_in, out_size, ws_size); grid = -1; return; }
        int dev = 0, cus = 0, per_cu = 0;
        hipGetDevice(&dev); hipDeviceGetAttribute(&cus, hipDeviceAttributeMultiprocessorCount, dev);
        if (hipFuncSetAttribute((const void*)fwd_kernel, hipFuncAttributeMaxDynamicSharedMemorySize, LDS_BYTES) != hipSuccess) { fprintf(stderr, "kernel_launch: hipFuncSetAttribute failed\n"); grid = -1; return; }
        if (hipOccupancyMaxActiveBlocksPerMultiprocessor(&per_cu, (const void*)fwd_kernel, NTHREADS, LDS_BYTES) != hipSuccess || per_cu < 1) { fprintf(stderr, "kernel_launch: occupancy query failed (%d)\n", per_cu); (void)hipGetLastError(); per_cu = 1; }
        if (per_cu > 1) per_cu = 1;
        grid = cus * per_cu;
        if (grid % 8 != 0 || grid < 8) { fprintf(stderr, "kernel_launch: unexpected CU count %d\n", cus); }
    }
    if (grid < 0) return;
    if (hipMemsetAsync(d_ws, 0, 32768, stream) != hipSuccess) { fprintf(stderr, "kernel_launch: hipMemsetAsync failed\n"); return; }
    Params p{};
    for (int i = 0; i < 31; ++i) p.in[i] = (const float*)d_in[i];
    p.out = (float*)d_out; p.ws = (unsigned char*)d_ws;
    void* args[] = {&p};
    hipError_t e = hipLaunchCooperativeKernel((const void*)fwd_kernel, dim3(grid), dim3(NTHREADS), args, LDS_BYTES, stream);
    if (e != hipSuccess) fprintf(stderr, "kernel_launch: cooperative launch failed: %s (grid %d)\n", hipGetErrorString(e), grid);
}
```

```cpp
#include <hip/hip_runtime.h>
#include <hip/hip_cooperative_groups.h>
#include <cstdio>
#include <cstdint>
namespace pg8 {
#define PG8_LAS __attribute__((address_space(3)))
typedef unsigned short bf16_t;
typedef short bf16x8 __attribute__((ext_vector_type(8)));
typedef float f32x4 __attribute__((ext_vector_type(4)));
typedef unsigned u32x4 __attribute__((ext_vector_type(4)));
constexpr int BM = 256, BK = 64, HALF = 128, HTB = HALF * BK * 2  , STAGE_BYTES = 8 * HTB, NXCD = 8, WGM = 8;

__host__ __device__ __forceinline__ int lds_byte(int r, int c) { const int st = (r >> 4) * 2 + (c >> 5), rr = r & 15, cc = c & 31, ob = rr * 64 + cc * 2; return st * 1024 + (ob ^ (((ob >> 9) & 1) << 5)); }
__host__ __device__ __forceinline__ void stage_rc(int b, int& R, int& C) { const int st = b / 1024, sb = b % 1024, swz = sb ^ (((sb >> 9) & 1) << 5); R = (st >> 1) * 16 + swz / 64; C = (st & 1) * 32 + (swz % 64) / 2; }
__host__ __device__ __forceinline__ int perm32(int rho) { const int n = rho >> 4, i = rho & 15; return 8 * (i >> 2) + 4 * n + (i & 3); }

struct Unit { int pm, pn; };
struct Gemm { const bf16_t* A; const bf16_t* Bt; int M, N, K, ld; };

struct StaticOrder {
    int nM, nN, nwg, G, c;
    __host__ __device__ void init(int M, int N, int G_, int c_) { nM = M / BM; nN = N / BM; nwg = nM * nN; G = G_; c = c_; }
    __host__ __device__ bool next(int i, Unit& u) const {
        const long L = (long)i * G + c; if (L >= nwg) return false;
        int wgid = (int)L; { const int q = nwg / NXCD, r = nwg % NXCD, xcd = wgid % NXCD, off = wgid / NXCD; wgid = (xcd < r ? xcd * (q + 1) : r * (q + 1) + (xcd - r) * q) + off; }
        const int nig = WGM * nN, gid = wgid / nig, fm = gid * WGM, gsz = (nM - fm) < WGM ? (nM - fm) : WGM;
        u.pm = fm + ((wgid % nig) % gsz); u.pn = (wgid % nig) / gsz; return true;
    }
    __device__ __forceinline__ void a_ready(const Unit&) const {}
    __device__ __forceinline__ void done(const Unit&) const {}
};

__device__ __forceinline__ unsigned cvt_pk_bf16(float lo, float hi) { unsigned r; asm volatile("v_cvt_pk_bf16_f32 %0, %1, %2" : "=v"(r) : "v"(lo), "v"(hi)); return r; }
typedef float f32x2 __attribute__((ext_vector_type(2)));

constexpr int MP = 32768;
constexpr float EPSN = 1e-6f;
constexpr float QC2 = 0.125f * 1.4426950408889634f;
__device__ __forceinline__ void st_bf16x8(bf16_t* p, const f32x4 a, const f32x4 b) { u32x4 w; w.x = cvt_pk_bf16(a[0], a[1]); w.y = cvt_pk_bf16(a[2], a[3]); w.z = cvt_pk_bf16(b[0], b[1]); w.w = cvt_pk_bf16(b[2], b[3]); *(u32x4*)p = w; }
__device__ __forceinline__ float dot4(const f32x4 a) { return (a[0] * a[0] + a[1] * a[1]) + (a[2] * a[2] + a[3] * a[3]); }

struct EpiG1 {
    static constexpr bool PERM = true, AFTER_DRAIN = false;
    const float* rs; const float* gq; const float* gk;
    bf16_t* Q; bf16_t* KB; bf16_t* VB; bf16_t* C;
    float* kp; float* ks; float* vp; float* vs; float* cpo; float* cso;
    __device__ __forceinline__ void operator()(const f32x4 (&acc)[2][2][4][2], const Unit& u, int wr, int wc, int fr, int fq) const {
        const int pn = u.pn;
#pragma unroll
        for (int ai = 0; ai < 2; ++ai)
#pragma unroll
            for (int m = 0; m < 4; ++m) {
                const int r = u.pm * BM + ai * HALF + wr * 64 + m * 16 + fr;
                const float rsv = rs[r];
                if (pn < 4) {
                    f32x4 v[2][2]; float ss = 0.f;
#pragma unroll
                    for (int bj = 0; bj < 2; ++bj)
#pragma unroll
                        for (int n = 0; n < 2; ++n) { v[bj][n] = acc[ai][bj][m][n] * rsv; ss += dot4(v[bj][n]); }
                    ss += __shfl_xor(ss, 16); ss += __shfl_xor(ss, 32);
                    const float rstd = 1.0f / sqrtf(ss * (1.0f / 64.0f) + EPSN);
                    const float* g = pn < 2 ? gq : gk; const float sc = pn < 2 ? rstd * QC2 : rstd;
                    const int grp = 4 * (pn & 1) + wc;
#pragma unroll
                    for (int bj = 0; bj < 2; ++bj) {
                        const int d0 = 32 * bj + 8 * fq; const f32x4 g0 = *(const f32x4*)(g + d0), g1 = *(const f32x4*)(g + d0 + 4);
                        const f32x4 o0 = v[bj][0] * g0 * sc, o1 = v[bj][1] * g1 * sc; const int col = 64 * grp + d0;
                        if (pn < 2) st_bf16x8(Q + (size_t)r * 512 + col, o0, o1);
                        else { float* ko = (r < MP ? kp + (size_t)r * 512 : ks + (size_t)(r - MP) * 512) + col; *(f32x4*)ko = o0; *(f32x4*)(ko + 4) = o1; st_bf16x8(KB + (size_t)r * 512 + col, o0, o1); }
                    }
                } else if (pn < 6) {
#pragma unroll
                    for (int bj = 0; bj < 2; ++bj) {
                        const int col = 256 * (pn - 4) + 128 * bj + 32 * wc + 8 * fq; const f32x4 o0 = acc[ai][bj][m][0] * rsv, o1 = acc[ai][bj][m][1] * rsv;
                        float* vo = (r < MP ? vp + (size_t)r * 512 : vs + (size_t)(r - MP) * 512) + col; *(f32x4*)vo = o0; *(f32x4*)(vo + 4) = o1; st_bf16x8(VB + (size_t)r * 512 + col, o0, o1);
                    }
                } else {
                    const int ch = 128 * (pn - 6) + 32 * wc + 8 * fq; f32x4 c[2];
#pragma unroll
                    for (int n = 0; n < 2; ++n) { const f32x4 a = acc[ai][0][m][n] * rsv, gt = acc[ai][1][m][n] * rsv;
#pragma unroll
                        for (int e = 0; e < 4; ++e) c[n][e] = a[e] / (1.0f + __expf(-gt[e])); }
                    st_bf16x8(C + (size_t)r * 512 + ch, c[0], c[1]);
                    float* cs = nullptr;
                    if (r >= MP) cs = cso + ((size_t)((r - MP) >> 4) * 30 + 14 + ((r - MP) & 15)) * 512; else if ((r & 4095) >= 4066) cs = cpo + ((size_t)(r >> 12) * 30 + (r & 4095) - 4066) * 512;
                    if (cs) { *(f32x4*)(cs + ch) = c[0]; *(f32x4*)(cs + ch + 4) = c[1]; }
                }
            }
    }
};
struct EpiMem {
    static constexpr bool PERM = true, AFTER_DRAIN = false;
    const float* rs; float* mk; float* mv;
    __device__ __forceinline__ void operator()(const f32x4 (&acc)[2][2][4][2], const Unit& u, int wr, int wc, int fr, int fq) const {
        float* base = u.pn < 2 ? mk : mv; const int cb = 256 * (u.pn & 1);
#pragma unroll
        for (int ai = 0; ai < 2; ++ai)
#pragma unroll
            for (int m = 0; m < 4; ++m) { const int r = u.pm * BM + ai * HALF + wr * 64 + m * 16 + fr; const float rsv = rs[r];
#pragma unroll
                for (int bj = 0; bj < 2; ++bj) { float* o = base + (size_t)r * 512 + cb + 128 * bj + 32 * wc + 8 * fq; *(f32x4*)o = acc[ai][bj][m][0] * rsv; *(f32x4*)(o + 4) = acc[ai][bj][m][1] * rsv; } }
    }
};
__device__ __forceinline__ void bf8_to_f32(const u32x4 w, f32x4& lo, f32x4& hi) {
    lo = (f32x4){__builtin_bit_cast(float, w.x << 16), __builtin_bit_cast(float, w.x & 0xffff0000u), __builtin_bit_cast(float, w.y << 16), __builtin_bit_cast(float, w.y & 0xffff0000u)};
    hi = (f32x4){__builtin_bit_cast(float, w.z << 16), __builtin_bit_cast(float, w.z & 0xffff0000u), __builtin_bit_cast(float, w.w << 16), __builtin_bit_cast(float, w.w & 0xffff0000u)}; }
struct EpiRes {
    static constexpr bool PERM = true, AFTER_DRAIN = false;
    const bf16_t* resb; bf16_t* xb; float* ssp;
    __device__ __forceinline__ void operator()(const f32x4 (&acc)[2][2][4][2], const Unit& u, int wr, int wc, int fr, int fq) const {
#pragma unroll
        for (int ai = 0; ai < 2; ++ai) {
            u32x4 rb[4][2];
#pragma unroll
            for (int m = 0; m < 4; ++m)
#pragma unroll
                for (int bj = 0; bj < 2; ++bj) rb[m][bj] = *(const u32x4*)(resb + (size_t)(u.pm * BM + ai * HALF + wr * 64 + m * 16 + fr) * 1024 + 256 * u.pn + 128 * bj + 32 * wc + 8 * fq);
#pragma unroll
            for (int m = 0; m < 4; ++m) { const int r = u.pm * BM + ai * HALF + wr * 64 + m * 16 + fr; float ss = 0.f;
#pragma unroll
                for (int bj = 0; bj < 2; ++bj) { const int col = 256 * u.pn + 128 * bj + 32 * wc + 8 * fq; f32x4 x0, x1; bf8_to_f32(rb[m][bj], x0, x1);
                    x0 += acc[ai][bj][m][0]; x1 += acc[ai][bj][m][1];
                    st_bf16x8(xb + (size_t)r * 1024 + col, x0, x1); ss += dot4(x0) + dot4(x1); }
                ss += __shfl_xor(ss, 16); ss += __shfl_xor(ss, 32);
                if (fq == 0) ssp[(size_t)r * 16 + 4 * u.pn + wc] = ss; }
            asm volatile("" ::: "memory"); }
    }
};
__device__ __forceinline__ float row_rs(const float* ssp, int r) { const f32x4 a = *(const f32x4*)(ssp + (size_t)r * 16), b = *(const f32x4*)(ssp + (size_t)r * 16 + 4), c = *(const f32x4*)(ssp + (size_t)r * 16 + 8), d = *(const f32x4*)(ssp + (size_t)r * 16 + 12);
    const float s = ((a[0] + a[1]) + (a[2] + a[3])) + ((b[0] + b[1]) + (b[2] + b[3])) + ((c[0] + c[1]) + (c[2] + c[3])) + ((d[0] + d[1]) + (d[2] + d[3])); return 1.0f / sqrtf(s * (1.0f / 1024.0f) + EPSN); }
template <int ACT> struct EpiScaleBf16 {
    static constexpr bool PERM = true, AFTER_DRAIN = false;
    const float* ssp; bf16_t* O; int ldc;
    __device__ __forceinline__ void operator()(const f32x4 (&acc)[2][2][4][2], const Unit& u, int wr, int wc, int fr, int fq) const {
#pragma unroll
        for (int ai = 0; ai < 2; ++ai)
#pragma unroll
            for (int m = 0; m < 4; ++m) { const int r = u.pm * BM + ai * HALF + wr * 64 + m * 16 + fr; const float rsv = row_rs(ssp, r);
#pragma unroll
                for (int bj = 0; bj < 2; ++bj) { const int col = 256 * u.pn + 128 * bj + 32 * wc + 8 * fq; f32x4 o0 = acc[ai][bj][m][0] * rsv, o1 = acc[ai][bj][m][1] * rsv;
                    if (ACT == 1) {
#pragma unroll
                        for (int e = 0; e < 4; ++e) { const float a = fmaxf(o0[e], 0.f), b = fmaxf(o1[e], 0.f); o0[e] = a * a; o1[e] = b * b; } }
                    st_bf16x8(O + (size_t)r * ldc + col, o0, o1); } }
    }
};
struct EpiOut {
    static constexpr bool PERM = true, AFTER_DRAIN = false;
    const bf16_t* resb; float* yp;
    __device__ __forceinline__ void operator()(const f32x4 (&acc)[2][2][4][2], const Unit& u, int wr, int wc, int fr, int fq) const {
#pragma unroll
        for (int ai = 0; ai < 2; ++ai) {
            u32x4 rb[4][2];
#pragma unroll
            for (int m = 0; m < 4; ++m)
#pragma unroll
                for (int bj = 0; bj < 2; ++bj) rb[m][bj] = *(const u32x4*)(resb + (size_t)(u.pm * BM + ai * HALF + wr * 64 + m * 16 + fr) * 1024 + 256 * u.pn + 128 * bj + 32 * wc + 8 * fq);
#pragma unroll
            for (int m = 0; m < 4; ++m) { const int r = u.pm * BM + ai * HALF + wr * 64 + m * 16 + fr; float* yo = yp + (size_t)r * 1024;
#pragma unroll
                for (int bj = 0; bj < 2; ++bj) { const int col = 256 * u.pn + 128 * bj + 32 * wc + 8 * fq; f32x4 x0, x1; bf8_to_f32(rb[m][bj], x0, x1);
                    *(f32x4*)(yo + col) = x0 + acc[ai][bj][m][0]; *(f32x4*)(yo + col + 4) = x1 + acc[ai][bj][m][1]; } }
            asm volatile("" ::: "memory"); }
    }
};
struct EpiPart {
    static constexpr bool PERM = true, AFTER_DRAIN = false;
    float* part;
    __device__ __forceinline__ void operator()(const f32x4 (&acc)[2][2][4][2], const Unit& u, int wr, int wc, int fr, int fq) const {
#pragma unroll
        for (int ai = 0; ai < 2; ++ai)
#pragma unroll
            for (int m = 0; m < 4; ++m) { const int r = u.pm * BM + ai * HALF + wr * 64 + m * 16 + fr;
#pragma unroll
                for (int bj = 0; bj < 2; ++bj) { float* yo = part + (size_t)r * 1024 + 256 * u.pn + 128 * bj + 32 * wc + 8 * fq; *(f32x4*)yo = acc[ai][bj][m][0]; *(f32x4*)(yo + 4) = acc[ai][bj][m][1]; } }
    }
};
struct OneUnit { int pm, pn;
    __device__ __forceinline__ bool next(int i, Unit& u) const { if (i) return false; u.pm = pm; u.pn = pn; return true; }
    __device__ __forceinline__ void a_ready(const Unit&) const {}
    __device__ __forceinline__ void done(const Unit&) const {}
};
template <class Epi, class Sched, bool ALIGN_EPI = false, bool SP2 = false>
__device__ __forceinline__ void gemm_phase(PG8_LAS unsigned char* lds, const Gemm g, const Sched& S, const Epi& E) {
    int tid = threadIdx.x; asm volatile("" : "+v"(tid));
    const int wid = __builtin_amdgcn_readfirstlane(tid >> 6), lane = tid & 63, wr = wid >> 2, wc = wid & 3, fr = lane & 15, fq = lane >> 4;
    const int K = g.ld, nt = g.K / BK;
    unsigned voffA[2], voffB[2];
#pragma unroll
    for (int i = 0; i < 2; ++i) { int R, C; stage_rc(tid * 16 + i * 8192, R, C); const int Rb = Epi::PERM ? ((R & ~31) + perm32(R & 31)) : R;
        voffA[i] = (unsigned)(R * K + C) * 2u; voffB[i] = (unsigned)(Rb * K + C) * 2u; }
    const size_t kstep = (size_t)(BK * 2);
    const size_t hstep = (size_t)HALF * K * 2;
    const size_t tstep = 2 * hstep;
    const unsigned ldsw = (unsigned)wid * 1024u;
    const int aoff = lds_byte(wr * 64 + fr, fq * 8), boff = lds_byte(wc * 32 + fr, fq * 8);
#define PG8_SA(b, h) (((b) * 2 + (h)) * HTB)
#define PG8_SB(b, h) ((4 + (b) * 2 + (h)) * HTB)
#define PG8_STAGE(bufoff, gbase, voff) do { _Pragma("unroll") for (int _i = 0; _i < 2; ++_i) \
        __builtin_amdgcn_global_load_lds((const unsigned*)((const char*)(gbase) + (voff)[_i]), (PG8_LAS unsigned*)(lds + (bufoff) + ldsw + _i * 8192), 16, 0, 0); } while (0)
#define PG8_LDA(dst, b, h) do { _Pragma("unroll") for (int m = 0; m < 4; ++m) _Pragma("unroll") for (int k = 0; k < 2; ++k) dst[m][k] = *(const PG8_LAS bf16x8*)(lds + PG8_SA(b, h) + aoff + m * 2048 + k * 1024); } while (0)
#define PG8_LDB(dst, b, h) do { _Pragma("unroll") for (int n = 0; n < 2; ++n) _Pragma("unroll") for (int k = 0; k < 2; ++k) dst[n][k] = *(const PG8_LAS bf16x8*)(lds + PG8_SB(b, h) + boff + n * 2048 + k * 1024); } while (0)
#define PG8_MMA(ai, bj, At, Bt) do { __builtin_amdgcn_s_setprio(1); _Pragma("unroll") for (int m = 0; m < 4; ++m) _Pragma("unroll") for (int n = 0; n < 2; ++n) _Pragma("unroll") for (int k = 0; k < 2; ++k) \
        acc[ai][bj][m][n] = __builtin_amdgcn_mfma_f32_16x16x32_bf16(Bt[n][k], At[m][k], acc[ai][bj][m][n], 0, 0, 0); __builtin_amdgcn_s_setprio(0); } while (0)
#define PG8_WAIT_V(n) asm volatile("s_waitcnt vmcnt(" #n ")" ::: "memory")
#define PG8_WAIT_L(n) asm volatile("s_waitcnt lgkmcnt(" #n ")" ::: "memory")
#define PG8_BAR __builtin_amdgcn_s_barrier()
#define PG8_SCHED __builtin_amdgcn_sched_barrier(0)
    Unit cur, nxt; int ui = 0;
    if (!S.next(0, cur)) return;
    f32x4 acc[2][2][4][2];
#pragma unroll
    for (int a = 0; a < 2; ++a)
#pragma unroll
        for (int b = 0; b < 2; ++b)
#pragma unroll
            for (int m = 0; m < 4; ++m)
#pragma unroll
                for (int n = 0; n < 2; ++n) acc[a][b][m][n] = (f32x4){0.f, 0.f, 0.f, 0.f};
    bf16x8 At[4][2], B0[2][2], B1[2][2];
    const char* cA = (const char*)g.A + (size_t)cur.pm * tstep; const char* cB = (const char*)g.Bt + (size_t)cur.pn * tstep;
    S.a_ready(cur);
    if constexpr (SP2) {
        PG8_STAGE(PG8_SB(0, 0), cB, voffB); PG8_STAGE(PG8_SB(0, 1), cB + hstep, voffB); PG8_STAGE(PG8_SA(0, 0), cA, voffA); PG8_STAGE(PG8_SA(0, 1), cA + hstep, voffA);
        if (wr == 1) PG8_BAR;
        PG8_WAIT_V(2); PG8_BAR;
        PG8_STAGE(PG8_SB(1, 0), cB + kstep, voffB); PG8_STAGE(PG8_SA(1, 0), cA + kstep, voffA); PG8_STAGE(PG8_SB(1, 1), cB + hstep + kstep, voffB);
        PG8_WAIT_V(6); PG8_BAR;
    } else {
        PG8_STAGE(PG8_SB(0, 0), cB, voffB); PG8_STAGE(PG8_SA(0, 0), cA, voffA); PG8_STAGE(PG8_SB(0, 1), cB + hstep, voffB); PG8_STAGE(PG8_SA(0, 1), cA + hstep, voffA);
        if (wr == 1) PG8_BAR;
        PG8_WAIT_V(4); PG8_BAR;
        PG8_STAGE(PG8_SB(1, 0), cB + kstep, voffB); PG8_STAGE(PG8_SA(1, 0), cA + kstep, voffA); PG8_STAGE(PG8_SB(1, 1), cB + hstep + kstep, voffB);
        PG8_WAIT_V(6); PG8_BAR;
    }
    for (;;) {
        const bool has_next = S.next(ui + 1, nxt);
        const char* nA = has_next ? (const char*)g.A + (size_t)nxt.pm * tstep : cA; const char* nB = has_next ? (const char*)g.Bt + (size_t)nxt.pn * tstep : cB;
        for (int t = 0; t < nt; t += 2) {
            const bool last = (t == nt - 2);
            const char* a1 = cA + (size_t)(t + 1) * kstep;
            const char* a2 = last ? nA : cA + (size_t)(t + 2) * kstep; const char* b2 = last ? nB : cB + (size_t)(t + 2) * kstep;
            const char* a3 = a2 + kstep; const char* b3 = b2 + kstep;
            if (last && has_next) S.a_ready(nxt);
            if constexpr (SP2) {
            PG8_LDB(B0, 0, 0); PG8_LDB(B1, 0, 1); PG8_SCHED; PG8_LDA(At, 0, 0); PG8_STAGE(PG8_SA(1, 1), a1 + hstep, voffA);
            PG8_WAIT_V(8); PG8_WAIT_L(0); PG8_BAR; PG8_MMA(0, 0, At, B0); PG8_MMA(0, 1, At, B1); PG8_BAR; PG8_SCHED;
            PG8_LDA(At, 0, 1); PG8_STAGE(PG8_SB(0, 0), b2, voffB); PG8_STAGE(PG8_SB(0, 1), b2 + hstep, voffB); PG8_STAGE(PG8_SA(0, 0), a2, voffA);
            PG8_WAIT_V(8); PG8_WAIT_L(0); PG8_BAR; PG8_MMA(1, 0, At, B0); PG8_MMA(1, 1, At, B1); PG8_BAR; PG8_SCHED;
            PG8_LDB(B0, 1, 0); PG8_LDB(B1, 1, 1); PG8_SCHED; PG8_LDA(At, 1, 0); PG8_STAGE(PG8_SA(0, 1), a2 + hstep, voffA);
            PG8_WAIT_V(8); PG8_WAIT_L(0); PG8_BAR; PG8_MMA(0, 0, At, B0); PG8_MMA(0, 1, At, B1); PG8_BAR; PG8_SCHED;
            PG8_LDA(At, 1, 1); PG8_STAGE(PG8_SB(1, 0), b3, voffB); PG8_STAGE(PG8_SB(1, 1), b3 + hstep, voffB); PG8_STAGE(PG8_SA(1, 0), a3, voffA);
            PG8_WAIT_V(8); PG8_WAIT_L(0); PG8_BAR; PG8_MMA(1, 0, At, B0); PG8_MMA(1, 1, At, B1); PG8_BAR; PG8_SCHED;
            } else {
            PG8_LDB(B0, 0, 0); PG8_SCHED; PG8_LDA(At, 0, 0); PG8_STAGE(PG8_SA(1, 1), a1 + hstep, voffA);
            PG8_WAIT_L(8); PG8_BAR; PG8_WAIT_L(0); PG8_MMA(0, 0, At, B0); PG8_BAR; PG8_SCHED;
            PG8_LDB(B1, 0, 1); PG8_STAGE(PG8_SB(0, 0), b2, voffB);
            PG8_BAR; PG8_WAIT_L(0); PG8_MMA(0, 1, At, B1); PG8_BAR;
            PG8_LDA(At, 0, 1); PG8_STAGE(PG8_SA(0, 0), a2, voffA);
            PG8_BAR; PG8_WAIT_L(0); PG8_MMA(1, 0, At, B0); PG8_BAR; PG8_SCHED;
            PG8_STAGE(PG8_SB(0, 1), b2 + hstep, voffB);
            PG8_WAIT_V(6); PG8_BAR; PG8_MMA(1, 1, At, B1); PG8_BAR;
            PG8_LDB(B0, 1, 0); PG8_SCHED; PG8_LDA(At, 1, 0); PG8_STAGE(PG8_SA(0, 1), a2 + hstep, voffA);
            PG8_WAIT_L(8); PG8_BAR; PG8_WAIT_L(0); PG8_MMA(0, 0, At, B0); PG8_BAR; PG8_SCHED;
            PG8_LDB(B1, 1, 1); PG8_STAGE(PG8_SB(1, 0), b3, voffB);
            PG8_BAR; PG8_WAIT_L(0); PG8_MMA(0, 1, At, B1); PG8_BAR;
            PG8_LDA(At, 1, 1); PG8_STAGE(PG8_SA(1, 0), a3, voffA);
            PG8_BAR; PG8_WAIT_L(0); PG8_MMA(1, 0, At, B0); PG8_BAR; PG8_SCHED;
            PG8_STAGE(PG8_SB(1, 1), b3 + hstep, voffB);
            PG8_WAIT_V(6); PG8_BAR; PG8_MMA(1, 1, At, B1); PG8_BAR;
            }
        }
        if constexpr (ALIGN_EPI) { if (wr == 0) PG8_BAR; }
        if constexpr (!Epi::AFTER_DRAIN) { E(acc, cur, wr, wc, fr, fq); S.done(cur); }
        if (!has_next) break;
#pragma unroll
        for (int a = 0; a < 2; ++a)
#pragma unroll
            for (int b = 0; b < 2; ++b)
#pragma unroll
                for (int m = 0; m < 4; ++m)
#pragma unroll
                    for (int n = 0; n < 2; ++n) acc[a][b][m][n] = (f32x4){0.f, 0.f, 0.f, 0.f};
        cur = nxt; cA = nA; cB = nB; ++ui;
        if constexpr (ALIGN_EPI) { if (wr == 1) PG8_BAR; }
    }
    PG8_WAIT_V(0);
    if constexpr (!ALIGN_EPI) { if (wr == 0) PG8_BAR; }
    PG8_BAR;
    if constexpr (Epi::AFTER_DRAIN) { E.fused(acc, cur, wr, wc, fr, fq, lds, wid, lane); S.done(cur); }
#undef PG8_SA
#undef PG8_SB
#undef PG8_STAGE
#undef PG8_LDA
#undef PG8_LDB
#undef PG8_MMA
#undef PG8_WAIT_V
#undef PG8_WAIT_L
#undef PG8_BAR
#undef PG8_SCHED
}
}
#include <hip/hip_bf16.h>
#include <cmath>
namespace attn_body {
using bf16=__hip_bfloat16;
using bf16x8=__attribute__((ext_vector_type(8)))short;
using s16x4=__attribute__((ext_vector_type(4)))short;
using f32x16=__attribute__((ext_vector_type(16)))float;
using u32x4=__attribute__((ext_vector_type(4)))unsigned;
constexpr int SEQ=4096,D=64,PQ=512,PK=512,PV=512,PO=1024;
constexpr int NW=8,QBLK=32,QB=QBLK*NW,KVBLK=64,NQB=SEQ/QB;
constexpr int ATTN_UNIT_ROWS=QB;
__device__ __forceinline__ int crow(int r,int hi){return (r&3)+8*(r>>2)+4*hi;}
#define SBAR() __builtin_amdgcn_sched_barrier(0)
typedef __attribute__((address_space(3))) const float* lds_fptr;
__device__ __forceinline__ void bmask(f32x16&p0,f32x16&p1,int dist,lds_fptr tb){
  if(dist<0){
    #pragma unroll
    for(int r=0;r<16;++r){p0[r]=-INFINITY;p1[r]=-INFINITY;}
  } else if(dist<=2){
    #pragma unroll
    for(int r=0;r<16;++r){const int o=(r&3)+8*(r>>2); p0[r]+=tb[o]; p1[r]+=tb[o+32];}
  }
}

__device__ __forceinline__ void binit(f32x16&c0,f32x16&c1,int dist,lds_fptr tb){
  if(dist<0){
    #pragma unroll
    for(int r=0;r<16;++r){c0[r]=-INFINITY;c1[r]=-INFINITY;}
  } else if(dist<=2){
    #pragma unroll
    for(int r=0;r<16;++r){const int o=(r&3)+8*(r>>2); c0[r]=tb[o]; c1[r]=tb[o+32];}
  } else {
    #pragma unroll
    for(int r=0;r<16;++r){c0[r]=0.f;c1[r]=0.f;}
  }
}
__device__ __forceinline__ void binit1(f32x16&c,int dist,lds_fptr tb){
  if(dist<0){
    #pragma unroll
    for(int r=0;r<16;++r)c[r]=-INFINITY;
  } else if(dist<=2){
    #pragma unroll
    for(int r=0;r<16;++r)c[r]=tb[(r&3)+8*(r>>2)];
  } else {
    #pragma unroll
    for(int r=0;r<16;++r)c[r]=0.f;
  }
}
__device__ __forceinline__ void bpost(f32x16&c0,f32x16&c1,float mhat){
  #pragma unroll
  for(int r=0;r<16;++r){c0[r]-=mhat;c1[r]-=mhat;}
}
constexpr int NSLOT=3, SLOTB=8192;
constexpr int LDS_K=0, LDS_V=NSLOT*SLOTB, LDS_WS=2*NSLOT*SLOTB, LDS_OST=LDS_WS+NW*64*4, LDS_BYTES=LDS_OST+NW*4096;
constexpr float C2=0.125f*1.4426950408889634f;
__device__ __forceinline__ void glds16(const void*gsrc,unsigned lds_dst){unsigned keep;
  asm volatile("s_mov_b32 %0, m0\n\ts_mov_b32 m0, %2\n\ts_nop 0\n\tglobal_load_lds_dwordx4 %1, off\n\ts_mov_b32 m0, %0":"=&s"(keep):"v"(gsrc),"s"(lds_dst):"memory");}
__device__ __forceinline__ float max3f(float a,float b,float c){float r;asm("v_max3_f32 %0, %1, %2, %3":"=v"(r):"v"(a),"v"(b),"v"(c));return r;}
__device__ __forceinline__ float max2f(float a,float b){float r;asm("v_max_f32_e32 %0, %1, %2":"=v"(r):"v"(a),"v"(b));return r;}
__device__ __forceinline__ float fadd_s(float a,float b){float r;asm("v_add_f32_e32 %0, %1, %2":"=v"(r):"v"(a),"v"(b));return r;}
__device__ __forceinline__ float fsub_s(float a,float b){float r;asm("v_sub_f32_e32 %0, %1, %2":"=v"(r):"v"(a),"v"(b));return r;}
typedef float f32x2_t __attribute__((ext_vector_type(2))); typedef __bf16 bf16x2_t __attribute__((ext_vector_type(2)));
__device__ __forceinline__ unsigned cvtpk_s(float lo,float hi){f32x2_t v={lo,hi};bf16x2_t b=__builtin_convertvector(v,bf16x2_t);return __builtin_bit_cast(unsigned,b);}
#define WAIT_BAR(N) asm volatile("s_waitcnt vmcnt(" #N ") lgkmcnt(0)\n\ts_barrier":::"memory")

__device__ __forceinline__ void qkt(f32x16&p0,f32x16&p1,const char*Kslot,const bf16x8*qr,const f32x16&negm,int r32,int hi){
  const char*kb=Kslot+hi*1024+r32*16;
  #pragma unroll
  for(int d0=0;d0<4;++d0){
    const bf16x8 b0=*reinterpret_cast<const bf16x8*>(kb+d0*2048);
    const bf16x8 b1=*reinterpret_cast<const bf16x8*>(kb+d0*2048+512);
    {p0=__builtin_amdgcn_mfma_f32_32x32x16_bf16(b0,qr[d0],p0,0,0,0);p1=__builtin_amdgcn_mfma_f32_32x32x16_bf16(b1,qr[d0],p1,0,0,0);}}
}
typedef __attribute__((address_space(3))) const char* lds_cptr;
typedef short v4i16_t __attribute__((ext_vector_type(4)));
__device__ __forceinline__ void kload8(bf16x8*kf,lds_cptr kp){
  kf[0]=*(const __attribute__((address_space(3))) bf16x8*)(kp);      kf[1]=*(const __attribute__((address_space(3))) bf16x8*)(kp+512);
  kf[2]=*(const __attribute__((address_space(3))) bf16x8*)(kp+2048); kf[3]=*(const __attribute__((address_space(3))) bf16x8*)(kp+2560);
  kf[4]=*(const __attribute__((address_space(3))) bf16x8*)(kp+4096); kf[5]=*(const __attribute__((address_space(3))) bf16x8*)(kp+4608);
  kf[6]=*(const __attribute__((address_space(3))) bf16x8*)(kp+6144); kf[7]=*(const __attribute__((address_space(3))) bf16x8*)(kp+6656);
}
__device__ __forceinline__ void kload2(bf16x8*kf,lds_cptr kp,int j){ kf[2*j]=*(const __attribute__((address_space(3))) bf16x8*)(kp+j*2048); kf[2*j+1]=*(const __attribute__((address_space(3))) bf16x8*)(kp+j*2048+512); }
__device__ __forceinline__ s16x4 vtr(lds_cptr p){ return __builtin_bit_cast(s16x4,__builtin_amdgcn_ds_read_tr16_b64_v4i16((__attribute__((address_space(3))) v4i16_t*)p)); }
__device__ __forceinline__ float rowmax(const f32x16&p0,const f32x16&p1){
  float a=max3f(p0[0],p0[1],p1[0]),b=max3f(p0[2],p0[3],p1[1]);a=max3f(a,p1[2],p1[3]);
  #pragma unroll
  for(int r=4;r<16;r+=4){a=max3f(a,p0[r],p0[r+1]);b=max3f(b,p0[r+2],p0[r+3]);a=max3f(a,p1[r],p1[r+1]);b=max3f(b,p1[r+2],p1[r+3]);}
  const float m=max2f(a,b);
  auto rr=__builtin_amdgcn_permlane32_swap(__float_as_uint(m),__float_as_uint(m),false,false);
  return max2f(__uint_as_float(rr[0]),__uint_as_float(rr[1]));
}
__device__ __forceinline__ void pv(f32x16*o,int vb,bf16x8 pa0,bf16x8 pa1,bf16x8 pa2,bf16x8 pa3){
  #pragma unroll
  for(int d0=0;d0<2;++d0){s16x4 lo[4],hi[4];
    #pragma unroll
    for(int ks=0;ks<4;++ks){
      asm volatile("ds_read_b64_tr_b16 %0,%1 offset:%c2":"=&v"(lo[ks]):"v"(vb),"i"(d0*4096+ks*1024):"memory");
      asm volatile("ds_read_b64_tr_b16 %0,%1 offset:%c2":"=&v"(hi[ks]):"v"(vb),"i"(d0*4096+ks*1024+512):"memory");}
    asm volatile("s_waitcnt lgkmcnt(0)":::"memory");SBAR();
    #define PK(k) (bf16x8){lo[k][0],lo[k][1],lo[k][2],lo[k][3],hi[k][0],hi[k][1],hi[k][2],hi[k][3]}
    o[d0]=__builtin_amdgcn_mfma_f32_32x32x16_bf16(pa0,PK(0),o[d0],0,0,0);
    o[d0]=__builtin_amdgcn_mfma_f32_32x32x16_bf16(pa1,PK(1),o[d0],0,0,0);
    o[d0]=__builtin_amdgcn_mfma_f32_32x32x16_bf16(pa2,PK(2),o[d0],0,0,0);
    o[d0]=__builtin_amdgcn_mfma_f32_32x32x16_bf16(pa3,PK(3),o[d0],0,0,0);
    #undef PK
  }
}

#ifndef ATTN_STORE16
#define ATTN_STORE16(p,v) (*(u32x4*)(p)=(v))
#endif
template<int THRL> __device__ __forceinline__ void attn_unit(int b,int qcol,int kcol,int vcol,int ocol,int qb,int hd,const float*reltab,const bf16*Q,const bf16*__restrict__ K,const bf16*__restrict__ V,bf16*O,char*shm){
  int tid=threadIdx.x; asm volatile("":"+v"(tid));
  const int lane=tid&63,r32=lane&31,hi=lane>>5; const int wid=__builtin_amdgcn_readfirstlane(tid>>6);
  const long rowbase=(long)b*SEQ; const int q0=qb*QB;
  const bf16*Qw=Q+(rowbase+q0+wid*QBLK)*PQ+qcol;
  const bf16*Kh=K+rowbase*PK+kcol,*Vh=V+rowbase*PV+vcol;
  const lds_cptr shm3=(lds_cptr)shm;
  const unsigned lds0=(unsigned)(uintptr_t)shm;
  float*wsf=(float*)(shm+LDS_WS)+wid*64;
  const bf16*ksrc=Kh+(long)lane*PK+wid*8;
  const bf16*vsrc=Vh+(long)(16*(wid&3)+(lane>>2))*PV+(wid>>2)*32+(lane&3)*8;
  const unsigned kdst=lds0+LDS_K+wid*1024, vdst=lds0+LDS_V+wid*1024;
  #define DMA_K(t,slot) glds16(ksrc+(long)(t)*KVBLK*PK,(unsigned)__builtin_amdgcn_readfirstlane(kdst+(slot)))
  #define DMA_V(t,slot) glds16(vsrc+(long)(t)*KVBLK*PV,(unsigned)__builtin_amdgcn_readfirstlane(vdst+(slot)))
  const int vb0=(int)(lds0+LDS_V)+((lane>>4)&1)*32+(lane&3)*8+(4*hi+((lane&15)>>2))*64;
  const char*Kbase=shm+LDS_K; bf16x8 kf[8];
  const lds_cptr kp0=shm3+LDS_K+hi*1024+r32*16; const lds_cptr vp0=shm3+LDS_V+((lane>>4)&1)*32+(lane&3)*8+(4*hi+((lane&15)>>2))*64;
  const int NT=(q0+QB)/KVBLK;
  DMA_K(0,0);DMA_V(0,0);DMA_K(1,SLOTB);
  if(tid<256){ const int rel_=tid-191, n_=rel_<0?-rel_:rel_; const int bk_=(rel_>0?16:0)+(n_<8?n_:min(15,2+(31-__clz(n_*n_))));
    ((__attribute__((address_space(3))) float*)(shm3+LDS_BYTES))[tid]=(reltab[bk_*4+hd]-reltab[15*4+hd])*1.4426950408889634f; }
  bf16x8 qr[4];
  #pragma unroll
  for(int d0=0;d0<4;++d0)qr[d0]=*reinterpret_cast<const bf16x8*>(&Qw[(long)r32*PQ+d0*16+hi*8]);
  float mhat=0.f,l_reg=0.f;f32x16 o[2];o[0]=f32x16{};o[1]=f32x16{};f32x16 negm=f32x16{};asm volatile("":"+v"(negm));
  const int wc2=wid>>1; const lds_fptr dtl=(lds_fptr)(shm3+LDS_BYTES)+191-(32*(wid&1)+r32)+4*hi;
  bool resc=false;
  #define START(P0,P1) do{ const float rm=rowmax(P0,P1); resc=false; \
    { const float dl=rm; mhat=fadd_s(mhat,dl); \
      _Pragma("unroll") for(int r=0;r<16;++r){P0[r]=fsub_s(P0[r],dl);P1[r]=fsub_s(P1[r],dl);} \
      _Pragma("unroll") for(int r=0;r<16;++r)negm[r]=-mhat; asm volatile("":"+v"(negm)); } \
    _Pragma("unroll") for(int r=0;r<16;++r)P0[r]=__builtin_amdgcn_exp2f(P0[r]); }while(0)
  #define RESC() do{ if(resc){ asm volatile("s_waitcnt lgkmcnt(0)":::"memory"); \
      _Pragma("unroll") for(int d_=0;d_<2;++d_) _Pragma("unroll") for(int r=0;r<16;++r)o[d_][r]*=wsf[crow(r,hi)]; } }while(0)
  f32x16 pA0,pA1,pB0,pB1;
  int sl_prev=0,sl_cur=0,sl_next=SLOTB;
  #define ROT() do{sl_prev=sl_cur;sl_cur=sl_next;sl_next=(sl_next==(NSLOT-1)*SLOTB)?0:sl_next+SLOTB;}while(0)
  DMA_K(2,2*SLOTB);
  WAIT_BAR(3);
  { const int dist_=wc2+(NT-4); binit(pA0,pA1,dist_,dtl-64*dist_); }
  qkt(pA0,pA1,Kbase,qr,negm,r32,hi);asm volatile("s_nop 15\n\ts_nop 7":"+v"(pA0),"+v"(pA1));
  START(pA0,pA1);
  _Pragma("unroll") for(int r=0;r<16;++r)pA1[r]=__builtin_amdgcn_exp2f(pA1[r]);
  WAIT_BAR(0);
  DMA_K(3,0);DMA_V(1,SLOTB);
  ROT();
  kload8(kf,kp0+sl_cur);
  WAIT_BAR(2);
  s16x4 vlo[8],vhi[8]; u32x4 pw0,pw1,pw2,pw3;
  #define PKW(P,B) cvtpk_s(P[B],P[B+1])
  #define PAF(k) __builtin_bit_cast(bf16x8,pw##k)
  #define VFR(i) (bf16x8){vlo[i][0],vlo[i][1],vlo[i][2],vlo[i][3],vhi[i][0],vhi[i][1],vhi[i][2],vhi[i][3]}
  #define PIN(x) asm volatile("":"+v"(x))
  #define MX3(a,b,c) __builtin_fmaxf(__builtin_fmaxf((a),(b)),(c))
  #define GAPA(MF,A0,A1,A2,A3,W0,W1,PW) do{ MF; sacc+=A0; sacc+=A1; sacc+=A2; sacc+=A3; PIN(sacc); W0; W1; PIN(PW); SBAR(); }while(0)
  #define EX(v) __builtin_amdgcn_exp2f(v)
  #define GAPB(MF,X,B) do{ MF; X[B]=EX(X[B]); X[B+1]=EX(X[B+1]); X[B+2]=EX(X[B+2]); X[B+3]=EX(X[B+3]); PIN(X); SBAR(); }while(0)
  #define VRD(i) do{ vlo[i]=vtr(vp_+(((i)>>2)*4096+((i)&3)*1024)); vhi[i]=vtr(vp_+(((i)>>2)*4096+((i)&3)*1024+512)); }while(0)
  #define KRD(G,j) do{ if(G){ kload2(kf,kp0+sl_next,j); SBAR(); } }while(0)
  #define STEP(C0,C1,P0,P1,t,GK,GV,GL) do{ SBAR(); \
    const lds_cptr vp_=vp0+sl_prev; \
    CINIT0(C0,t); VRD(0); SBAR(); float sacc=(P0[0]+P0[1]); \
    GAPA(C0=__builtin_amdgcn_mfma_f32_32x32x16_bf16(kf[0],qr[0],CSRC(C0),0,0,0), P0[2],P0[3],P0[4],P0[5],     pw0[0]=PKW(P0,0), pw0[1]=PKW(P0,2), pw0); \
    CINIT1(C1,t); VRD(4); SBAR(); GAPA(C1=__builtin_amdgcn_mfma_f32_32x32x16_bf16(kf[1],qr[0],CSRC(C1),0,0,0), P0[6],P0[7],P0[8],P0[9],     pw0[2]=PKW(P0,4), pw0[3]=PKW(P0,6), pw0); \
    VRD(1); SBAR(); GAPA(C0=__builtin_amdgcn_mfma_f32_32x32x16_bf16(kf[2],qr[1],C0,0,0,0),   P0[10],P0[11],P0[12],P0[13], pw1[0]=PKW(P0,8), pw1[1]=PKW(P0,10), pw1); \
    VRD(5); SBAR(); GAPA(C1=__builtin_amdgcn_mfma_f32_32x32x16_bf16(kf[3],qr[1],C1,0,0,0),   P0[14],P0[15],P1[0],P1[1],   pw1[2]=PKW(P0,12),pw1[3]=PKW(P0,14), pw1); \
    VRD(2); SBAR(); GAPA(C0=__builtin_amdgcn_mfma_f32_32x32x16_bf16(kf[4],qr[2],C0,0,0,0),   P1[2],P1[3],P1[4],P1[5],     pw2[0]=PKW(P1,0), pw2[1]=PKW(P1,2), pw2); \
    VRD(6); SBAR(); GAPA(C1=__builtin_amdgcn_mfma_f32_32x32x16_bf16(kf[5],qr[2],C1,0,0,0),   P1[6],P1[7],P1[8],P1[9],     pw2[2]=PKW(P1,4), pw2[3]=PKW(P1,6), pw2); \
    VRD(3); SBAR(); GAPA(C0=__builtin_amdgcn_mfma_f32_32x32x16_bf16(kf[6],qr[3],C0,0,0,0),   P1[10],P1[11],P1[12],P1[13], pw3[0]=PKW(P1,8), pw3[1]=PKW(P1,10), pw3); \
    VRD(7); SBAR(); GAPA(C1=__builtin_amdgcn_mfma_f32_32x32x16_bf16(kf[7],qr[3],C1,0,0,0),   P1[14],P1[15],0.f,0.f,       pw3[2]=PKW(P1,12),pw3[3]=PKW(P1,14), pw3); \
    l_reg+=sacc; \
    if(GK){DMA_K((t)+3,sl_cur);} if(GV){DMA_V((t)+1,sl_next);} \
    CPOST(C0,C1); \
    { float a=MX3(C0[0],C0[1],C1[0]),b=MX3(C0[2],C0[3],C1[1]); a=MX3(a,C1[2],C1[3]); \
      _Pragma("unroll") for(int r=4;r<16;r+=4){a=MX3(a,C0[r],C0[r+1]);b=MX3(b,C0[r+2],C0[r+3]);a=MX3(a,C1[r],C1[r+1]);b=MX3(b,C1[r+2],C1[r+3]);} \
      float rm=__builtin_fmaxf(a,b); { auto rr=__builtin_amdgcn_permlane32_swap(__float_as_uint(rm),__float_as_uint(rm),false,false); rm=__builtin_fmaxf(__uint_as_float(rr[0]),__uint_as_float(rr[1])); } \
      resc=false; \
      if(__builtin_expect(__any(rm>(float)THRL),0)){ const float dl=__builtin_fmaxf(rm,0.f); mhat+=dl; \
        _Pragma("unroll") for(int r=0;r<16;++r){C0[r]-=dl;C1[r]-=dl;} \
        NEGM_UPD(); \
        const float f=__builtin_amdgcn_exp2f(-dl); l_reg*=f; if(hi==0)wsf[r32]=f; resc=true; } } \
    SBAR(); \
    GAPB(o[0]=__builtin_amdgcn_mfma_f32_32x32x16_bf16(PAF(0),VFR(0),o[0],0,0,0), C0,0); \
    GAPB(o[1]=__builtin_amdgcn_mfma_f32_32x32x16_bf16(PAF(0),VFR(4),o[1],0,0,0), C0,4); \
    KRD(GL,0); GAPB(o[0]=__builtin_amdgcn_mfma_f32_32x32x16_bf16(PAF(1),VFR(1),o[0],0,0,0), C0,8); \
    KRD(GL,1); GAPB(o[1]=__builtin_amdgcn_mfma_f32_32x32x16_bf16(PAF(1),VFR(5),o[1],0,0,0), C0,12); \
    KRD(GL,2); GAPB(o[0]=__builtin_amdgcn_mfma_f32_32x32x16_bf16(PAF(2),VFR(2),o[0],0,0,0), C1,0); \
    KRD(GL,3); GAPB(o[1]=__builtin_amdgcn_mfma_f32_32x32x16_bf16(PAF(2),VFR(6),o[1],0,0,0), C1,4); \
    GAPB(o[0]=__builtin_amdgcn_mfma_f32_32x32x16_bf16(PAF(3),VFR(3),o[0],0,0,0), C1,8); \
    GAPB(o[1]=__builtin_amdgcn_mfma_f32_32x32x16_bf16(PAF(3),VFR(7),o[1],0,0,0), C1,12); \
    }while(0)
  int t=1;
  #define CINIT0(C,t) do{}while(0)
  #define CINIT1(C,t) do{}while(0)
  #define CSRC(C) negm
  #define CPOST(C0,C1) do{}while(0)
  #define NEGM_UPD() do{ _Pragma("unroll") for(int r=0;r<16;++r)negm[r]=-mhat; asm volatile("":"+v"(negm)); }while(0)
  for(;t+7<NT;t+=2){
    STEP(pB0,pB1,pA0,pA1,t,true,true,true);     WAIT_BAR(2); RESC(); ROT();
    STEP(pA0,pA1,pB0,pB1,t+1,true,true,true);   WAIT_BAR(2); RESC(); ROT();
  }
  #undef CINIT0
  #undef CINIT1
  #undef CSRC
  #undef CPOST
  #undef NEGM_UPD
  #define NEGM_UPD() do{}while(0)
  #define CINIT0(C,t) do{const int dist_=wc2+(NT-4-(t)); binit1(C,dist_,dtl-64*dist_);}while(0)
  #define CINIT1(C,t) do{const int dist_=wc2+(NT-4-(t)); binit1(C,dist_,dtl-64*dist_+32);}while(0)
  #define CSRC(C) C
  #define CPOST(C0,C1) bpost(C0,C1,mhat)
  #define ENDW(tt) do{ if((tt)+3<NT){WAIT_BAR(2);} else if((tt)+2<NT){WAIT_BAR(1);} else {WAIT_BAR(0);} }while(0)
  for(;t+1<NT;t+=2){
    STEP(pB0,pB1,pA0,pA1,t,(t+3<NT),(t+1<NT),(t+1<NT));       ENDW(t);   RESC(); ROT();
    STEP(pA0,pA1,pB0,pB1,t+1,(t+4<NT),(t+2<NT),(t+2<NT));     ENDW(t+1); RESC(); ROT();
  }
  STEP(pB0,pB1,pA0,pA1,NT-1,false,false,false); RESC();
  { float sacc=pB0[0]+pB0[1]; _Pragma("unroll") for(int r=2;r<16;++r)sacc+=pB0[r]; _Pragma("unroll") for(int r=0;r<16;++r)sacc+=pB1[r]; l_reg+=sacc;
    pw0=(u32x4){PKW(pB0,0),PKW(pB0,2),PKW(pB0,4),PKW(pB0,6)};pw1=(u32x4){PKW(pB0,8),PKW(pB0,10),PKW(pB0,12),PKW(pB0,14)};pw2=(u32x4){PKW(pB1,0),PKW(pB1,2),PKW(pB1,4),PKW(pB1,6)};pw3=(u32x4){PKW(pB1,8),PKW(pB1,10),PKW(pB1,12),PKW(pB1,14)};
    SBAR(); pv(o,vb0+sl_cur,PAF(0),PAF(1),PAF(2),PAF(3)); }
  #undef PKW
  #undef PAF
  #undef VFR
  #undef PIN
  #undef MX3
  #undef GAPA
  #undef GAPB
  #undef EX
  #undef VRD
  #undef KRD
  #undef STEP
  #undef ENDW
  {auto rr=__builtin_amdgcn_permlane32_swap(__float_as_uint(l_reg),__float_as_uint(l_reg),false,false);l_reg=__uint_as_float(rr[0])+__uint_as_float(rr[1]);}
  if(hi==0)wsf[32+r32]=l_reg;asm volatile("s_waitcnt lgkmcnt(0)":::"memory");
  float rli[16];
  #pragma unroll
  for(int r=0;r<16;++r)rli[r]=__builtin_amdgcn_rcpf(wsf[32+crow(r,hi)]);
  bf16*Ow=O+(rowbase+q0+wid*QBLK)*PO+ocol;
  { bf16*stg=(bf16*)(shm+LDS_OST)+wid*2048;
    #pragma unroll
    for(int r=0;r<16;++r){const int orow=crow(r,hi);
      #pragma unroll
      for(int d0=0;d0<2;++d0)stg[orow*64+d0*32+r32]=__float2bfloat16(o[d0][r]*rli[r]);}
    asm volatile("s_waitcnt lgkmcnt(0)":::"memory");
    #pragma unroll
    for(int i=0;i<4;++i){const int row=i*8+(lane>>3),ch=lane&7; const u32x4 v=*(const u32x4*)(stg+row*64+ch*8); ATTN_STORE16(Ow+(long)row*PO+ch*8,v);} }
  asm volatile("s_waitcnt lgkmcnt(0)\n\ts_barrier":::"memory");
  #undef DMA_K
  #undef DMA_V
  #undef CINIT0
  #undef CINIT1
  #undef CSRC
  #undef CPOST
  #undef NEGM_UPD
  #undef START
  #undef RESC
  #undef ROT
}
constexpr int ATTN_LDS_BYTES=LDS_BYTES+1024;
#undef SBAR
#undef WAIT_BAR
}
#include <hip/hip_bf16.h>
#include <cmath>
namespace attn2 {
using bf16=__hip_bfloat16;
using bf16x8=__attribute__((ext_vector_type(8)))short;
using s16x4=__attribute__((ext_vector_type(4)))short;
using f32x16=__attribute__((ext_vector_type(16)))float;
using u32x4=__attribute__((ext_vector_type(4)))unsigned;
constexpr int SEQ=4096,D=64,PQ=512,PK=512,PV=512,PO=1024;
constexpr int NW=8,QBLK=32,QB=QBLK*NW,KVBLK=64,NQB=SEQ/QB;
constexpr int ATTN_UNIT_ROWS=QB;
__device__ __forceinline__ int crow(int r,int hi){return (r&3)+8*(r>>2)+4*hi;}
#define SBAR() __builtin_amdgcn_sched_barrier(0)
typedef __attribute__((address_space(3))) const float* lds_fptr;
__device__ __forceinline__ void bmask(f32x16&p0,f32x16&p1,int dist,lds_fptr tb){
  if(dist<0){
    #pragma unroll
    for(int r=0;r<16;++r){p0[r]=-INFINITY;p1[r]=-INFINITY;}
  } else if(dist<=2){
    #pragma unroll
    for(int r=0;r<16;++r){const int o=(r&3)+8*(r>>2); p0[r]+=tb[o]; p1[r]+=tb[o+32];}
  }
}

__device__ __forceinline__ void binit(f32x16&c0,f32x16&c1,int dist,lds_fptr tb){
  if(dist<0){
    #pragma unroll
    for(int r=0;r<16;++r){c0[r]=-INFINITY;c1[r]=-INFINITY;}
  } else if(dist<=2){
    #pragma unroll
    for(int r=0;r<16;++r){const int o=(r&3)+8*(r>>2); c0[r]=tb[o]; c1[r]=tb[o+32];}
  } else {
    #pragma unroll
    for(int r=0;r<16;++r){c0[r]=0.f;c1[r]=0.f;}
  }
}
__device__ __forceinline__ void binit1(f32x16&c,int dist,lds_fptr tb){
  if(dist<0){
    #pragma unroll
    for(int r=0;r<16;++r)c[r]=-INFINITY;
  } else if(dist<=2){
    #pragma unroll
    for(int r=0;r<16;++r)c[r]=tb[(r&3)+8*(r>>2)];
  } else {
    #pragma unroll
    for(int r=0;r<16;++r)c[r]=0.f;
  }
}
__device__ __forceinline__ void bpost(f32x16&c0,f32x16&c1,float mhat){
  #pragma unroll
  for(int r=0;r<16;++r){c0[r]-=mhat;c1[r]-=mhat;}
}
constexpr int NSLOT=3, SLOTB=8192;
constexpr int LDS_K=0, LDS_V=NSLOT*SLOTB, LDS_WS=LDS_V+NSLOT*2*SLOTB, LDS_OST=LDS_WS+NW*64*4, LDS_BYTES=LDS_OST+NW*4096;
constexpr float C2=0.125f*1.4426950408889634f;
template<int OFF> __device__ __forceinline__ void glds16s(const void*sbase,unsigned voff,unsigned lds_dst){unsigned keep;
  asm volatile("s_mov_b32 %0, m0\n\ts_mov_b32 m0, %3\n\ts_nop 0\n\tglobal_load_lds_dwordx4 %1, %2 offset:%c4\n\ts_mov_b32 m0, %0":"=&s"(keep):"v"(voff),"s"(sbase),"s"(lds_dst),"i"(OFF):"memory");}
__device__ __forceinline__ void glds16(const void*gsrc,unsigned lds_dst){unsigned keep;
  asm volatile("s_mov_b32 %0, m0\n\ts_mov_b32 m0, %2\n\ts_nop 0\n\tglobal_load_lds_dwordx4 %1, off\n\ts_mov_b32 m0, %0":"=&s"(keep):"v"(gsrc),"s"(lds_dst):"memory");}
__device__ __forceinline__ float max3f(float a,float b,float c){float r;asm("v_max3_f32 %0, %1, %2, %3":"=v"(r):"v"(a),"v"(b),"v"(c));return r;}
__device__ __forceinline__ float max2f(float a,float b){float r;asm("v_max_f32_e32 %0, %1, %2":"=v"(r):"v"(a),"v"(b));return r;}
__device__ __forceinline__ float fadd_s(float a,float b){float r;asm("v_add_f32_e32 %0, %1, %2":"=v"(r):"v"(a),"v"(b));return r;}
__device__ __forceinline__ float fsub_s(float a,float b){float r;asm("v_sub_f32_e32 %0, %1, %2":"=v"(r):"v"(a),"v"(b));return r;}
typedef float f32x2_t __attribute__((ext_vector_type(2))); typedef __bf16 bf16x2_t __attribute__((ext_vector_type(2)));
__device__ __forceinline__ unsigned cvtpk_s(float lo,float hi){f32x2_t v={lo,hi};bf16x2_t b=__builtin_convertvector(v,bf16x2_t);return __builtin_bit_cast(unsigned,b);}
#define WAIT_BAR(N) asm volatile("s_waitcnt vmcnt(" #N ") lgkmcnt(0)\n\ts_barrier":::"memory")

__device__ __forceinline__ void qkt(f32x16&p0,f32x16&p1,const char*Kslot,const bf16x8*qr,int r32,int hi){
  const char*kb=Kslot+hi*1024+r32*16;
  #pragma unroll
  for(int d0=0;d0<4;++d0){
    const bf16x8 b0=*reinterpret_cast<const bf16x8*>(kb+d0*2048);
    const bf16x8 b1=*reinterpret_cast<const bf16x8*>(kb+d0*2048+512);
    {p0=__builtin_amdgcn_mfma_f32_32x32x16_bf16(b0,qr[d0],p0,0,0,0);p1=__builtin_amdgcn_mfma_f32_32x32x16_bf16(b1,qr[d0],p1,0,0,0);}}
}
typedef __attribute__((address_space(3))) const char* lds_cptr;
typedef short v4i16_t __attribute__((ext_vector_type(4)));
__device__ __forceinline__ void kload8(bf16x8*kf,lds_cptr kp){
  kf[0]=*(const __attribute__((address_space(3))) bf16x8*)(kp);      kf[1]=*(const __attribute__((address_space(3))) bf16x8*)(kp+512);
  kf[2]=*(const __attribute__((address_space(3))) bf16x8*)(kp+2048); kf[3]=*(const __attribute__((address_space(3))) bf16x8*)(kp+2560);
  kf[4]=*(const __attribute__((address_space(3))) bf16x8*)(kp+4096); kf[5]=*(const __attribute__((address_space(3))) bf16x8*)(kp+4608);
  kf[6]=*(const __attribute__((address_space(3))) bf16x8*)(kp+6144); kf[7]=*(const __attribute__((address_space(3))) bf16x8*)(kp+6656);
}
__device__ __forceinline__ void kload2(bf16x8*kf,lds_cptr kp,int j){ kf[2*j]=*(const __attribute__((address_space(3))) bf16x8*)(kp+j*2048); kf[2*j+1]=*(const __attribute__((address_space(3))) bf16x8*)(kp+j*2048+512); }
__device__ __forceinline__ s16x4 vtr(lds_cptr p){ return __builtin_bit_cast(s16x4,__builtin_amdgcn_ds_read_tr16_b64_v4i16((__attribute__((address_space(3))) v4i16_t*)p)); }
__device__ __forceinline__ float rowmax(const f32x16&p0,const f32x16&p1){
  float a=max3f(p0[0],p0[1],p1[0]),b=max3f(p0[2],p0[3],p1[1]);a=max3f(a,p1[2],p1[3]);
  #pragma unroll
  for(int r=4;r<16;r+=4){a=max3f(a,p0[r],p0[r+1]);b=max3f(b,p0[r+2],p0[r+3]);a=max3f(a,p1[r],p1[r+1]);b=max3f(b,p1[r+2],p1[r+3]);}
  const float m=max2f(a,b);
  auto rr=__builtin_amdgcn_permlane32_swap(__float_as_uint(m),__float_as_uint(m),false,false);
  return max2f(__uint_as_float(rr[0]),__uint_as_float(rr[1]));
}
__device__ __forceinline__ void pv(f32x16*o,int vb,bf16x8 pa0,bf16x8 pa1,bf16x8 pa2,bf16x8 pa3){
  #pragma unroll
  for(int d0=0;d0<4;++d0){s16x4 lo[4],hi[4];
    #pragma unroll
    for(int ks=0;ks<4;++ks){
      asm volatile("ds_read_b64_tr_b16 %0,%1 offset:%c2":"=&v"(lo[ks]):"v"(vb),"i"(d0*4096+ks*1024):"memory");
      asm volatile("ds_read_b64_tr_b16 %0,%1 offset:%c2":"=&v"(hi[ks]):"v"(vb),"i"(d0*4096+ks*1024+512):"memory");}
    asm volatile("s_waitcnt lgkmcnt(0)":::"memory");SBAR();
    #define PK(k) (bf16x8){lo[k][0],lo[k][1],lo[k][2],lo[k][3],hi[k][0],hi[k][1],hi[k][2],hi[k][3]}
    o[d0]=__builtin_amdgcn_mfma_f32_32x32x16_bf16(pa0,PK(0),o[d0],0,0,0);
    o[d0]=__builtin_amdgcn_mfma_f32_32x32x16_bf16(pa1,PK(1),o[d0],0,0,0);
    o[d0]=__builtin_amdgcn_mfma_f32_32x32x16_bf16(pa2,PK(2),o[d0],0,0,0);
    o[d0]=__builtin_amdgcn_mfma_f32_32x32x16_bf16(pa3,PK(3),o[d0],0,0,0);
    #undef PK
  }
}

#ifndef ATTN_STORE16
#define ATTN_STORE16(p,v) (*(u32x4*)(p)=(v))
#endif
template<int THRL> __device__ __forceinline__ void attn_unit(int b,int qcol,int kcol,int vcol,int ocol,int qb,int hd,const float*reltab,const bf16*Q,const bf16*__restrict__ K,const bf16*__restrict__ V,bf16*O,char*shm){
  int tid=threadIdx.x; asm volatile("":"+v"(tid));
  const int lane=tid&63,r32=lane&31,hi=lane>>5; const int wid=__builtin_amdgcn_readfirstlane(tid>>6);
  const long rowbase=(long)b*SEQ; const int q0=qb*QB;
  const bf16*Qw=Q+(rowbase+q0+wid*QBLK)*PQ+qcol;
  const bf16*Kh=K+rowbase*PK+kcol,*Vh=V+rowbase*PV+vcol;
  const lds_cptr shm3=(lds_cptr)shm;
  const unsigned lds0=(unsigned)(uintptr_t)shm;
  float*wsf=(float*)(shm+LDS_WS)+wid*64;
  const unsigned koff=(unsigned)((lane*PK+wid*8)*2);
  const unsigned voff=(unsigned)(((16*(wid&3)+(lane>>2))*PV+(wid>>2)*32+(lane&3)*8)*2);
  const unsigned kdst=lds0+LDS_K+wid*1024, vdst=lds0+LDS_V+wid*1024;
  #define DMA_K(t,slot) glds16s<0>(Kh+(long)(t)*KVBLK*PK,koff,(unsigned)__builtin_amdgcn_readfirstlane(kdst+(slot)))
  #define DMA_V(t,slot) do{ glds16s<0>(Vh+(long)(t)*KVBLK*PV,voff,(unsigned)__builtin_amdgcn_readfirstlane(vdst+2*(slot))); glds16s<0>(Vh+64+(long)(t)*KVBLK*PV,voff,(unsigned)__builtin_amdgcn_readfirstlane(vdst+2*(slot)+8192)); }while(0)
  const int vb0=(int)(lds0+LDS_V)+((lane>>4)&1)*32+(lane&3)*8+(4*hi+((lane&15)>>2))*64;
  const char*Kbase=shm+LDS_K; bf16x8 kf[8];
  const lds_cptr kp0=shm3+LDS_K+hi*1024+r32*16; const lds_cptr vp0=shm3+LDS_V+((lane>>4)&1)*32+(lane&3)*8+(4*hi+((lane&15)>>2))*64;
  const int NT=(q0+QB)/KVBLK;
  DMA_K(0,0);DMA_V(0,0);DMA_K(1,SLOTB);
  if(tid<256){ const int rel_=tid-191, n_=rel_<0?-rel_:rel_; const int bk_=(rel_>0?16:0)+(n_<8?n_:min(15,2+(31-__clz(n_*n_))));
    ((__attribute__((address_space(3))) float*)(shm3+LDS_BYTES))[tid]=(reltab[bk_*4+hd]-reltab[15*4+hd])*1.4426950408889634f; }
  const lds_cptr qlp0=shm3+LDS_OST+wid*4096+lane*16;
  { bf16x8 qr_[4];
    #pragma unroll
    for(int d0=0;d0<4;++d0)qr_[d0]=*reinterpret_cast<const bf16x8*>(&Qw[(long)r32*PQ+d0*16+hi*8]);
    #pragma unroll
    for(int d0=0;d0<4;++d0)*(__attribute__((address_space(3))) bf16x8*)(qlp0+d0*1024)=qr_[d0]; }
  #define QR(k) (*(const __attribute__((address_space(3))) bf16x8*)(qlp_+(k)*1024))
  bf16x8 qfr0;
  float mhat=0.f,l_reg=0.f;f32x16 o[4];o[0]=f32x16{};o[1]=f32x16{};o[2]=f32x16{};o[3]=f32x16{};
  const int wc2=wid>>1; const lds_fptr dtl=(lds_fptr)(shm3+LDS_BYTES)+191-(32*(wid&1)+r32)+4*hi;
  bool resc=false;
  #define START(P0,P1) do{ const float rm=rowmax(P0,P1); resc=false; \
    { const float dl=rm; mhat=fadd_s(mhat,dl); \
      _Pragma("unroll") for(int r=0;r<16;++r){P0[r]=fsub_s(P0[r],dl);P1[r]=fsub_s(P1[r],dl);} \
      } \
    _Pragma("unroll") for(int r=0;r<16;++r)P0[r]=__builtin_amdgcn_exp2f(P0[r]); }while(0)
  #define RESC() do{ if(resc){ asm volatile("s_waitcnt lgkmcnt(0)":::"memory"); \
      _Pragma("unroll") for(int d_=0;d_<4;++d_) _Pragma("unroll") for(int r=0;r<16;++r)o[d_][r]*=wsf[crow(r,hi)]; } }while(0)
  f32x16 pA0,pA1,pB0,pB1;
  int sl_prev=0,sl_cur=0,sl_next=SLOTB;
  #define ROT() do{sl_prev=sl_cur;sl_cur=sl_next;sl_next=(sl_next==(NSLOT-1)*SLOTB)?0:sl_next+SLOTB;}while(0)
  DMA_K(2,2*SLOTB);
  WAIT_BAR(3);
  { const int dist_=wc2+(NT-4); binit(pA0,pA1,dist_,dtl-64*dist_); }
  { bf16x8 qr_[4]; const lds_cptr qlp_=qlp0;
    #pragma unroll
    for(int d0=0;d0<4;++d0)qr_[d0]=QR(d0);
    qkt(pA0,pA1,Kbase,qr_,r32,hi); qfr0=qr_[0]; }asm volatile("s_nop 15\n\ts_nop 7":"+v"(pA0),"+v"(pA1));
  START(pA0,pA1);
  _Pragma("unroll") for(int r=0;r<16;++r)pA1[r]=__builtin_amdgcn_exp2f(pA1[r]);
  WAIT_BAR(0);
  DMA_K(3,0);DMA_V(1,SLOTB);
  ROT();
  kload8(kf,kp0+sl_cur);
  WAIT_BAR(3);
  s16x4 vlo[8],vhi[8]; u32x4 pw0,pw1,pw2,pw3;
  #define PKW(P,B) cvtpk_s(P[B],P[B+1])
  #define PAF(k) __builtin_bit_cast(bf16x8,pw##k)
  #define VFR(i) (bf16x8){vlo[i][0],vlo[i][1],vlo[i][2],vlo[i][3],vhi[i][0],vhi[i][1],vhi[i][2],vhi[i][3]}
  #define PIN(x) asm volatile("":"+v"(x))
  #define MX3(a,b,c) __builtin_fmaxf(__builtin_fmaxf((a),(b)),(c))
  #define GAPA(MF,A0,A1,A2,A3,W0,W1,PW) do{ MF; sacc+=A0; sacc+=A1; sacc+=A2; sacc+=A3; PIN(sacc); W0; W1; PIN(PW); SBAR(); }while(0)
  #define EX(v) __builtin_amdgcn_exp2f(v)
  #define GAPB2(MF,X,B) do{ MF; X[B]=EX(X[B]); X[B+1]=EX(X[B+1]); PIN(X); SBAR(); }while(0)
  #define VRD2(i) do{ vlo[i]=vtr(vp_+((((i)>>2)+2)*4096+((i)&3)*1024)); vhi[i]=vtr(vp_+((((i)>>2)+2)*4096+((i)&3)*1024+512)); }while(0)
  #define VRD(i) do{ vlo[i]=vtr(vp_+(((i)>>2)*4096+((i)&3)*1024)); vhi[i]=vtr(vp_+(((i)>>2)*4096+((i)&3)*1024+512)); }while(0)
  #define KRD(G,j) do{ if(G){ kload2(kf,kp0+sl_next,j); SBAR(); } }while(0)
  #define STEP(C0,C1,P0,P1,t,GK,GV,GL) do{ SBAR(); \
    const lds_cptr vp_=vp0+2*sl_prev; lds_cptr qlp_=qlp0; asm volatile("":"+v"(qlp_)); \
    const bf16x8 qB_=QR(1); \
    CINIT0(C0,t); VRD(0); SBAR(); float sacc=(P0[0]+P0[1]); \
    GAPA(C0=__builtin_amdgcn_mfma_f32_32x32x16_bf16(kf[0],qfr0,CSRC(C0),0,0,0), P0[2],P0[3],P0[4],P0[5],     pw0[0]=PKW(P0,0), pw0[1]=PKW(P0,2), pw0); \
    CINIT1(C1,t); VRD(4); SBAR(); GAPA(C1=__builtin_amdgcn_mfma_f32_32x32x16_bf16(kf[1],qfr0,CSRC(C1),0,0,0), P0[6],P0[7],P0[8],P0[9],     pw0[2]=PKW(P0,4), pw0[3]=PKW(P0,6), pw0); \
    const bf16x8 qC_=QR(2); VRD(1); SBAR(); GAPA(C0=__builtin_amdgcn_mfma_f32_32x32x16_bf16(kf[2],qB_,C0,0,0,0),   P0[10],P0[11],P0[12],P0[13], pw1[0]=PKW(P0,8), pw1[1]=PKW(P0,10), pw1); \
    VRD(5); SBAR(); GAPA(C1=__builtin_amdgcn_mfma_f32_32x32x16_bf16(kf[3],qB_,C1,0,0,0),   P0[14],P0[15],P1[0],P1[1],   pw1[2]=PKW(P0,12),pw1[3]=PKW(P0,14), pw1); \
    const bf16x8 qD_=QR(3); VRD(2); SBAR(); GAPA(C0=__builtin_amdgcn_mfma_f32_32x32x16_bf16(kf[4],qC_,C0,0,0,0),   P1[2],P1[3],P1[4],P1[5],     pw2[0]=PKW(P1,0), pw2[1]=PKW(P1,2), pw2); \
    VRD(6); SBAR(); GAPA(C1=__builtin_amdgcn_mfma_f32_32x32x16_bf16(kf[5],qC_,C1,0,0,0),   P1[6],P1[7],P1[8],P1[9],     pw2[2]=PKW(P1,4), pw2[3]=PKW(P1,6), pw2); \
    VRD(3); SBAR(); GAPA(C0=__builtin_amdgcn_mfma_f32_32x32x16_bf16(kf[6],qD_,C0,0,0,0),   P1[10],P1[11],P1[12],P1[13], pw3[0]=PKW(P1,8), pw3[1]=PKW(P1,10), pw3); \
    VRD(7); SBAR(); GAPA(C1=__builtin_amdgcn_mfma_f32_32x32x16_bf16(kf[7],qD_,C1,0,0,0),   P1[14],P1[15],0.f,0.f,       pw3[2]=PKW(P1,12),pw3[3]=PKW(P1,14), pw3); \
    l_reg+=sacc; \
    if(GK){DMA_K((t)+3,sl_cur);} if(GV){DMA_V((t)+1,sl_next);} \
    CPOST(C0,C1); \
    { float a=MX3(C0[0],C0[1],C1[0]),b=MX3(C0[2],C0[3],C1[1]); a=MX3(a,C1[2],C1[3]); \
      _Pragma("unroll") for(int r=4;r<16;r+=4){a=MX3(a,C0[r],C0[r+1]);b=MX3(b,C0[r+2],C0[r+3]);a=MX3(a,C1[r],C1[r+1]);b=MX3(b,C1[r+2],C1[r+3]);} \
      float rm=__builtin_fmaxf(a,b); { auto rr=__builtin_amdgcn_permlane32_swap(__float_as_uint(rm),__float_as_uint(rm),false,false); rm=__builtin_fmaxf(__uint_as_float(rr[0]),__uint_as_float(rr[1])); } \
      resc=false; \
      if(__builtin_expect(__any(rm>(float)THRL),0)){ const float dl=__builtin_fmaxf(rm,0.f); mhat+=dl; \
        _Pragma("unroll") for(int r=0;r<16;++r){C0[r]-=dl;C1[r]-=dl;} \
        NEGM_UPD(); \
        const float f=__builtin_amdgcn_exp2f(-dl); l_reg*=f; if(hi==0)wsf[r32]=f; resc=true; } } \
    SBAR(); \
    GAPB2(o[0]=__builtin_amdgcn_mfma_f32_32x32x16_bf16(PAF(0),VFR(0),o[0],0,0,0), C0,0);  VRD2(0); SBAR(); \
    GAPB2(o[1]=__builtin_amdgcn_mfma_f32_32x32x16_bf16(PAF(0),VFR(4),o[1],0,0,0), C0,2);  VRD2(4); SBAR(); \
    KRD(GL,0); GAPB2(o[0]=__builtin_amdgcn_mfma_f32_32x32x16_bf16(PAF(1),VFR(1),o[0],0,0,0), C0,4);  VRD2(1); SBAR(); \
    KRD(GL,1); GAPB2(o[1]=__builtin_amdgcn_mfma_f32_32x32x16_bf16(PAF(1),VFR(5),o[1],0,0,0), C0,6);  VRD2(5); SBAR(); \
    KRD(GL,2); GAPB2(o[0]=__builtin_amdgcn_mfma_f32_32x32x16_bf16(PAF(2),VFR(2),o[0],0,0,0), C0,8);  VRD2(2); SBAR(); \
    KRD(GL,3); GAPB2(o[1]=__builtin_amdgcn_mfma_f32_32x32x16_bf16(PAF(2),VFR(6),o[1],0,0,0), C0,10); VRD2(6); SBAR(); \
    GAPB2(o[0]=__builtin_amdgcn_mfma_f32_32x32x16_bf16(PAF(3),VFR(3),o[0],0,0,0), C0,12); VRD2(3); SBAR(); \
    GAPB2(o[1]=__builtin_amdgcn_mfma_f32_32x32x16_bf16(PAF(3),VFR(7),o[1],0,0,0), C0,14); VRD2(7); SBAR(); \
    GAPB2(o[2]=__builtin_amdgcn_mfma_f32_32x32x16_bf16(PAF(0),VFR(0),o[2],0,0,0), C1,0); \
    GAPB2(o[3]=__builtin_amdgcn_mfma_f32_32x32x16_bf16(PAF(0),VFR(4),o[3],0,0,0), C1,2); \
    GAPB2(o[2]=__builtin_amdgcn_mfma_f32_32x32x16_bf16(PAF(1),VFR(1),o[2],0,0,0), C1,4); \
    GAPB2(o[3]=__builtin_amdgcn_mfma_f32_32x32x16_bf16(PAF(1),VFR(5),o[3],0,0,0), C1,6); \
    GAPB2(o[2]=__builtin_amdgcn_mfma_f32_32x32x16_bf16(PAF(2),VFR(2),o[2],0,0,0), C1,8); \
    GAPB2(o[3]=__builtin_amdgcn_mfma_f32_32x32x16_bf16(PAF(2),VFR(6),o[3],0,0,0), C1,10); \
    GAPB2(o[2]=__builtin_amdgcn_mfma_f32_32x32x16_bf16(PAF(3),VFR(3),o[2],0,0,0), C1,12); \
    GAPB2(o[3]=__builtin_amdgcn_mfma_f32_32x32x16_bf16(PAF(3),VFR(7),o[3],0,0,0), C1,14); \
    }while(0)
  int t=1;
  #define CINIT0(C,t) do{}while(0)
  #define CINIT1(C,t) do{}while(0)
  #define CSRC(C) (f32x16{})
  #define CPOST(C0,C1) bpost(C0,C1,mhat)
  #define NEGM_UPD() do{}while(0)
  for(;t+7<NT;t+=2){
    STEP(pB0,pB1,pA0,pA1,t,true,true,true);     WAIT_BAR(3); RESC(); ROT();
    STEP(pA0,pA1,pB0,pB1,t+1,true,true,true);   WAIT_BAR(3); RESC(); ROT();
  }
  #undef CINIT0
  #undef CINIT1
  #undef CSRC
  #undef CPOST
  #undef NEGM_UPD
  #define NEGM_UPD() do{}while(0)
  #define CINIT0(C,t) do{const int dist_=wc2+(NT-4-(t)); binit1(C,dist_,dtl-64*dist_);}while(0)
  #define CINIT1(C,t) do{const int dist_=wc2+(NT-4-(t)); binit1(C,dist_,dtl-64*dist_+32);}while(0)
  #define CSRC(C) C
  #define CPOST(C0,C1) bpost(C0,C1,mhat)
  #define ENDW(tt) do{ if((tt)+3<NT){WAIT_BAR(3);} else if((tt)+2<NT){WAIT_BAR(2);} else {WAIT_BAR(0);} }while(0)
  for(;t+1<NT;t+=2){
    STEP(pB0,pB1,pA0,pA1,t,(t+3<NT),(t+1<NT),(t+1<NT));       ENDW(t);   RESC(); ROT();
    STEP(pA0,pA1,pB0,pB1,t+1,(t+4<NT),(t+2<NT),(t+2<NT));     ENDW(t+1); RESC(); ROT();
  }
  STEP(pB0,pB1,pA0,pA1,NT-1,false,false,false); RESC();
  { float sacc=pB0[0]+pB0[1]; _Pragma("unroll") for(int r=2;r<16;++r)sacc+=pB0[r]; _Pragma("unroll") for(int r=0;r<16;++r)sacc+=pB1[r]; l_reg+=sacc;
    pw0=(u32x4){PKW(pB0,0),PKW(pB0,2),PKW(pB0,4),PKW(pB0,6)};pw1=(u32x4){PKW(pB0,8),PKW(pB0,10),PKW(pB0,12),PKW(pB0,14)};pw2=(u32x4){PKW(pB1,0),PKW(pB1,2),PKW(pB1,4),PKW(pB1,6)};pw3=(u32x4){PKW(pB1,8),PKW(pB1,10),PKW(pB1,12),PKW(pB1,14)};
    SBAR(); pv(o,vb0+2*sl_cur,PAF(0),PAF(1),PAF(2),PAF(3)); }
  #undef PKW
  #undef PAF
  #undef VFR
  #undef PIN
  #undef MX3
  #undef GAPA
  #undef GAPB2
  #undef VRD2
  #undef EX
  #undef VRD
  #undef KRD
  #undef STEP
  #undef ENDW
  {auto rr=__builtin_amdgcn_permlane32_swap(__float_as_uint(l_reg),__float_as_uint(l_reg),false,false);l_reg=__uint_as_float(rr[0])+__uint_as_float(rr[1]);}
  if(hi==0)wsf[32+r32]=l_reg;asm volatile("s_waitcnt lgkmcnt(0)":::"memory");
  float rli[16];
  #pragma unroll
  for(int r=0;r<16;++r)rli[r]=__builtin_amdgcn_rcpf(wsf[32+crow(r,hi)]);
  bf16*Ow=O+(rowbase+q0+wid*QBLK)*PO+ocol;
  { bf16*stg=(bf16*)(shm+LDS_OST)+wid*2048;
    #pragma unroll
    for(int hh=0;hh<2;++hh){
      #pragma unroll
      for(int r=0;r<16;++r){const int orow=crow(r,hi);
        #pragma unroll
        for(int d0=0;d0<2;++d0)stg[orow*64+d0*32+r32]=__float2bfloat16(o[2*hh+d0][r]*rli[r]);}
      asm volatile("s_waitcnt lgkmcnt(0)":::"memory");
      #pragma unroll
      for(int i=0;i<4;++i){const int row=i*8+(lane>>3),ch=lane&7; const u32x4 v=*(const u32x4*)(stg+row*64+ch*8); ATTN_STORE16(Ow+(long)row*PO+hh*64+ch*8,v);}
      asm volatile("s_waitcnt lgkmcnt(0)":::"memory"); } }
  asm volatile("s_waitcnt lgkmcnt(0)\n\ts_barrier":::"memory");
  #undef DMA_K
  #undef DMA_V
  #undef QR
  #undef CINIT0
  #undef CINIT1
  #undef CSRC
  #undef CPOST
  #undef NEGM_UPD
  #undef START
  #undef RESC
  #undef ROT
}
constexpr int ATTN_LDS_BYTES=LDS_BYTES+1024;
#undef SBAR
#undef WAIT_BAR
}

namespace cg = cooperative_groups;
constexpr int NWAVES = 8, NTHREADS = 512;
constexpr int MTOT = 33280, MPR = 32768, MSA = 512;
constexpr int DM = 1024, TP = 4096, TS = 16, NBP = 8, NBS = 32, PAST = 4096;
constexpr float EPS = 1e-6f, LOG2E = 1.4426950408889634f;
constexpr float LAM_INIT = 0.2f;
constexpr size_t O_YP = 0, O_YS = 33554432, O_KP = 34078720, O_VP = 50855936, O_CP = 67633152, O_MK = 67756032, O_MV = 68804608, O_KS = 69853184, O_VS = 70115328, O_CS = 70377472, O_END = 70868992;
constexpr size_t MiB = 1u << 20;
constexpr size_t WS_RS0 = 1 * MiB, WS_RSM = 1 * MiB + 256 * 1024, WS_SSP1 = 2 * MiB, WS_SSP2 = 5 * MiB, WS_QSS = 8 * MiB;
constexpr size_t WS_W1T = 12 * MiB, WS_WOT = 17 * MiB, WS_WMQT = 19 * MiB, WS_WMKVT = 20 * MiB, WS_WMOT = 22 * MiB, WS_WF1T = 23 * MiB, WS_WF2T = 31 * MiB;
constexpr size_t WS_MEMB = 40 * MiB, WS_MKB = 44 * MiB, WS_MVB = 54 * MiB;
constexpr size_t WS_XB = 64 * MiB, WS_Q = 130 * MiB, WS_KB = 163 * MiB, WS_VB = 196 * MiB, WS_C = 229 * MiB, WS_A3 = 294 * MiB, WS_OA = 360 * MiB;
constexpr size_t WS_X1 = 490 * MiB, WS_X1B = 620 * MiB, WS_QM = 685 * MiB, WS_OM = 718 * MiB, WS_X2B = 751 * MiB, WS_END = 816 * MiB;
constexpr size_t WS_PART = 426 * MiB;
#ifndef XREP
#define XREP 1
#endif
#ifndef SREP
#define SREP 1
#endif
constexpr int SNP = 4;
constexpr size_t WS_U = 64 * MiB;
static_assert(WS_U + (size_t)MTOT * 4096 * 2 <= WS_OA, "U overlay");
#ifndef PHMASK
#define PHMASK 0xFFFFF
#endif
#define PH(k) ((PHMASK >> (k)) & 1)
constexpr int LDS_BYTES = 147456;

#define LAS __attribute__((address_space(3)))
typedef unsigned short bf16;
typedef unsigned v4u __attribute__((ext_vector_type(4)));
typedef unsigned v2u __attribute__((ext_vector_type(2)));
typedef float f32x4 __attribute__((ext_vector_type(4)));
__device__ __forceinline__ unsigned f2bf(float f) { unsigned u = __builtin_bit_cast(unsigned, f); return (u + 0x7fffu + ((u >> 16) & 1u)) >> 16; }
__device__ __forceinline__ unsigned pk2(float lo, float hi) { return f2bf(lo) | (f2bf(hi) << 16); }
__device__ __forceinline__ float bf2f(unsigned h) { return __builtin_bit_cast(float, h << 16); }
__device__ __forceinline__ float wave_sum(float v) {
#pragma unroll
    for (int o = 1; o < 64; o <<= 1) v += __shfl_xor(v, o);
    return v;
}
__device__ __forceinline__ void unpack8(const v4u w, float* f) { f[0] = bf2f(w.x & 0xffffu); f[1] = bf2f(w.x >> 16); f[2] = bf2f(w.y & 0xffffu); f[3] = bf2f(w.y >> 16); f[4] = bf2f(w.z & 0xffffu); f[5] = bf2f(w.z >> 16); f[6] = bf2f(w.w & 0xffffu); f[7] = bf2f(w.w >> 16); }

struct Params { const float* in[31]; float* out; unsigned char* ws; };
enum { I_XP = 0, I_XS, I_CK, I_CV, I_CC, I_CMK, I_CMV, I_MEM, I_REL, I_GMIX, I_WIN, I_GQ, I_GK, I_LAM, I_GSUB, I_WCONV, I_BCONV, I_LNG, I_LNB, I_WOUT, I_GCROSS, I_GMEM, I_WMQ, I_WMK, I_WMV, I_GMQ, I_GMK, I_WMO, I_GFFN, I_WFF1, I_WFF2 };

__device__ __forceinline__ int rel_bucket(int rel) {
    const int n = rel < 0 ? -rel : rel; const int lg = n < 8 ? n : min(15, 2 + (31 - __clz(n * n)));
    return (rel > 0 ? 16 : 0) + lg;
}
#define RDL(x, d) __builtin_bit_cast(float, __builtin_amdgcn_readlane(__builtin_bit_cast(int, (x)), (d)))
__device__ __forceinline__ float compute_lam(const float* lv, int lane) {
    const float a = wave_sum(lv[lane] * lv[64 + lane]), b = wave_sum(lv[128 + lane] * lv[192 + lane]);
    return __expf(a) - __expf(b) + LAM_INIT;
}

__device__ __forceinline__ void p0_transpose_item(const float* W, int K, int N, const float* gain, bf16* WT, int dst_row0, LAS float* scr, int k0, int n0, int lane) {
    float wv[32];
#pragma unroll
    for (int i = 0; i < 32; ++i) wv[i] = W[(size_t)(k0 + 2 * i + (lane >> 5)) * N + n0 + (lane & 31)];
#pragma unroll
    for (int i = 0; i < 32; ++i) { const int kk = 2 * i + (lane >> 5); const float g = gain ? gain[k0 + kk] : 1.0f; scr[kk * 33 + (lane & 31)] = wv[i] * g; }
    asm volatile("s_waitcnt lgkmcnt(0)" ::: "memory");
    const int c = lane & 7;
#pragma unroll
    for (int j = 0; j < 4; ++j) { const int n = (lane >> 3) + 8 * j; const LAS float* s = scr + (8 * c) * 33 + n;
        v4u o; o.x = pk2(s[0 * 33], s[1 * 33]); o.y = pk2(s[2 * 33], s[3 * 33]); o.z = pk2(s[4 * 33], s[5 * 33]); o.w = pk2(s[6 * 33], s[7 * 33]);
        *(v4u*)(WT + (size_t)(dst_row0 + n) * K + k0 + 8 * c) = o; }
    asm volatile("s_waitcnt lgkmcnt(0)" ::: "memory");
}
__device__ __forceinline__ int w1_row(int a) {
    if (a < 1024) { const int pn = a >> 8, wc = (a >> 6) & 3, bj = (a >> 5) & 1; return 256 * pn + 128 * bj + 32 * wc; }
    if (a < 1536) return a;
    const int g = a >= 2048, ch = a - (g ? 2048 : 1536), t = ch >> 7, wc = (ch >> 5) & 3; return 1536 + 256 * t + 128 * g + 32 * wc;
}
template <int NR> __device__ __forceinline__ void rows_to_bf16_rs(const float* x0, bf16* o0, float* rs0, size_t row_step, int lane) {
    f32x4 v[NR][4];
#pragma unroll
    for (int i = 0; i < NR; ++i)
#pragma unroll
        for (int j = 0; j < 4; ++j) v[i][j] = __builtin_nontemporal_load((const f32x4*)(x0 + (size_t)i * row_step * 1024) + lane + 64 * j);
#pragma unroll
    for (int i = 0; i < NR; ++i) { float s = 0.f;
#pragma unroll
        for (int j = 0; j < 4; ++j) s += (v[i][j].x * v[i][j].x + v[i][j].y * v[i][j].y) + (v[i][j].z * v[i][j].z + v[i][j].w * v[i][j].w);
        s = wave_sum(s);
        unsigned long long* o8 = (unsigned long long*)(o0 + (size_t)i * row_step * 1024) + lane;
#pragma unroll
        for (int j = 0; j < 4; ++j) o8[64 * j] = (unsigned long long)pk2(v[i][j].x, v[i][j].y) | ((unsigned long long)pk2(v[i][j].z, v[i][j].w) << 32);
        if (lane == 0) rs0[(size_t)i * row_step] = 1.0f / sqrtf(s * (1.0f / 1024.0f) + EPS); }
}


#define XB_TMO      128
#define XB_XCNT(j)  (256  + 64 * (j))
#define XB_XSUB(j)  (1280 + 64 * (j))
#define XB_XGEN(j)  (2304 + 64 * (j))
#define XB_TOP      3328
#define XB_TOPGEN   3392
#define XCD_BAR_WORDS 3456
#define XB_SPIN_CAP (1u << 18)

__device__ __forceinline__ unsigned xb_ld(unsigned* p)              { return __hip_atomic_load(p, __ATOMIC_RELAXED, __HIP_MEMORY_SCOPE_AGENT); }
__device__ __forceinline__ unsigned xb_add(unsigned* p, unsigned v) { return __hip_atomic_fetch_add(p, v, __ATOMIC_RELAXED, __HIP_MEMORY_SCOPE_AGENT); }
__device__ __forceinline__ unsigned xb_xcc_id() { return (unsigned)__builtin_amdgcn_s_getreg((3 << 11) | 20) & 0xFu; }
#define XB_SPIN(cond, bar) do { unsigned _sp = 0; while (cond) { __builtin_amdgcn_s_sleep(1); \
    if ((++_sp & 255u) == 0u) { if (xb_ld(&(bar)[XB_TMO])) break; if (_sp > XB_SPIN_CAP) { atomicAdd(&(bar)[XB_TMO], 1u); break; } } } } while (0)

struct XcdBarrier {
    unsigned* bar; unsigned x;
    volatile LAS unsigned* st;
};

__device__ __forceinline__ XcdBarrier xcd_barrier_post(unsigned* bar, volatile LAS unsigned* st) {
    XcdBarrier b; b.bar = bar; b.x = xb_xcc_id(); b.st = st;
    if (threadIdx.x == 0) (void)xb_add(&bar[XB_XCNT(b.x)], 1u);
    return b;
}
__device__ __forceinline__ void xcd_barrier_complete(unsigned* bar, unsigned x, unsigned& nloc, unsigned& nx) {
    const unsigned G = gridDim.x * gridDim.y * gridDim.z;
    unsigned sum, cnt, mine, sp = 0u;
    for (;;) {
        sum = 0u; cnt = 0u; mine = 0u;
#pragma unroll
        for (unsigned j = 0; j < 16; ++j) { const unsigned c = xb_ld(&bar[XB_XCNT(j)]); sum += c; cnt += (c > 0u) ? 1u : 0u; mine = (j == x) ? c : mine; }
        if (sum == G) break;
        __builtin_amdgcn_s_sleep(1);
        if ((++sp & 255u) == 0u) { if (xb_ld(&bar[XB_TMO])) break; if (sp > XB_SPIN_CAP) { atomicAdd(&bar[XB_TMO], 1u); break; } }
    }
    nloc = mine > 0u ? mine : 1u; nx = cnt > 0u ? cnt : 1u;
}

__device__ __forceinline__ void xcd_barrier(const XcdBarrier& b) {
    asm volatile("s_waitcnt vmcnt(0)" ::: "memory");
    __syncthreads();
    if (threadIdx.x == 0) {
        unsigned* bar = b.bar;
        __builtin_amdgcn_s_waitcnt(0);
        unsigned nloc = b.st[0], nx = b.st[1];
        if (nloc == 0u) { xcd_barrier_complete(bar, b.x, nloc, nx); b.st[0] = nloc; b.st[1] = nx; }
        const unsigned old = xb_add(&bar[XB_XSUB(b.x)], 1u);
        const unsigned gen = old / nloc;
        if (old + 1u == (gen + 1u) * nloc) {
            __builtin_amdgcn_fence(__ATOMIC_RELEASE, "agent");
            asm volatile("s_waitcnt vmcnt(0)" ::: "memory");
            const unsigned og = xb_add(&bar[XB_TOP], 1u);
            const unsigned tg = og / nx;
            if (og + 1u == (tg + 1u) * nx) xb_add(&bar[XB_TOPGEN], 1u);
            else XB_SPIN(xb_ld(&bar[XB_TOPGEN]) == tg, bar);
            __builtin_amdgcn_fence(__ATOMIC_ACQUIRE, "agent");
            xb_add(&bar[XB_XGEN(b.x)], 1u);
            asm volatile("s_waitcnt vmcnt(0)" ::: "memory");
        } else {
            XB_SPIN(xb_ld(&bar[XB_XGEN(b.x)]) == gen, bar);
            __builtin_amdgcn_fence(__ATOMIC_ACQUIRE, "agent");
            asm volatile("s_waitcnt vmcnt(0)" ::: "memory");
        }
    }
    __syncthreads();
}


__device__ __forceinline__ void mk_row(int r, int lane, float* mko, const float* cmk, const float* gmk, const float* gmq, bf16* MKB) {
    f32x4 a, b;
    if (r < 2048) {
        float* mk = mko + (size_t)r * 512 + lane * 8; a = *(f32x4*)mk; b = *(f32x4*)(mk + 4);
        float ss = (a.x * a.x + a.y * a.y) + (a.z * a.z + a.w * a.w) + (b.x * b.x + b.y * b.y) + (b.z * b.z + b.w * b.w);
        ss += __shfl_xor(ss, 1); ss += __shfl_xor(ss, 2); ss += __shfl_xor(ss, 4); ss += __shfl_xor(ss, 8);
        const float rstd = 1.0f / sqrtf(ss * (1.0f / 128.0f) + EPS); const float* g = gmk + (lane & 15) * 8;
        a = a * *(const f32x4*)g * rstd; b = b * *(const f32x4*)(g + 4) * rstd;
        *(f32x4*)mk = a; *(f32x4*)(mk + 4) = b;
    } else { const float* mk = cmk + (size_t)(r - 2048) * 512 + lane * 8; a = *(const f32x4*)mk; b = *(const f32x4*)(mk + 4); }
    const float* gq = gmq + (lane & 15) * 8; a = a * *(const f32x4*)gq; b = b * *(const f32x4*)(gq + 4);
    v4u o; o.x = pk2(a.x, a.y); o.y = pk2(a.z, a.w); o.z = pk2(b.x, b.y); o.w = pk2(b.z, b.w);
    *(v4u*)(MKB + (size_t)r * 512 + lane * 8) = o;
}
__device__ __forceinline__ void mvt_item(int it, int lane, const float* mvp, const float* cmv, bf16* MVT) {
    const int kg = it & 7, head = (it >> 3) & 3, bb = it >> 5;
    const float* vsrc = (bb < 8 ? mvp + (size_t)bb * 256 * 512 : cmv + (size_t)(bb - 8) * 256 * 512) + (size_t)(32 * kg) * 512 + head * 128;
#pragma unroll 1
    for (int half = 0; half < 2; ++half) { const int e = lane + 64 * half; float v[32];
#pragma unroll
        for (int k = 0; k < 32; ++k) v[k] = vsrc[(size_t)k * 512 + e];
        bf16* dst = MVT + ((size_t)(bb * 4 + head) * 128 + e) * 256 + 32 * kg;
#pragma unroll
        for (int g = 0; g < 4; ++g) { v4u o; o.x = pk2(v[4 * g], v[4 * g + 1]); o.y = pk2(v[4 * g + 2], v[4 * g + 3]); o.z = pk2(v[16 + 4 * g], v[16 + 4 * g + 1]); o.w = pk2(v[16 + 4 * g + 2], v[16 + 4 * g + 3]); *(v4u*)(dst + 8 * g) = o; }
    }
}

__device__ __forceinline__ bool static_unit0(int nM, int nN, int G, int c, int& pm, int& pn) {
    const int nwg = nM * nN; if (c >= nwg) return false;
    const int q = nwg / 8, r = nwg % 8, xcd = c % 8, off = c / 8; const int wgid = (xcd < r ? xcd * (q + 1) : r * (q + 1) + (xcd - r) * q) + off;
    const int nig = 8 * nN, gid = wgid / nig, fm = gid * 8, gsz = (nM - fm) < 8 ? (nM - fm) : 8;
    pm = fm + ((wgid % nig) % gsz); pn = (wgid % nig) / gsz; return true;
}

typedef short s16x4 __attribute__((ext_vector_type(4)));
constexpr int PART_STRIDE = 132;
template <int NS> __device__ __forceinline__ void sample_attn_task(int b, int h, int sp, int lane_in, int wave, LAS unsigned char* lds, const bf16* QB, const float* ck, const float* cv, const float* kn, const float* vn, const float* rel, float* PART) {
    int lane = lane_in; asm volatile("" : "+v"(lane));
    const int c = lane & 15, g = lane >> 4;
    const int T0 = (257 * sp) / NS, T1 = (257 * (sp + 1)) / NS;
#if QEXP
    const int tmask_ = (PART == nullptr) ? 0 : -1; if (PART == nullptr) PART = (float*)QB + (490u << 18) - (130u << 18);
#endif
    pg8::bf16x8 qf[2][2];
#pragma unroll
    for (int m = 0; m < 2; ++m)
#pragma unroll
        for (int s2 = 0; s2 < 2; ++s2) qf[m][s2] = *(const pg8::bf16x8*)(QB + (size_t)(MPR + b * 16 + c) * 512 + (2 * h + m) * 64 + 32 * s2 + 8 * g);
    f32x4 O[2][8]; float mx[2], ls[2];
#pragma unroll
    for (int m = 0; m < 2; ++m) { mx[m] = -1e30f; ls[m] = 0.f;
#pragma unroll
        for (int et = 0; et < 8; ++et) O[m][et] = (f32x4){0.f, 0.f, 0.f, 0.f}; }
    const float* Kc = ck + (size_t)b * PAST * 512; const float* Kn = kn + (size_t)b * 16 * 512;
    const unsigned kl = (unsigned)(size_t)(lds + wave * 16384);
    const unsigned dA = (unsigned)((lane >> 5) * 2048 + (2 * h + ((lane >> 4) & 1)) * 256), dP = (unsigned)((lane & 15) ^ (lane >> 5));
    const unsigned rA = kl + (unsigned)(2 * c * 256), rX = (unsigned)(c ^ (2 * g));
    const float* Vc = cv + (size_t)b * PAST * 512; const float* Vn = vn + (size_t)b * 16 * 512;
    const unsigned voff = (unsigned)((4 * g * 512 + h * 128 + 4 * c) * 4);
    f32x4 rk[2][2][2]; f32x4 rvA[2][4], rvB[2][4];
#define SA_VLD(dst, base, IMM) asm volatile("global_load_dwordx4 %0, %1, %2 offset:" #IMM : "=&v"(dst) : "v"(voff), "s"(base) : "memory")
#define SA_ISSUE(rv, buf, tt) do { const int tq_ = (tt); const float* kb_ = tq_ < 256 ? Kc + (size_t)(16 * tq_) * 512 : Kn; const char* vb_ = (const char*)(tq_ < 256 ? Vc + (size_t)(16 * tq_) * 512 : Vn); const char* vb2_ = vb_ + 4096; \
        SA_VLD(rv[0][0], vb_, 0); SA_VLD(rv[0][1], vb_, 2048); SA_VLD(rv[0][2], vb2_, 0); SA_VLD(rv[0][3], vb2_, 2048); \
        SA_VLD(rv[1][0], vb_, 256); SA_VLD(rv[1][1], vb_, 2304); SA_VLD(rv[1][2], vb2_, 256); SA_VLD(rv[1][3], vb2_, 2304); \
        _Pragma("unroll") for (int i = 0; i < 8; ++i) attn2::glds16s<0>(kb_, dA + i * 4096 + ((dP ^ (2 * i)) << 4), (unsigned)__builtin_amdgcn_readfirstlane(kl + (buf) * 8192 + i * 1024)); } while (0)
    float relv = rel[(lane & 31) * 4 + h];
    SA_ISSUE(rvA, 0, T0); SA_ISSUE(rvB, 1, min(T0 + 1, T1 - 1));
#pragma unroll
    for (int m = 0; m < 2; ++m)
#pragma unroll
        for (int s2 = 0; s2 < 2; ++s2) asm volatile("" : "+v"(qf[m][s2]));
    asm volatile("" : "+v"(relv));
    const float far = __builtin_bit_cast(float, __builtin_amdgcn_readlane(__builtin_bit_cast(int, relv), 15));
#define SA_STEP(rv, buf, tt, PADCHK) do { const int t_ = (tt); \
        pg8::bf16x8 kf[2][2]; s16x4 vf[8]; \
        asm volatile("s_waitcnt vmcnt(16)" : "+v"(rv[0][0]), "+v"(rv[0][1]), "+v"(rv[0][2]), "+v"(rv[0][3]), "+v"(rv[1][0]), "+v"(rv[1][1]), "+v"(rv[1][2]), "+v"(rv[1][3]) :: "memory");     \
        _Pragma("unroll") for (int m = 0; m < 2; ++m) _Pragma("unroll") for (int s2 = 0; s2 < 2; ++s2) _Pragma("unroll") for (int e = 0; e < 2; ++e) rk[m][s2][e] = *(const LAS f32x4*)(size_t)(rA + (buf) * 8192 + m * 256 + ((rX ^ (8 * s2 + e)) << 4)); \
        _Pragma("unroll") for (int m = 0; m < 2; ++m) _Pragma("unroll") for (int s2 = 0; s2 < 2; ++s2) { v4u w; w.x = attn_body::cvtpk_s(rk[m][s2][0].x, rk[m][s2][0].y); w.y = attn_body::cvtpk_s(rk[m][s2][0].z, rk[m][s2][0].w); w.z = attn_body::cvtpk_s(rk[m][s2][1].x, rk[m][s2][1].y); w.w = attn_body::cvtpk_s(rk[m][s2][1].z, rk[m][s2][1].w); kf[m][s2] = __builtin_bit_cast(pg8::bf16x8, w); } \
        _Pragma("unroll") for (int et = 0; et < 8; ++et) { v2u w; w.x = attn_body::cvtpk_s(rv[et >> 2][0][et & 3], rv[et >> 2][1][et & 3]); w.y = attn_body::cvtpk_s(rv[et >> 2][2][et & 3], rv[et >> 2][3][et & 3]); vf[et] = __builtin_bit_cast(s16x4, w); } \
        asm volatile("s_waitcnt lgkmcnt(0)" :: "v"(vf[0]), "v"(vf[1]), "v"(vf[2]), "v"(vf[3]), "v"(vf[4]), "v"(vf[5]), "v"(vf[6]), "v"(vf[7]) : "memory");      \
        SA_ISSUE(rv, buf, min(t_ + 2, T1 - 1)); \
        const bool near = t_ >= 244;                       \
        _Pragma("unroll") for (int m = 0; m < 2; ++m) { \
            f32x4 sc = (f32x4){0.f, 0.f, 0.f, 0.f}; \
            sc = __builtin_amdgcn_mfma_f32_16x16x32_bf16(kf[m][0], qf[m][0], sc, 0, 0, 0); sc = __builtin_amdgcn_mfma_f32_16x16x32_bf16(kf[m][1], qf[m][1], sc, 0, 0, 0); \
            if (near) { _Pragma("unroll") for (int r = 0; r < 4; ++r) sc[r] += (__builtin_bit_cast(float, __builtin_amdgcn_ds_bpermute(rel_bucket(16 * t_ + 4 * g + r - (PAST + c)) * 4, __builtin_bit_cast(int, relv))) - far) * LOG2E; } \
            if (PADCHK) { const bool pad_ = t_ >= T1;         \
                _Pragma("unroll") for (int r = 0; r < 4; ++r) sc[r] = pad_ ? -1e30f : sc[r]; } \
            float tm = fmaxf(fmaxf(sc.x, sc.y), fmaxf(sc.z, sc.w)); tm = fmaxf(tm, __shfl_xor(tm, 16)); tm = fmaxf(tm, __shfl_xor(tm, 32)); \
            if (__any(tm > mx[m])) { const float mn = fmaxf(mx[m], tm), al = __builtin_amdgcn_exp2f(mx[m] - mn); mx[m] = mn; ls[m] *= al; \
                _Pragma("unroll") for (int et = 0; et < 8; ++et) O[m][et] *= al; } \
            float ps = 0.f; \
            _Pragma("unroll") for (int r = 0; r < 4; ++r) { sc[r] = __builtin_amdgcn_exp2f(sc[r] - mx[m]); ps += sc[r]; } \
            ls[m] += ps; \
            v2u pw; pw.x = attn_body::cvtpk_s(sc.x, sc.y); pw.y = attn_body::cvtpk_s(sc.z, sc.w); const s16x4 pb = __builtin_bit_cast(s16x4, pw); \
            _Pragma("unroll") for (int et = 0; et < 8; ++et) O[m][et] = __builtin_amdgcn_mfma_f32_16x16x16bf16_1k(vf[et], pb, O[m][et], 0, 0, 0); } \
    } while (0)
#pragma unroll 1
    for (int t = T0; t < T1; t += 2) {
        SA_STEP(rvA, 0, t, false);
        SA_STEP(rvB, 1, t + 1, true);
    }
    asm volatile("s_waitcnt vmcnt(0)" : "+v"(rvA[0][0]), "+v"(rvA[0][1]), "+v"(rvA[0][2]), "+v"(rvA[0][3]), "+v"(rvA[1][0]), "+v"(rvA[1][1]), "+v"(rvA[1][2]), "+v"(rvA[1][3]) :: "memory");
    asm volatile("" : "+v"(rvB[0][0]), "+v"(rvB[0][1]), "+v"(rvB[0][2]), "+v"(rvB[0][3]), "+v"(rvB[1][0]), "+v"(rvB[1][1]), "+v"(rvB[1][2]), "+v"(rvB[1][3]) :: "memory");
#undef SA_STEP
#undef SA_ISSUE
#undef SA_VLD
#pragma unroll
    for (int m = 0; m < 2; ++m) { float l = ls[m]; l += __shfl_xor(l, 16); l += __shfl_xor(l, 32);
        float* pd = PART + ((size_t)(((b * 4 + h) * NS + sp) * 2 + m) * 16 + c) * PART_STRIDE;
#pragma unroll
        for (int hf = 0; hf < 2; ++hf)
#pragma unroll
            for (int r = 0; r < 4; ++r) *(f32x4*)(pd + 64 * hf + 16 * g + 4 * r) = (f32x4){O[m][4 * hf][r], O[m][4 * hf + 1][r], O[m][4 * hf + 2][r], O[m][4 * hf + 3][r]};
        if (g == 0) { pd[128] = mx[m]; pd[129] = l; } }
}

__device__ __forceinline__ void conv_finish(f32x4 (&acc)[4][2], int r0, int ch0, const float* lng, const float* lnb, bf16* A3) {
    const f32x4 g0 = *(const f32x4*)(lng + ch0), g1 = *(const f32x4*)(lng + ch0 + 4), bb0 = *(const f32x4*)(lnb + ch0), bb1 = *(const f32x4*)(lnb + ch0 + 4);
#pragma unroll
    for (int o = 0; o < 4; ++o) {
        f32x4 a0 = acc[o][0], a1 = acc[o][1];
        const float mean = wave_sum((a0.x + a0.y) + (a0.z + a0.w) + (a1.x + a1.y) + (a1.z + a1.w)) * (1.0f / 512.0f);
        a0 = a0 - mean; a1 = a1 - mean;
        const float rstd = 1.0f / sqrtf(wave_sum((a0.x * a0.x + a0.y * a0.y) + (a0.z * a0.z + a0.w * a0.w) + (a1.x * a1.x + a1.y * a1.y) + (a1.z * a1.z + a1.w * a1.w)) * (1.0f / 512.0f) + EPS);
        a0 = a0 * rstd * g0 + bb0; a1 = a1 * rstd * g1 + bb1;
        float y[8] = {a0.x, a0.y, a0.z, a0.w, a1.x, a1.y, a1.z, a1.w};
#pragma unroll
        for (int e = 0; e < 8; ++e) y[e] = y[e] / (1.0f + __expf(-y[e]));
        v4u w; w.x = pk2(y[0], y[1]); w.y = pk2(y[2], y[3]); w.z = pk2(y[4], y[5]); w.w = pk2(y[6], y[7]);
        *(v4u*)(A3 + (size_t)(r0 + o) * 1024 + 512 + ch0) = w;
    }
}
constexpr int CONV_TAPS_BYTES = 31 * 2048, CONV_ROWS_OFF = CONV_TAPS_BYTES;
__device__ __forceinline__ void conv_item_prompt(int ct, int tid_in, const bf16* CB, LAS unsigned char* lds, const float* bconv, const float* lng, const float* lnb, bf16* A3) {
    int tid = tid_in; asm volatile("" : "+v"(tid));
    const int lane = tid & 63, wave = __builtin_amdgcn_readfirstlane(tid >> 6);
    const int r0b = ct * 32, b = r0b >> 12, t0b = r0b & 4095;
    const bf16* cbase = CB + (size_t)(b * 4096) * 512;
#pragma unroll
    for (int q = 0; q < 8; ++q) { const int i = tid + 512 * q; if (i < 62 * 64) { const int j = i >> 6, tt = t0b - 30 + j; const unsigned msk = tt >= 0 ? 0xffffffffu : 0u;
        v4u v = *(const v4u*)(cbase + (size_t)(tt >= 0 ? tt : 0) * 512 + (i & 63) * 8); v.x &= msk; v.y &= msk; v.z &= msk; v.w &= msk;
        *(LAS v4u*)(lds + CONV_ROWS_OFF + (size_t)i * 16) = v; } }
    __syncthreads();
    const int ch0 = lane * 8, r0 = r0b + 4 * wave;
    f32x4 acc[4][2], W[4][2];
    { const f32x4 b0 = *(const f32x4*)(bconv + ch0), b1 = *(const f32x4*)(bconv + ch0 + 4);
#pragma unroll
        for (int o = 0; o < 4; ++o) { acc[o][0] = b0; acc[o][1] = b1; W[o][0] = (f32x4){0.f, 0.f, 0.f, 0.f}; W[o][1] = (f32x4){0.f, 0.f, 0.f, 0.f}; } }
    const LAS unsigned char* crow = lds + CONV_ROWS_OFF + (size_t)(4 * wave) * 1024 + lane * 16; const LAS unsigned char* wl = lds + lane * 16;
#pragma unroll 1
    for (int k = 0; k < 9; ++k) {
#pragma unroll
        for (int rr = 0; rr < 4; ++rr) { const int i = 4 * k + rr;
            f32x4 c0 = (f32x4){0.f, 0.f, 0.f, 0.f}, c1 = c0;
            if (i < 34) { float f[8]; unpack8(*(const LAS v4u*)(crow + (size_t)i * 1024), f); c0 = (f32x4){f[0], f[1], f[2], f[3]}; c1 = (f32x4){f[4], f[5], f[6], f[7]}; }
            if (i < 31) { W[rr][0] = *(const LAS f32x4*)(wl + (size_t)i * 2048); W[rr][1] = *(const LAS f32x4*)(wl + (size_t)i * 2048 + 1024); } else { W[rr][0] = (f32x4){0.f, 0.f, 0.f, 0.f}; W[rr][1] = W[rr][0]; }
#pragma unroll
            for (int o = 0; o < 4; ++o) { acc[o][0] += W[(rr - o) & 3][0] * c0; acc[o][1] += W[(rr - o) & 3][1] * c1; } }
    }
    conv_finish(acc, r0, ch0, lng, lnb, A3);
}
__device__ __forceinline__ void conv_task_sample(int task, int lane_in, const bf16* CB, const float* cc, const float* wconv, const float* bconv, const float* lng, const float* lnb, bf16* A3) {
    int lane = lane_in; asm volatile("" : "+v"(lane));
    const int r0 = MPR + task * 4, b = (r0 - MPR) >> 4, t0 = (r0 - MPR) & 15, rb = MPR + b * 16, ch0 = lane * 8;
    f32x4 acc[4][2], W[4][2];
    { const f32x4 b0 = *(const f32x4*)(bconv + ch0), b1 = *(const f32x4*)(bconv + ch0 + 4);
#pragma unroll
        for (int o = 0; o < 4; ++o) { acc[o][0] = b0; acc[o][1] = b1; W[o][0] = (f32x4){0.f, 0.f, 0.f, 0.f}; W[o][1] = (f32x4){0.f, 0.f, 0.f, 0.f}; } }
    const bf16* cbase = CB + (size_t)rb * 512 + ch0; const float* ccb = cc + (size_t)(b * 30 + 30) * 512 + ch0; const float* wb = wconv + ch0;
#pragma unroll 1
    for (int k = 0; k < 9; ++k) {
#pragma unroll
        for (int rr = 0; rr < 4; ++rr) { const int i = 4 * k + rr, tt = t0 - 30 + i;
            f32x4 c0 = (f32x4){0.f, 0.f, 0.f, 0.f}, c1 = c0;
            if (i < 34) { if (tt >= 0) { float f[8]; unpack8(*(const v4u*)(cbase + (size_t)tt * 512), f); c0 = (f32x4){f[0], f[1], f[2], f[3]}; c1 = (f32x4){f[4], f[5], f[6], f[7]}; } else { c0 = *(const f32x4*)(ccb + (ptrdiff_t)tt * 512); c1 = *(const f32x4*)(ccb + (ptrdiff_t)tt * 512 + 4); } }
            if (i < 31) { W[rr][0] = *(const f32x4*)(wb + i * 512); W[rr][1] = *(const f32x4*)(wb + i * 512 + 4); } else { W[rr][0] = (f32x4){0.f, 0.f, 0.f, 0.f}; W[rr][1] = W[rr][0]; }
#pragma unroll
            for (int o = 0; o < 4; ++o) { acc[o][0] += W[(rr - o) & 3][0] * c0; acc[o][1] += W[(rr - o) & 3][1] * c1; } }
    }
    conv_finish(acc, r0, ch0, lng, lnb, A3);
}

#define XATTN_GROUP(qrow, od, g, KLD, VLD) do { \
    pg8::bf16x8 qf[4]; float ss = 0.f; \
    _Pragma("unroll") for (int s4 = 0; s4 < 4; ++s4) { const v4u w = *(const v4u*)((qrow) + 32 * s4 + 8 * (g)); qf[s4] = __builtin_bit_cast(pg8::bf16x8, w); float f[8]; unpack8(w, f); \
        _Pragma("unroll") for (int e = 0; e < 8; ++e) ss += f[e] * f[e]; } \
    ss += __shfl_xor(ss, 16); ss += __shfl_xor(ss, 32); \
    const float qs = (1.0f / sqrtf(ss * (1.0f / 128.0f) + EPS)) * (0.08838834764831845f * LOG2E); \
    f32x4 Oacc[8]; float mx = -1e30f, l = 0.f; \
    _Pragma("unroll") for (int et = 0; et < 8; ++et) Oacc[et] = (f32x4){0.f, 0.f, 0.f, 0.f}; \
    _Pragma("unroll 1") for (int ch = 0; ch < 4; ++ch) {        \
        f32x4 st[4]; float cm = -1e30f; \
        _Pragma("unroll") for (int kt = 0; kt < 4; ++kt) { f32x4 acc = (f32x4){0.f, 0.f, 0.f, 0.f}; \
            _Pragma("unroll") for (int s4 = 0; s4 < 4; ++s4) { const pg8::bf16x8 kf = KLD(4 * ch + kt, s4); acc = __builtin_amdgcn_mfma_f32_16x16x32_bf16(kf, qf[s4], acc, 0, 0, 0); } \
            st[kt] = acc * qs; cm = fmaxf(cm, fmaxf(fmaxf(st[kt].x, st[kt].y), fmaxf(st[kt].z, st[kt].w))); } \
        cm = fmaxf(cm, __shfl_xor(cm, 16)); cm = fmaxf(cm, __shfl_xor(cm, 32)); \
        const float mn = fmaxf(mx, cm), al = __builtin_amdgcn_exp2f(mx - mn); mx = mn; l *= al; \
        _Pragma("unroll") for (int et = 0; et < 8; ++et) Oacc[et] *= al; \
        pg8::bf16x8 pb[2]; \
        _Pragma("unroll") for (int kp = 0; kp < 2; ++kp) { f32x4 p0 = st[2 * kp], p1 = st[2 * kp + 1]; \
            _Pragma("unroll") for (int e = 0; e < 4; ++e) { p0[e] = __builtin_amdgcn_exp2f(p0[e] - mx); p1[e] = __builtin_amdgcn_exp2f(p1[e] - mx); l += p0[e] + p1[e]; } \
            v4u w; w.x = attn_body::cvtpk_s(p0.x, p0.y); w.y = attn_body::cvtpk_s(p0.z, p0.w); w.z = attn_body::cvtpk_s(p1.x, p1.y); w.w = attn_body::cvtpk_s(p1.z, p1.w); pb[kp] = __builtin_bit_cast(pg8::bf16x8, w); } \
        _Pragma("unroll") for (int et = 0; et < 8; ++et) \
            _Pragma("unroll") for (int kp = 0; kp < 2; ++kp) { const pg8::bf16x8 vf = VLD(et, 2 * ch + kp); Oacc[et] = __builtin_amdgcn_mfma_f32_16x16x32_bf16(vf, pb[kp], Oacc[et], 0, 0, 0); } \
    } \
    l += __shfl_xor(l, 16); l += __shfl_xor(l, 32); const float il = 1.0f / l; \
    _Pragma("unroll") for (int et = 0; et < 8; ++et) { v2u w; w.x = attn_body::cvtpk_s(Oacc[et].x * il, Oacc[et].y * il); w.y = attn_body::cvtpk_s(Oacc[et].z * il, Oacc[et].w * il); *(v2u*)((od) + 16 * et) = w; } \
} while (0)
#define XATTN_GROUP2(qrow0, qrow1, od0, od1, g, KLD, VLD) do { \
    pg8::bf16x8 qf[2][4]; float qs[2]; \
    _Pragma("unroll") for (int u = 0; u < 2; ++u) { float ss = 0.f; const bf16* qrow_ = u ? (qrow1) : (qrow0); \
        _Pragma("unroll") for (int s4 = 0; s4 < 4; ++s4) { const v4u w = *(const v4u*)(qrow_ + 32 * s4 + 8 * (g)); qf[u][s4] = __builtin_bit_cast(pg8::bf16x8, w); float f[8]; unpack8(w, f); \
            _Pragma("unroll") for (int e = 0; e < 8; ++e) ss += f[e] * f[e]; } \
        ss += __shfl_xor(ss, 16); ss += __shfl_xor(ss, 32); \
        qs[u] = (1.0f / sqrtf(ss * (1.0f / 128.0f) + EPS)) * (0.08838834764831845f * LOG2E); } \
    f32x4 Oacc[2][8]; float mx[2] = {-1e30f, -1e30f}, l[2] = {0.f, 0.f}; \
    _Pragma("unroll") for (int u = 0; u < 2; ++u) _Pragma("unroll") for (int et = 0; et < 8; ++et) Oacc[u][et] = (f32x4){0.f, 0.f, 0.f, 0.f}; \
    _Pragma("unroll 1") for (int ch = 0; ch < 4; ++ch) {        \
        f32x4 st[2][4]; float cm[2] = {-1e30f, -1e30f}; \
        _Pragma("unroll") for (int kt = 0; kt < 4; ++kt) { f32x4 acc0 = (f32x4){0.f, 0.f, 0.f, 0.f}, acc1 = acc0; \
            _Pragma("unroll") for (int s4 = 0; s4 < 4; ++s4) { const pg8::bf16x8 kf = KLD(4 * ch + kt, s4); acc0 = __builtin_amdgcn_mfma_f32_16x16x32_bf16(kf, qf[0][s4], acc0, 0, 0, 0); acc1 = __builtin_amdgcn_mfma_f32_16x16x32_bf16(kf, qf[1][s4], acc1, 0, 0, 0); } \
            st[0][kt] = acc0 * qs[0]; st[1][kt] = acc1 * qs[1]; \
            cm[0] = fmaxf(cm[0], fmaxf(fmaxf(st[0][kt].x, st[0][kt].y), fmaxf(st[0][kt].z, st[0][kt].w))); cm[1] = fmaxf(cm[1], fmaxf(fmaxf(st[1][kt].x, st[1][kt].y), fmaxf(st[1][kt].z, st[1][kt].w))); } \
        pg8::bf16x8 pb[2][2]; \
        _Pragma("unroll") for (int u = 0; u < 2; ++u) { \
            cm[u] = fmaxf(cm[u], __shfl_xor(cm[u], 16)); cm[u] = fmaxf(cm[u], __shfl_xor(cm[u], 32)); \
            const float mn = fmaxf(mx[u], cm[u]), al = __builtin_amdgcn_exp2f(mx[u] - mn); mx[u] = mn; l[u] *= al; \
            _Pragma("unroll") for (int et = 0; et < 8; ++et) Oacc[u][et] *= al; \
            _Pragma("unroll") for (int kp = 0; kp < 2; ++kp) { f32x4 p0 = st[u][2 * kp], p1 = st[u][2 * kp + 1]; \
                _Pragma("unroll") for (int e = 0; e < 4; ++e) { p0[e] = __builtin_amdgcn_exp2f(p0[e] - mx[u]); p1[e] = __builtin_amdgcn_exp2f(p1[e] - mx[u]); l[u] += p0[e] + p1[e]; } \
                v4u w; w.x = attn_body::cvtpk_s(p0.x, p0.y); w.y = attn_body::cvtpk_s(p0.z, p0.w); w.z = attn_body::cvtpk_s(p1.x, p1.y); w.w = attn_body::cvtpk_s(p1.z, p1.w); pb[u][kp] = __builtin_bit_cast(pg8::bf16x8, w); } } \
        _Pragma("unroll") for (int et = 0; et < 8; ++et) \
            _Pragma("unroll") for (int kp = 0; kp < 2; ++kp) { const pg8::bf16x8 vf = VLD(et, 2 * ch + kp); \
                Oacc[0][et] = __builtin_amdgcn_mfma_f32_16x16x32_bf16(vf, pb[0][kp], Oacc[0][et], 0, 0, 0); Oacc[1][et] = __builtin_amdgcn_mfma_f32_16x16x32_bf16(vf, pb[1][kp], Oacc[1][et], 0, 0, 0); } \
    } \
    _Pragma("unroll") for (int u = 0; u < 2; ++u) { float lt = l[u]; lt += __shfl_xor(lt, 16); lt += __shfl_xor(lt, 32); const float il = 1.0f / lt; bf16* od_ = u ? (od1) : (od0); \
        _Pragma("unroll") for (int et = 0; et < 8; ++et) { v2u w; w.x = attn_body::cvtpk_s(Oacc[u][et].x * il, Oacc[u][et].y * il); w.y = attn_body::cvtpk_s(Oacc[u][et].z * il, Oacc[u][et].w * il); *(v2u*)(od_ + 16 * et) = w; } } \
} while (0)
#ifndef DMASK
#define DMASK 0
#endif
#ifndef QEXP
#define QEXP 0
#endif
#ifndef SREP2
#define SREP2 1
#endif
#ifndef SMODE
#define SMODE 0
#endif
#ifndef AORD
#define AORD 4
#endif
#ifndef SGAP
#define SGAP 4
#endif
#ifdef PROBE_A
#define GSYNC(k) do { if ((k) == 1) grid.sync(); else xcd_barrier(xbar); if (blockIdx.x == 0 && threadIdx.x == 0) ((unsigned long long*)(p.ws + 2048))[k] = __builtin_amdgcn_s_memrealtime(); } while (0)
#else
#define GSYNC(k) do { if ((k) == 1 && p.ws == nullptr) grid.sync(); xcd_barrier(xbar); } while (0)
#endif
__global__ void __launch_bounds__(NTHREADS, 2) fwd_kernel(Params p) {
    extern __shared__ __attribute__((aligned(16))) unsigned char lds_raw[];
    LAS unsigned char* lds = (LAS unsigned char*)lds_raw;
    cg::grid_group grid = cg::this_grid();
    const int tid = threadIdx.x, lane = tid & 63, wave = __builtin_amdgcn_readfirstlane(tid >> 6);
    const int G = gridDim.x, gw = blockIdx.x * NWAVES + wave, NGW = G * NWAVES;
    unsigned char* ws = p.ws; float* out = p.out;
    if (tid < 2) ((volatile LAS unsigned*)(lds + LDS_BYTES - 128))[tid] = 0u;
    __syncthreads();
    const XcdBarrier xbar = xcd_barrier_post((unsigned*)ws + 1024, (volatile LAS unsigned*)(lds + LDS_BYTES - 128));
#ifdef PROBE_A
    if (blockIdx.x == 0 && threadIdx.x == 0) ((unsigned long long*)(p.ws + 2048))[0] = __builtin_amdgcn_s_memrealtime();
#endif
    float* RS0 = (float*)(ws + WS_RS0); float* RSM = (float*)(ws + WS_RSM); float* SSP1 = (float*)(ws + WS_SSP1); float* SSP2 = (float*)(ws + WS_SSP2);
    bf16* W1T = (bf16*)(ws + WS_W1T); bf16* WOT = (bf16*)(ws + WS_WOT); bf16* WMQT = (bf16*)(ws + WS_WMQT); bf16* WMKVT = (bf16*)(ws + WS_WMKVT); bf16* WMOT = (bf16*)(ws + WS_WMOT);
    bf16* WF1T = (bf16*)(ws + WS_WF1T); bf16* WF2T = (bf16*)(ws + WS_WF2T); bf16* MEMB = (bf16*)(ws + WS_MEMB);
    bf16* XB = (bf16*)(ws + WS_XB); bf16* QB = (bf16*)(ws + WS_Q); bf16* KB = (bf16*)(ws + WS_KB); bf16* VB = (bf16*)(ws + WS_VB); bf16* CB = (bf16*)(ws + WS_C);
    bf16* A3 = (bf16*)(ws + WS_A3); float* OA = (float*)(ws + WS_OA); bf16* OAB = (bf16*)(ws + WS_OA); float* PART = (float*)(ws + WS_PART); float* PARTY = (float*)(ws + WS_PART + 16 * MiB); float* X1 = (float*)(ws + WS_X1); bf16* X1B = (bf16*)(ws + WS_X1B); bf16* QM = (bf16*)(ws + WS_QM); bf16* OM = (bf16*)(ws + WS_OM);
    bf16* X2B = (bf16*)(ws + WS_X2B); bf16* MKB = (bf16*)(ws + WS_MKB); bf16* MVT = (bf16*)(ws + WS_MVB); bf16* UB = (bf16*)(ws + WS_U);

    for (int rep_ = 0; rep_ < 1 + ((DMASK >> 0) & 1); ++rep_) { if (rep_) xcd_barrier(xbar);
    if constexpr (PH(0)) {
        LAS float* scr = (LAS float*)(lds + wave * 16384);
        constexpr int I1 = 16 * 80, I2 = 16 * 32, I3 = 16 * 16, I6 = 8 * 32, I7 = 16 * 128, I8 = 64 * 32;
        constexpr int NITEMS = I1 + I2 + 3 * I3 + I6 + I7 + I8;
        for (int it = gw; it < NITEMS; it += NGW) {
            int r = it;
            if (r < I1) { const int kb = r / 80, nb = r % 80; p0_transpose_item(p.in[I_WIN], 1024, 2560, p.in[I_GMIX], W1T, w1_row(32 * nb), scr, 64 * kb, 32 * nb, lane); continue; } r -= I1;
            if (r < I2) { const int kb = r / 32, nb = r % 32; p0_transpose_item(p.in[I_WOUT], 1024, 1024, nullptr, WOT, 32 * nb, scr, 64 * kb, 32 * nb, lane); continue; } r -= I2;
            if (r < I3) { const int kb = r / 16, nb = r % 16; p0_transpose_item(p.in[I_WMQ], 1024, 512, p.in[I_GCROSS], WMQT, 32 * nb, scr, 64 * kb, 32 * nb, lane); continue; } r -= I3;
            if (r < I3) { const int kb = r / 16, nb = r % 16; p0_transpose_item(p.in[I_WMK], 1024, 512, p.in[I_GMEM], WMKVT, 32 * nb, scr, 64 * kb, 32 * nb, lane); continue; } r -= I3;
            if (r < I3) { const int kb = r / 16, nb = r % 16; p0_transpose_item(p.in[I_WMV], 1024, 512, p.in[I_GMEM], WMKVT, 512 + 32 * nb, scr, 64 * kb, 32 * nb, lane); continue; } r -= I3;
            if (r < I6) { const int kb = r / 32, nb = r % 32; p0_transpose_item(p.in[I_WMO], 512, 1024, nullptr, WMOT, 32 * nb, scr, 64 * kb, 32 * nb, lane); continue; } r -= I6;
            if (r < I7) { const int kb = r / 128, nb = r % 128; p0_transpose_item(p.in[I_WFF1], 1024, 4096, p.in[I_GFFN], WF1T, 32 * nb, scr, 64 * kb, 32 * nb, lane); continue; } r -= I7;
            { const int kb = r / 32, nb = r % 32; p0_transpose_item(p.in[I_WFF2], 4096, 1024, nullptr, WF2T, 32 * nb, scr, 64 * kb, 32 * nb, lane); }
        }
        for (int m = 4 * gw; m < MTOT + 2048; m += 4 * NGW) {
            if (m < MPR) rows_to_bf16_rs<4>(p.in[I_XP] + (size_t)m * 1024, XB + (size_t)m * 1024, RS0 + m, 1, lane);
            else if (m < MTOT) rows_to_bf16_rs<4>(p.in[I_XS] + (size_t)(m - MPR) * 1024, XB + (size_t)m * 1024, RS0 + m, 1, lane);
            else rows_to_bf16_rs<4>(p.in[I_MEM] + (size_t)(m - MTOT) * 1024, MEMB + (size_t)(m - MTOT) * 1024, RSM + (m - MTOT), 1, lane);
        }
    }
    }
    GSYNC(1);

    for (int rep_ = 0; rep_ < 1 + ((DMASK >> 1) & 1); ++rep_) { if (rep_) xcd_barrier(xbar);
    if constexpr (PH(1)) {
        pg8::Gemm g{XB, W1T, MPR, 2560, 1024, 1024}; pg8::StaticOrder S; S.init(MPR, 2560, G, (int)blockIdx.x);
        pg8::EpiG1 E{RS0, p.in[I_GQ], p.in[I_GK], QB, KB, VB, CB, out + O_KP, out + O_KS, out + O_VP, out + O_VS, out + O_CP, out + O_CS};
        pg8::gemm_phase<pg8::EpiG1, pg8::StaticOrder, true, true>(lds, g, S, E);
    }
    }
    GSYNC(2);

    if constexpr (PH(5)) for (int it = gw; it < NBS * 14; it += NGW) {
        const int b = it / 14, i = it % 14; const float* src = p.in[I_CC] + (size_t)(b * 30 + 16 + i) * 512; float* dst = out + O_CS + (size_t)(b * 30 + i) * 512;
        *(f32x4*)(dst + lane * 8) = *(const f32x4*)(src + lane * 8); *(f32x4*)(dst + lane * 8 + 4) = *(const f32x4*)(src + lane * 8 + 4);
    }
    if constexpr (PH(6)) {
        const float* rel = p.in[I_REL];
        const int xq = (int)blockIdx.x & 7;
        for (int qrep = 0; qrep < 1 + ((QEXP) ? 1 : 0); ++qrep) {
        unsigned* qctr = (unsigned*)ws + 64 * xq + 512 * qrep;
        volatile LAS unsigned* qword = (volatile LAS unsigned*)(lds + LDS_BYTES - 256);
        constexpr int NQ_G = 3, NQ_M = 4, NQ_P0 = 24, NQ_S = 4 * SNP, NQ_P = 128, NQ_C = MTOT / 32 / 8, NQ_X = 24, NQ = NQ_G + NQ_M + NQ_S + NQ_P + NQ_C + NQ_X;
        unsigned* g1ctr = (unsigned*)ws + 4736;
        bool conv_lds = false;
        unsigned qnext = 0u; if (tid == 0) qnext = __hip_atomic_fetch_add(qctr, 1u, __ATOMIC_RELAXED, __HIP_MEMORY_SCOPE_AGENT);
        for (;;) {
            __syncthreads();
            if (tid == 0) qword[0] = qnext;
            __syncthreads();
            const int item = (int)qword[0];
            if (item >= NQ) break;
            if (tid == 0) qnext = __hip_atomic_fetch_add(qctr, 1u, __ATOMIC_RELAXED, __HIP_MEMORY_SCOPE_AGENT);
            int kind, idx;
            if (item < NQ_G) { kind = 0; idx = item; } else if (item < NQ_G + NQ_M) { kind = 1; idx = item - NQ_G; }
            else if (item < NQ_G + NQ_M + NQ_P0) { kind = 2; idx = item - NQ_G - NQ_M; }
            else if (item < NQ_G + NQ_M + NQ_P0 + NQ_S * (1 + SGAP)) { const int r = item - NQ_G - NQ_M - NQ_P0, rq = r / (1 + SGAP), rm = r % (1 + SGAP);
                if (rm == 0) { kind = 3; idx = rq; } else { kind = 2; idx = NQ_P0 + rq * SGAP + rm - 1; } }
            else if (item < NQ_G + NQ_M + NQ_S + NQ_P) { kind = 2; idx = item - NQ_G - NQ_M - NQ_S; } else if (item < NQ_G + NQ_M + NQ_S + NQ_P + NQ_C) { kind = 4; idx = item - NQ_G - NQ_M - NQ_S - NQ_P; }
            else { kind = 5; idx = item - NQ_G - NQ_M - NQ_S - NQ_P - NQ_C; }
            if (qrep && ((QEXP) == 1) && kind != 2) continue;
            if (qrep && ((QEXP) == 2) && kind != 3 && kind != 4 && kind != 5) continue;
            if (qrep && ((QEXP) == 3) && kind != 3) continue;
            if (kind == 5) { const int wt = (idx * 8 + xq) * 8 + wave;
                int ln5 = lane; asm volatile("" : "+v"(ln5));
                if (wt < 512) {
#pragma unroll 1
                    for (int i = 0; i < 16; ++i) mk_row(2048 + 16 * wt + i, ln5, out + O_MK, p.in[I_CMK], p.in[I_GMK], p.in[I_GMQ], MKB); }
                else mvt_item(256 + (wt - 512), ln5, out + O_MV, p.in[I_CMV], MVT);
                continue; }
            if (kind == 0) { const int u = xq + 8 * idx;
                if (u < 20) { pg8::Gemm g{XB, W1T, MTOT, 2560, 1024, 1024}; pg8::OneUnit S{128 + u / 10, u % 10};
                    pg8::EpiG1 E{RS0, p.in[I_GQ], p.in[I_GK], QB, KB, VB, CB, out + O_KP, out + O_KS, out + O_VP, out + O_VS, out + O_CP, out + O_CS};
                    pg8::gemm_phase<pg8::EpiG1, pg8::OneUnit, true, true>(lds, g, S, E);
                    if (tid == 0 && !qrep) { __builtin_amdgcn_fence(__ATOMIC_RELEASE, "agent"); asm volatile("s_waitcnt vmcnt(0)" ::: "memory"); __hip_atomic_fetch_add(g1ctr, 1u, __ATOMIC_RELAXED, __HIP_MEMORY_SCOPE_AGENT); } }
            } else if (kind == 1) { const int u = xq + 8 * idx;
                pg8::Gemm g{MEMB, WMKVT, 2048, 1024, 1024, 1024}; pg8::OneUnit S{u >> 2, u & 3};
                pg8::EpiMem E{RSM, out + O_MK, out + O_MV};
                pg8::gemm_phase<pg8::EpiMem, pg8::OneUnit, true, true>(lds, g, S, E);
            } else if (kind == 3) { const int b = 4 * xq + idx / SNP, part = idx % SNP;
                if (tid == 0) { unsigned sp = 0; while (__hip_atomic_load(g1ctr, __ATOMIC_RELAXED, __HIP_MEMORY_SCOPE_AGENT) < 20u && ++sp < (1u << 22)) __builtin_amdgcn_s_sleep(4);
                    __builtin_amdgcn_fence(__ATOMIC_ACQUIRE, "agent"); asm volatile("s_waitcnt vmcnt(0)" ::: "memory"); }
                __syncthreads();
                if constexpr (PH(7))
#pragma unroll 1
                  for (int sr_ = 0; sr_ < (qrep ? SREP2 : SREP); ++sr_) sample_attn_task<2 * SNP>(b, wave >> 1, 2 * part + (wave & 1), lane, wave, lds, QB, p.in[I_CK], p.in[I_CV], out + O_KS, out + O_VS, rel, (QEXP == 3 && SMODE && qrep) ? nullptr : PART);
            } else if (kind == 2) { const int j = idx, bhm = 8 * xq + (AORD == 1 ? (j >> 4) : (j / (16 * AORD)) * AORD + (j % AORD)), qb = 15 - (AORD == 1 ? (j & 15) : (j % (16 * AORD)) / AORD), b = bhm >> 3, hm = bhm & 7;
                if constexpr (PH(15)) attn2::attn_unit<8>(b, hm * 64, hm * 64, (hm >> 1) * 128, hm * 128, qb, hm >> 1, rel,
                                        (const attn2::bf16*)QB, (const attn2::bf16*)KB, (const attn2::bf16*)VB, (attn2::bf16*)OAB, (char*)lds_raw);
            } else { const int ct = idx * 8 + xq;
                if constexpr (PH(4)) {
                    if (!conv_lds) { conv_lds = true;
                        int tl = tid; asm volatile("" : "+v"(tl));
                        for (int i = tl; i < 31 * 128; i += NTHREADS) { const int j = i >> 7, q = i & 127; *(LAS f32x4*)(lds + (size_t)((j * 2 + (q & 1)) * 64 + (q >> 1)) * 16) = *(const f32x4*)(p.in[I_WCONV] + (size_t)i * 4); } }
                    if (ct < 1024) conv_item_prompt(ct, tid, CB, lds, p.in[I_BCONV], p.in[I_LNG], p.in[I_LNB], A3);
                    else conv_task_sample((ct - 1024) * 8 + wave, lane, CB, p.in[I_CC], p.in[I_WCONV], p.in[I_BCONV], p.in[I_LNG], p.in[I_LNB], A3); } }
        }
        }
    }
    GSYNC(3);
    for (int rep_ = 0; rep_ < 1 + ((DMASK >> 3) & 1); ++rep_) { if (rep_) xcd_barrier(xbar);
    if constexpr (PH(3)) for (int r = gw; r < 2048; r += NGW) mk_row(r, lane, out + O_MK, p.in[I_CMK], p.in[I_GMK], p.in[I_GMQ], MKB);
    if constexpr (PH(3)) for (int it = gw; it < 8 * 4 * 8; it += NGW) mvt_item(it, lane, out + O_MV, p.in[I_CMV], MVT);
    if constexpr (PH(8)) {
        const float lam = compute_lam(p.in[I_LAM], lane);
        for (int r = gw; r < MTOT; r += NGW) {
            const int h = lane >> 4, e0 = (lane & 15) * 8; f32x4 a0, a1, b0, b1;
            if (r < MPR) { float fa[8], fb[8]; unpack8(*(const v4u*)(OAB + (size_t)r * 1024 + (2 * h) * 128 + e0), fa); unpack8(*(const v4u*)(OAB + (size_t)r * 1024 + (2 * h + 1) * 128 + e0), fb);
                a0 = (f32x4){fa[0], fa[1], fa[2], fa[3]}; a1 = (f32x4){fa[4], fa[5], fa[6], fa[7]}; b0 = (f32x4){fb[0], fb[1], fb[2], fb[3]}; b1 = (f32x4){fb[4], fb[5], fb[6], fb[7]}; }
            else { const int sb = (r - MPR) >> 4, q = (r - MPR) & 15; f32x4 acc[2][2];
#pragma unroll
                for (int m = 0; m < 2; ++m) { const float* pb = PART + ((size_t)((sb * 4 + h) * (2 * SNP) * 2 + m) * 16 + q) * PART_STRIDE; float M = -1e30f;
#pragma unroll
                    for (int sp = 0; sp < 2 * SNP; ++sp) M = fmaxf(M, pb[(size_t)sp * 2 * 16 * PART_STRIDE + 128]);
                    float L = 0.f; f32x4 s0 = (f32x4){0.f, 0.f, 0.f, 0.f}, s1 = s0;
#pragma unroll
                    for (int sp = 0; sp < 2 * SNP; ++sp) { const float* ps = pb + (size_t)sp * 2 * 16 * PART_STRIDE; const float f = exp2f(ps[128] - M); L += ps[129] * f; s0 += *(const f32x4*)(ps + e0) * f; s1 += *(const f32x4*)(ps + e0 + 4) * f; }
                    const float il = 1.0f / L; acc[m][0] = s0 * il; acc[m][1] = s1 * il; }
                a0 = acc[0][0]; a1 = acc[0][1]; b0 = acc[1][0]; b1 = acc[1][1]; }
            const f32x4 d0 = a0 - b0 * lam, d1 = a1 - b1 * lam;
            float ss = (d0.x * d0.x + d0.y * d0.y) + (d0.z * d0.z + d0.w * d0.w) + (d1.x * d1.x + d1.y * d1.y) + (d1.z * d1.z + d1.w * d1.w);
            ss += __shfl_xor(ss, 1); ss += __shfl_xor(ss, 2); ss += __shfl_xor(ss, 4); ss += __shfl_xor(ss, 8);
            const float sc = (1.0f - LAM_INIT) / sqrtf(ss * (1.0f / 128.0f) + EPS); const f32x4 g0 = *(const f32x4*)(p.in[I_GSUB] + e0), g1 = *(const f32x4*)(p.in[I_GSUB] + e0 + 4);
            const f32x4 y0 = d0 * g0 * sc, y1 = d1 * g1 * sc;
            v4u o; o.x = pk2(y0.x, y0.y); o.y = pk2(y0.z, y0.w); o.z = pk2(y1.x, y1.y); o.w = pk2(y1.z, y1.w);
            *(v4u*)(A3 + (size_t)r * 1024 + h * 128 + e0) = o;
        }
    }
    }
    for (int rep_ = 0; rep_ < ((DMASK >> 12) & 1) * 10; ++rep_) xcd_barrier(xbar);
    GSYNC(4);
    for (int rep_ = 0; rep_ < 1 + ((DMASK >> 4) & 1); ++rep_) { if (rep_) xcd_barrier(xbar);
    if constexpr (PH(9)) {
        pg8::Gemm g{A3, WOT, MPR, 1024, 1024, 1024}; pg8::StaticOrder S; S.init(MPR, 1024, G, (int)blockIdx.x);
        pg8::EpiRes E{XB, X1B, SSP1};
        pg8::gemm_phase<pg8::EpiRes, pg8::StaticOrder, true, true>(lds, g, S, E);
    }
    }
    GSYNC(5);
    for (int rep_ = 0; rep_ < 1 + ((DMASK >> 5) & 1); ++rep_) { if (rep_) xcd_barrier(xbar);
    if constexpr (PH(10)) {
        unsigned* g3ctr = (unsigned*)ws + 4672;
        unsigned* g4sctr = (unsigned*)ws + 4864; unsigned* xtctr = (unsigned*)ws + 4928; unsigned* g4ctr = (unsigned*)ws + 5120;
        { const int cs = (int)((blockIdx.x + G - 8) % G);
          pg8::Gemm g{A3 + (size_t)MPR * 1024, WOT, MSA, 1024, 1024, 1024}; pg8::StaticOrder S; S.init(MSA, 1024, G, cs);
          pg8::EpiRes E{XB + (size_t)MPR * 1024, X1B + (size_t)MPR * 1024, SSP1 + (size_t)MPR * 16};
          pg8::gemm_phase<pg8::EpiRes, pg8::StaticOrder, true, true>(lds, g, S, E);
          if (cs < 8 && tid == 0) { __builtin_amdgcn_fence(__ATOMIC_RELEASE, "agent"); asm volatile("s_waitcnt vmcnt(0)" ::: "memory"); __hip_atomic_fetch_add(g3ctr, 1u, __ATOMIC_RELAXED, __HIP_MEMORY_SCOPE_AGENT); } }
        { pg8::Gemm g{X1B, WMQT, MPR, 512, 1024, 1024}; pg8::StaticOrder S; S.init(MPR, 512, G, (int)blockIdx.x);
          pg8::EpiScaleBf16<0> E{SSP1, QM, 512};
          pg8::gemm_phase<pg8::EpiScaleBf16<0>, pg8::StaticOrder, true, true>(lds, g, S, E);
          int upm, upn; if (static_unit0(MPR / 256, 2, G, (int)blockIdx.x, upm, upn) && tid == 0) {
              __builtin_amdgcn_fence(__ATOMIC_RELEASE, "agent"); asm volatile("s_waitcnt vmcnt(0)" ::: "memory"); __hip_atomic_fetch_add(g4ctr + ((upm >> 1) * 2 + upn) * 16, 1u, __ATOMIC_RELAXED, __HIP_MEMORY_SCOPE_AGENT); } }
        if (blockIdx.x >= 64 && blockIdx.x < 68) {
            if (tid == 0) { unsigned sp = 0; while (__hip_atomic_load(g3ctr, __ATOMIC_RELAXED, __HIP_MEMORY_SCOPE_AGENT) < 8u * (unsigned)(rep_ + 1) && ++sp < (1u << 22)) __builtin_amdgcn_s_sleep(4);
                __builtin_amdgcn_fence(__ATOMIC_ACQUIRE, "agent"); asm volatile("s_waitcnt vmcnt(0)" ::: "memory"); }
            __syncthreads(); }
        { pg8::Gemm g{X1B + (size_t)MPR * 1024, WMQT, MSA, 512, 1024, 1024}; pg8::StaticOrder S; S.init(MSA, 512, G, (int)((blockIdx.x + G - 64) % G));
          pg8::EpiScaleBf16<0> E{SSP1 + (size_t)MPR * 16, QM + (size_t)MPR * 512, 512};
          pg8::gemm_phase<pg8::EpiScaleBf16<0>, pg8::StaticOrder, true, true>(lds, g, S, E);
          if (blockIdx.x >= 64 && blockIdx.x < 68 && tid == 0) { __builtin_amdgcn_fence(__ATOMIC_RELEASE, "agent"); asm volatile("s_waitcnt vmcnt(0)" ::: "memory"); __hip_atomic_fetch_add(g4sctr, 1u, __ATOMIC_RELAXED, __HIP_MEMORY_SCOPE_AGENT); } }
    {
        const int vcu = (G % 8 == 0) ? ((int)blockIdx.x % 8) * (G / 8) + (int)blockIdx.x / 8 : (int)blockIdx.x;
        constexpr int KS = 136, VS = 264, VOFF = 256 * KS * 2;
        volatile LAS unsigned* tword = (volatile LAS unsigned*)(lds + LDS_BYTES - 256);
        for (;;) {
            __syncthreads();
            if (tid == 0) { const unsigned t_ = __hip_atomic_fetch_add(xtctr, 1u, __ATOMIC_RELAXED, __HIP_MEMORY_SCOPE_AGENT); tword[0] = t_;
                if (t_ < 256u + NBS * 4) { const bool sm_ = t_ >= 256u; const unsigned* dep = sm_ ? g4sctr : g4ctr + ((((t_ >> 5) * 8 + (t_ & 7)) * 2 + ((t_ >> 4) & 1)) * 16); const unsigned need = sm_ ? 4u : 2u;
                    unsigned sp = 0; while (__hip_atomic_load(dep, __ATOMIC_RELAXED, __HIP_MEMORY_SCOPE_AGENT) < need && ++sp < (1u << 22)) __builtin_amdgcn_s_sleep(4);
                    __builtin_amdgcn_fence(__ATOMIC_ACQUIRE, "agent"); asm volatile("s_waitcnt vmcnt(0)" ::: "memory"); } }
            __syncthreads();
            const int bt = (int)tword[0]; if (bt >= 256 + NBS * 4) break;
            const bool smp = bt >= 256; const int bb = smp ? 8 + ((bt - 256) >> 2) : bt >> 5, head = smp ? (bt - 256) & 3 : (bt >> 3) & 3, part = bt & 7;
            int td = tid; asm volatile("" : "+v"(td)); const int ln = td & 63;
            __syncthreads();
#pragma unroll
            for (int i = 0; i < 8; ++i) { const int ch = td + 512 * i, row = ch >> 4, cc = ch & 15;
                *(LAS v4u*)(lds + (row * KS + cc * 8) * 2) = *(const v4u*)(MKB + (size_t)(bb * 256 + row) * 512 + head * 128 + cc * 8); }
#pragma unroll
            for (int i = 0; i < 8; ++i) { const int ch = td + 512 * i, row = ch >> 5, cc = ch & 31;
                *(LAS v4u*)(lds + VOFF + (row * VS + cc * 8) * 2) = *(const v4u*)(MVT + ((size_t)(bb * 4 + head) * 128 + row) * 256 + cc * 8); }
            __syncthreads();
            const int c = ln & 15, g = ln >> 4;
            const LAS unsigned char* kl = lds + (c * KS + 8 * g) * 2; const LAS unsigned char* vl = lds + VOFF + (c * VS + 8 * g) * 2;
#define XK_L(kt, s4) (*(const LAS pg8::bf16x8*)(kl + ((16 * (kt)) * KS + 32 * (s4)) * 2))
#define XV_L(et, kp) (*(const LAS pg8::bf16x8*)(vl + ((16 * (et)) * VS + 32 * (kp)) * 2))
            if (smp) { if (wave == 0) { int cl = c; asm volatile("" : "+v"(cl)); const int r = MPR + (bb - 8) * 16 + cl;
                    XATTN_GROUP(QM + (size_t)r * 512 + head * 128, OM + (size_t)r * 512 + head * 128 + 4 * g, g, XK_L, XV_L); } }
            else
#pragma unroll 1
            for (int gi = 0; gi < 4; gi += 2) { int cl = c; asm volatile("" : "+v"(cl)); const int r = bb * 4096 + part * 512 + (wave * 4 + gi) * 16 + cl;
                XATTN_GROUP2(QM + (size_t)r * 512 + head * 128, QM + (size_t)(r + 16) * 512 + head * 128, OM + (size_t)r * 512 + head * 128 + 4 * g, OM + (size_t)(r + 16) * 512 + head * 128 + 4 * g, g, XK_L, XV_L); }
#undef XK_L
#undef XV_L
        }
        __syncthreads();
    }
    }
    }
    GSYNC(7);
    if constexpr (PH(12)) {
        pg8::Gemm g{OM, WMOT, MPR, 1024, 512, 512}; pg8::StaticOrder S; S.init(MPR, 1024, G, (int)blockIdx.x);
        pg8::EpiRes E{X1B, X2B, SSP2};
        pg8::gemm_phase<pg8::EpiRes, pg8::StaticOrder, true, true>(lds, g, S, E);
    }
    GSYNC(8);
    for (int rep_ = 0; rep_ < 1 + ((DMASK >> 8) & 1); ++rep_) { if (rep_) xcd_barrier(xbar);
    if constexpr (PH(13)) {
        { pg8::Gemm g{OM + (size_t)MPR * 512, WMOT, MSA, 1024, 512, 512}; pg8::StaticOrder S; S.init(MSA, 1024, G, (int)blockIdx.x);
          pg8::EpiRes E{X1B + (size_t)MPR * 1024, X2B + (size_t)MPR * 1024, SSP2 + (size_t)MPR * 16};
          pg8::gemm_phase<pg8::EpiRes, pg8::StaticOrder, true, true>(lds, g, S, E); }
        { pg8::Gemm g{X2B, WF1T, MPR, 4096, 1024, 1024}; pg8::StaticOrder S; S.init(MPR, 4096, G, (int)blockIdx.x);
          pg8::EpiScaleBf16<1> E{SSP2, UB, 4096};
          pg8::gemm_phase<pg8::EpiScaleBf16<1>, pg8::StaticOrder, true, true>(lds, g, S, E); }
    }
    }
    GSYNC(9);
    for (int rep_ = 0; rep_ < 1 + ((DMASK >> 9) & 1); ++rep_) { if (rep_) xcd_barrier(xbar);
    if constexpr (PH(14)) {
        unsigned* g7ctr = (unsigned*)ws + 4608;
        { const int cs = (int)((blockIdx.x + G - 8) % G);
          pg8::Gemm g{X2B + (size_t)MPR * 1024, WF1T, MSA, 4096, 1024, 1024}; pg8::StaticOrder S; S.init(MSA, 4096, G, cs);
          pg8::EpiScaleBf16<1> E{SSP2 + (size_t)MPR * 16, UB + (size_t)MPR * 4096, 4096};
          pg8::gemm_phase<pg8::EpiScaleBf16<1>, pg8::StaticOrder, true, true>(lds, g, S, E);
          if (cs < 32 && tid == 0) {
              __builtin_amdgcn_fence(__ATOMIC_RELEASE, "agent"); asm volatile("s_waitcnt vmcnt(0)" ::: "memory");
              __hip_atomic_fetch_add(g7ctr, 1u, __ATOMIC_RELAXED, __HIP_MEMORY_SCOPE_AGENT); } }
        { pg8::Gemm g{UB, WF2T, MPR, 1024, 4096, 4096}; pg8::StaticOrder S; S.init(MPR, 1024, G, (int)blockIdx.x);
          pg8::EpiOut E{X2B, out + O_YP};
          pg8::gemm_phase<pg8::EpiOut, pg8::StaticOrder, true, true>(lds, g, S, E); }
        if (blockIdx.x >= 64 && blockIdx.x < 96) {
            if (tid == 0) { unsigned sp = 0; while (__hip_atomic_load(g7ctr, __ATOMIC_RELAXED, __HIP_MEMORY_SCOPE_AGENT) < 32u * (unsigned)(rep_ + 1) && ++sp < (1u << 22)) __builtin_amdgcn_s_sleep(4);
                __builtin_amdgcn_fence(__ATOMIC_ACQUIRE, "agent"); asm volatile("s_waitcnt vmcnt(0)" ::: "memory"); }
            __syncthreads(); }
#pragma unroll 1
        for (int kq = 0; kq < 4; ++kq) { pg8::Gemm g{UB + (size_t)MPR * 4096 + kq * 1024, WF2T + kq * 1024, MSA, 1024, 1024, 4096}; pg8::StaticOrder S; S.init(MSA, 1024, G, (int)((blockIdx.x + G - 8 * kq - 64) % G));
          pg8::EpiPart E{PARTY + (size_t)kq * MSA * 1024};
          pg8::gemm_phase<pg8::EpiPart, pg8::StaticOrder, true, true>(lds, g, S, E); }
        if (rep_ == ((DMASK >> 9) & 1)) {
            xcd_barrier(xbar);
            for (int r = gw; r < MSA; r += NGW) {
#pragma unroll
                for (int j = 0; j < 4; ++j) { const size_t o = (size_t)r * 1024 + 4 * lane + 256 * j; const v2u xw = *(const v2u*)(X2B + (size_t)MPR * 1024 + o); f32x4 v = (f32x4){bf2f(xw.x & 0xffffu), bf2f(xw.x >> 16), bf2f(xw.y & 0xffffu), bf2f(xw.y >> 16)};
#pragma unroll
                    for (int kq = 0; kq < 4; ++kq) v += *(const f32x4*)(PARTY + (size_t)kq * MSA * 1024 + o);
                    *(f32x4*)(out + O_YS + o) = v; } }
        }
    }
    }
#ifdef PROBE_A
    GSYNC(10);
    if (blockIdx.x == 0 && threadIdx.x == 0) { const unsigned long long* ts = (const unsigned long long*)(p.ws + 2048);
        out[O_YP] += floorf((float)(ts[PROBE_A + 1] - ts[PROBE_A]) * 0.001f + 0.5f) * 10.0f;
        out[O_YS] += PROBE_B < 0 ? 100.0f : floorf((float)(ts[PROBE_B + 1] - ts[PROBE_B]) * 0.001f + 0.5f) * 10.0f; }
#endif
}

extern "C" void kernel_launch(void* const* d_in, const int* in_sizes, int n_in, void* d_out, int out_size, void* d_ws, size_t ws_size, hipStream_t stream) {
    static int grid = 0;
    if (grid == 0) {
        if (n_in != 31 || out_size != (int)O_END || ws_size < WS_END) { fprintf(stderr, "kernel_launch: unexpected shapes (n_in %d, out %d, ws %zu)\n", n_in, out_size, ws_size); grid = -1; return; }
        int dev = 0, cus = 0, per_cu = 0;
        hipGetDevice(&dev); hipDeviceGetAttribute(&cus, hipDeviceAttributeMultiprocessorCount, dev);
        if (hipFuncSetAttribute((const void*)fwd_kernel, hipFuncAttributeMaxDynamicSharedMemorySize, LDS_BYTES) != hipSuccess) { fprintf(stderr, "kernel_launch: hipFuncSetAttribute failed\n"); grid = -1; return; }
        if (hipOccupancyMaxActiveBlocksPerMultiprocessor(&per_cu, (const void*)fwd_kernel, NTHREADS, LDS_BYTES) != hipSuccess || per_cu < 1) { fprintf(stderr, "kernel_launch: occupancy query failed (%d)\n", per_cu); (void)hipGetLastError(); per_cu = 1; }
        if (per_cu > 1) per_cu = 1;
        grid = cus * per_cu;
        if (grid % 8 != 0 || grid < 8) { fprintf(stderr, "kernel_launch: unexpected CU count %d\n", cus); }
    }
    if (grid < 0) return;
    if (hipMemsetAsync(d_ws, 0, 32768, stream) != hipSuccess) { fprintf(stderr, "kernel_launch: hipMemsetAsync failed\n"); return; }
    Params p{};
    for (int i = 0; i < 31; ++i) p.in[i] = (const float*)d_in[i];
    p.out = (float*)d_out; p.ws = (unsigned char*)d_ws;
    void* args[] = {&p};
    hipError_t e = hipLaunchCooperativeKernel((const void*)fwd_kernel, dim3(grid), dim3(NTHREADS), args, LDS_BYTES, stream);
    if (e != hipSuccess) fprintf(stderr, "kernel_launch: cooperative launch failed: %s (grid %d)\n", hipGetErrorString(e), grid);
}
```
